# Optimizing an MI355X kernel written in HIP

```python
import functools
import jax
import jax.numpy as jnp
from jax import lax
import numpy as np

D_MODEL = 1024
BATCH = 4
SEQ = 4096
DEPTH = 2
DEC_BATCH = 128
DEC_SEQ = 4
PAST_LEN = 2048
PAGE_SIZE = 128

M_HEADS = 4
M_WIDTH = D_MODEL // 2
M_HEAD_DIM = M_WIDTH // M_HEADS
M_CONV = 4
M_CHUNK = 64
HEAD_DIM = 64
N_WIDTH = D_MODEL // 2
N_HEADS = N_WIDTH // HEAD_DIM
N_KV = 2
KV_W = N_KV * HEAD_DIM
CMP_STRIDE = 16
CMP_LEN = 2 * CMP_STRIDE
CMP_HID = 128
SEL_BLOCK = 64
SEL_TOP = 16
WINDOW = 512
Q_BLOCK = 128
ROT_DIM = HEAD_DIM // 4
ROPE_THETA = 500000.0
D_FF = -(-8 * D_MODEL // (3 * 256)) * 256
EPS = 1e-6
NEG = -1e30
TINY = 1e-30
FORCE_SCORE = 1e9
SPLIT_SIZES = (M_WIDTH, M_WIDTH, M_WIDTH, M_HEADS, M_HEADS, N_WIDTH, 6 * KV_W, 3 * N_HEADS, D_MODEL, D_MODEL)
IN_WIDTH = sum(SPLIT_SIZES)

kernel_name = 'hybrid_mlstm_nsa_decoder_step'


def rmsnorm(x, g):
    xf = x.astype(jnp.float32)
    y = xf * lax.rsqrt(jnp.mean(xf * xf, axis=-1, keepdims=True) + EPS) * g.astype(jnp.float32)
    return y.astype(x.dtype)


def split_cols(z):
    pts = [int(p) for p in np.cumsum(SPLIT_SIZES)[:-1]]
    return jnp.split(z, pts, axis=-1)


def rope_partial(x, pos):
    half = ROT_DIM // 2
    inv = ROPE_THETA ** (-jnp.arange(half, dtype=jnp.float32) / half)
    ang = pos.astype(jnp.float32)[:, None] * inv[None, :]
    cos = jnp.cos(ang)[None, :, None, :]
    sin = jnp.sin(ang)[None, :, None, :]
    xf = x.astype(jnp.float32)
    x1 = xf[..., :half]
    x2 = xf[..., half:ROT_DIM]
    out = jnp.concatenate([x1 * cos - x2 * sin, x2 * cos + x1 * sin, xf[..., ROT_DIM:]], axis=-1)
    return out.astype(x.dtype)


def masked_softmax(s, mask):
    s = jnp.where(mask, s.astype(jnp.float32), NEG)
    p = jnp.exp(s - jnp.max(s, axis=-1, keepdims=True)) * mask
    return p / jnp.maximum(jnp.sum(p, axis=-1, keepdims=True), TINY)


def causal_conv(u, buf, w, b):
    T = u.shape[1]
    xp = jnp.concatenate([buf.astype(u.dtype), u], axis=1)
    y = b + sum(xp[:, j:j + T] * w[j] for j in range(M_CONV))
    return jax.nn.silu(y), xp[:, T:]


def mlstm_chunkwise(q, k, v, i_pre, log_f, C0, n0, m0):
    B, T, H, _ = q.shape
    cs = T if T <= M_CHUNK else M_CHUNK
    nc = T // cs

    def to_chunks(a):
        a = a.astype(jnp.float32).reshape((B, nc, cs, H) + a.shape[3:])
        return jnp.moveaxis(a, (1, 3), (0, 2))

    tril = jnp.tril(jnp.ones((cs, cs), dtype=bool))

    def step(carry, inp):
        C, n, m = carry
        qc, kc, vc, ic, fc = inp
        F = jnp.cumsum(fc, axis=-1)
        a = ic - F
        mt = F + jnp.maximum(m[..., None], lax.cummax(a, axis=a.ndim - 1))
        logD = jnp.where(tril, a[..., None, :] + (F - mt)[..., :, None], -jnp.inf)
        S = jnp.einsum('bhtd,bhsd->bhts', qc, kc) * jnp.exp(logD)
        inter = jnp.exp(m[..., None] + F - mt)
        num = jnp.einsum('bhts,bhse->bhte', S, vc) + inter[..., None] * jnp.einsum('bhtd,bhde->bhte', qc, C)
        den = jnp.sum(S, axis=-1) + inter * jnp.einsum('bhtd,bhd->bht', qc, n)
        h = num / jnp.maximum(jnp.abs(den), jnp.exp(-mt))[..., None]
        m_new = mt[..., -1]
        w = jnp.exp(a + (F[..., -1] - m_new)[..., None])
        decay = jnp.exp(m + F[..., -1] - m_new)
        C_new = decay[..., None, None] * C + jnp.einsum('bhs,bhsd,bhse->bhde', w, kc, vc)
        n_new = decay[..., None] * n + jnp.einsum('bhs,bhsd->bhd', w, kc)
        return (C_new, n_new, m_new), h

    init = (C0.astype(jnp.float32), n0.astype(jnp.float32), m0.astype(jnp.float32))
    (C, n, m), h = lax.scan(step, init, (to_chunks(q), to_chunks(k), to_chunks(v), to_chunks(i_pre), to_chunks(log_f)))
    h = jnp.moveaxis(h, (0, 2), (1, 3)).reshape(B, T, H, v.shape[-1])
    return h, C, n, m


def mlstm_branch(u, v, o, ig, fg, conv_buf, C0, n0, m0, conv_w, conv_b, w_mq, w_mk, b_gates, norm_g):
    B, T, _ = u.shape
    c, conv_new = causal_conv(u, conv_buf, conv_w, conv_b)
    c = c.reshape(B, T, M_HEADS, M_HEAD_DIM)
    q = jnp.einsum('bthd,hde->bthe', c, w_mq)
    k = jnp.einsum('bthd,hde->bthe', c, w_mk) * (M_HEAD_DIM ** -0.5)
    v = v.reshape(B, T, M_HEADS, M_HEAD_DIM)
    pre = jnp.concatenate([ig, fg], axis=-1).astype(jnp.float32) + b_gates.astype(jnp.float32)
    i_pre = pre[..., :M_HEADS]
    log_f = jax.nn.log_sigmoid(pre[..., M_HEADS:])
    h, C, n, m = mlstm_chunkwise(q, k, v, i_pre, log_f, C0, n0, m0)
    h = h * lax.rsqrt(jnp.mean(h * h, axis=-1, keepdims=True) + EPS) * norm_g.astype(jnp.float32).reshape(M_HEADS, M_HEAD_DIM)
    out = h.reshape(B, T, M_WIDTH) * jax.nn.sigmoid(o.astype(jnp.float32))
    return out.astype(u.dtype), conv_new, C, n, m


def compress(raw, pe, w1, w2):
    B, L = raw.shape[:2]
    n_chunk = L // CMP_STRIDE
    ch = raw[:, :n_chunk * CMP_STRIDE].reshape(B, n_chunk, CMP_STRIDE, N_KV, HEAD_DIM)
    blocks = jnp.concatenate([ch[:, :-1], ch[:, 1:]], axis=2) + pe[None, None, :, None, :]
    hid = jax.nn.gelu(jnp.einsum('bnlgd,lde->bnge', blocks, w1))
    return jnp.einsum('bnge,ef->bngf', hid, w2)


def sel_overlap(n_cmp, n_blk):
    start = np.arange(n_cmp) * CMP_STRIDE
    bs = np.arange(n_blk) * SEL_BLOCK
    ov = np.minimum(start[:, None] + CMP_LEN, bs[None, :] + SEL_BLOCK) - np.maximum(start[:, None], bs[None, :])
    return jnp.asarray(np.clip(ov, 0, None) / CMP_LEN, dtype=jnp.float32)


def gather_rows(kv, idx):
    return jax.vmap(jax.vmap(lambda a, i: a[i]))(kv, idx)


def nsa_core(q, q_rot, qpos, kc, vc, cmp_end, k_sel, v_sel, kw, vw, kwpos, gates):
    B, Q = q.shape[:2]
    L = k_sel.shape[1]
    R = N_HEADS // N_KV
    scale = HEAD_DIM ** -0.5
    qp = q.reshape(B, Q, N_KV, R, HEAD_DIM)
    qr = q_rot.reshape(B, Q, N_KV, R, HEAD_DIM)
    p_c = masked_softmax(jnp.einsum('bqgrd,bngd->bgrqn', qp, kc) * scale, cmp_end[None, :] <= qpos[:, None])
    o_c = jnp.einsum('bgrqn,bngd->bqgrd', p_c, vc)
    n_blk = -(-L // SEL_BLOCK)
    imp = jnp.einsum('bgrqn,nj->bgqj', p_c, sel_overlap(kc.shape[1], n_blk))
    blk = jnp.arange(n_blk)[None, :]
    cur = (qpos // SEL_BLOCK)[:, None]
    forced = (blk == 0) | (blk == cur) | (blk == cur - 1)
    score = jnp.where(blk <= cur, jnp.where(forced, FORCE_SCORE, imp), -1.0)
    _, top = lax.top_k(score, min(SEL_TOP, n_blk))
    tok = (top[..., None] * SEL_BLOCK + jnp.arange(SEL_BLOCK)).reshape(B, N_KV, Q, -1)
    idx = jnp.minimum(tok, L - 1)
    ks = gather_rows(jnp.swapaxes(k_sel, 1, 2), idx)
    vs = gather_rows(jnp.swapaxes(v_sel, 1, 2), idx)
    p_s = masked_softmax(jnp.einsum('bqgrd,bgqnd->bgrqn', qr, ks) * scale, (tok <= qpos[:, None])[:, :, None])
    o_s = jnp.einsum('bgrqn,bgqnd->bqgrd', p_s, vs)
    dpos = qpos[:, None] - kwpos[None, :]
    mask_w = (dpos >= 0) & (dpos < WINDOW) & (kwpos[None, :] >= 0)
    p_w = masked_softmax(jnp.einsum('bqgrd,bkgd->bgrqk', qr, kw) * scale, mask_w)
    o_w = jnp.einsum('bgrqk,bkgd->bqgrd', p_w, vw)
    g = gates.reshape(B, Q, N_KV, R, 3)
    out = g[..., 0:1] * o_c + g[..., 1:2] * o_s + g[..., 2:3] * o_w
    return out.reshape(B, Q, N_WIDTH).astype(q.dtype)


def nsa_prompt(q, q_rot, pos, k_cmp, v_cmp, k_sel, v_sel, k_win, v_win, gates, cmp):
    pe_k, pe_v, w1_k, w2_k, w1_v, w2_v = cmp
    B, T = q.shape[:2]
    kc = compress(k_cmp, pe_k, w1_k, w2_k)
    vc = compress(v_cmp, pe_v, w1_v, w2_v)
    cmp_end = jnp.arange(kc.shape[1]) * CMP_STRIDE + (CMP_LEN - 1)
    pad = ((0, 0), (WINDOW, 0), (0, 0), (0, 0))
    kw_pad = jnp.pad(k_win, pad)
    vw_pad = jnp.pad(v_win, pad)

    def one_block(i):
        s0 = i * Q_BLOCK
        take = lambda a, n: lax.dynamic_slice_in_dim(a, s0, n, axis=1)
        qpos = lax.dynamic_slice_in_dim(pos, s0, Q_BLOCK)
        kwpos = qpos[0] - WINDOW + jnp.arange(WINDOW + Q_BLOCK)
        return nsa_core(take(q, Q_BLOCK), take(q_rot, Q_BLOCK), qpos, kc, vc, cmp_end, k_sel, v_sel,
                        take(kw_pad, WINDOW + Q_BLOCK), take(vw_pad, WINDOW + Q_BLOCK), kwpos, take(gates, Q_BLOCK))

    out = lax.map(one_block, jnp.arange(T // Q_BLOCK))
    out = jnp.moveaxis(out, 0, 1).reshape(B, T, N_WIDTH)
    wp = min(WINDOW, T)
    return out, jnp.stack([k_win[:, -wp:], v_win[:, -wp:]], axis=2)


def nsa_sample(q, q_rot, pos, k_cmp, v_cmp, k_sel, v_sel, k_win, v_win, gates, cmp, past, win_buf):
    pe_k, pe_v, w1_k, w2_k, w1_v, w2_v = cmp
    T = q.shape[1]
    P = past.shape[1]
    WB = win_buf.shape[1]
    full = lambda i, new: jnp.concatenate([past[:, :, i].astype(new.dtype), new], axis=1)
    kc = compress(full(0, k_cmp), pe_k, w1_k, w2_k)
    vc = compress(full(1, v_cmp), pe_v, w1_v, w2_v)
    cmp_end = jnp.arange(kc.shape[1]) * CMP_STRIDE + (CMP_LEN - 1)
    kw = jnp.concatenate([win_buf[:, :, 0].astype(k_win.dtype), k_win], axis=1)
    vw = jnp.concatenate([win_buf[:, :, 1].astype(v_win.dtype), v_win], axis=1)
    kwpos = P - WB + jnp.arange(WB + T)
    out = nsa_core(q, q_rot, pos, kc, vc, cmp_end, full(2, k_sel), full(3, v_sel), kw, vw, kwpos, gates)
    return out, jnp.stack([kw[:, -WB:], vw[:, -WB:]], axis=2)


def layer_step(x, pos, W, l, conv_buf, C0, n0, m0, nsa_fn):
    B, T, _ = x.shape
    h = rmsnorm(x, W['norm1_g'][l])
    u, v, o, ig, fg, q, kv, ng, ga, gb = split_cols(h @ W['w_in'][l])
    h_a, conv_new, C, n, m = mlstm_branch(u, v, o, ig, fg, conv_buf, C0, n0, m0, W['conv_w'][l], W['conv_b'][l],
                                          W['w_mq'][l], W['w_mk'][l], W['b_gates'][l], W['mlstm_norm_g'][l])
    q = q.reshape(B, T, N_HEADS, HEAD_DIM)
    kv = kv.reshape(B, T, 6, N_KV, HEAD_DIM)
    k_cmp, v_cmp, v_sel, v_win = kv[:, :, 0], kv[:, :, 1], kv[:, :, 3], kv[:, :, 5]
    k_sel = rope_partial(kv[:, :, 2], pos)
    k_win = rope_partial(kv[:, :, 4], pos)
    q_rot = rope_partial(q, pos)
    gates = jax.nn.sigmoid(ng.astype(jnp.float32)).reshape(B, T, N_HEADS, 3)
    h_b, win_new = nsa_fn(q, q_rot, pos, k_cmp, v_cmp, k_sel, v_sel, k_win, v_win, gates)
    merged = jax.nn.sigmoid(ga) * (h_a @ W['w_branch_a'][l]) + jax.nn.sigmoid(gb) * (h_b @ W['w_branch_b'][l])
    x = x + merged.astype(x.dtype) @ W['w_out'][l]
    g_ff, u_ff = jnp.split(rmsnorm(x, W['norm2_g'][l]) @ W['w_ffn_up'][l], 2, axis=-1)
    x = x + (jax.nn.silu(g_ff) * u_ff) @ W['w_ffn_down'][l]
    kv_rows = jnp.stack([k_cmp, v_cmp, k_sel, v_sel], axis=2)
    return x, kv_rows, win_new, C, n, m, conv_new


def setup_inputs(seed: int = 0) -> dict:
    key = jax.random.key(seed)
    ks = jax.random.split(key, 40)
    nrm = lambda i, shape, s: s * jax.random.normal(ks[i], shape, dtype=jnp.float32)
    n_pages = PAST_LEN // PAGE_SIZE
    n_used = DEC_BATCH * n_pages
    n_pool = n_used + n_used // 4
    page_table = jax.random.permutation(ks[0], n_pool)[:n_used].reshape(DEC_BATCH, n_pages).astype(jnp.int32)
    wb = min(WINDOW, PAST_LEN)
    b_gates = jnp.concatenate([nrm(1, (DEPTH, M_HEADS), 0.1),
                               jnp.linspace(3.0, 6.0, M_HEADS, dtype=jnp.float32)[None, :] + nrm(2, (DEPTH, M_HEADS), 0.1)], axis=1)
    return {
        'x_prompt': nrm(3, (BATCH, SEQ, D_MODEL), 1.0),
        'x_sample': nrm(4, (DEC_BATCH, DEC_SEQ, D_MODEL), 1.0),
        'cache_kv_pages': nrm(5, (DEPTH, n_pool, PAGE_SIZE, 4, N_KV, HEAD_DIM), 1.0),
        'page_table': page_table,
        'cache_win': nrm(6, (DEPTH, DEC_BATCH, wb, 2, N_KV, HEAD_DIM), 1.0),
        'state_mlstm_C': nrm(7, (DEPTH, DEC_BATCH, M_HEADS, M_HEAD_DIM, M_HEAD_DIM), 0.5),
        'state_mlstm_n': nrm(8, (DEPTH, DEC_BATCH, M_HEADS, M_HEAD_DIM), 0.5),
        'state_mlstm_m': nrm(9, (DEPTH, DEC_BATCH, M_HEADS), 1.0),
        'state_mlstm_conv': nrm(10, (DEPTH, DEC_BATCH, M_CONV - 1, M_WIDTH), 1.0),
        'norm1_g': 1.0 + nrm(11, (DEPTH, D_MODEL), 0.01),
        'w_in': nrm(12, (DEPTH, D_MODEL, IN_WIDTH), D_MODEL ** -0.5),
        'b_gates': b_gates,
        'conv_w': nrm(13, (DEPTH, M_CONV, M_WIDTH), M_CONV ** -0.5),
        'conv_b': nrm(14, (DEPTH, M_WIDTH), 0.01),
        'w_mq': nrm(15, (DEPTH, M_HEADS, M_HEAD_DIM, M_HEAD_DIM), M_HEAD_DIM ** -0.5),
        'w_mk': nrm(16, (DEPTH, M_HEADS, M_HEAD_DIM, M_HEAD_DIM), M_HEAD_DIM ** -0.5),
        'mlstm_norm_g': 1.0 + nrm(17, (DEPTH, M_WIDTH), 0.01),
        'cmp_pe_k': nrm(18, (DEPTH, CMP_LEN, HEAD_DIM), 0.02),
        'cmp_pe_v': nrm(19, (DEPTH, CMP_LEN, HEAD_DIM), 0.02),
        'cmp_w1_k': nrm(20, (DEPTH, CMP_LEN, HEAD_DIM, CMP_HID), (CMP_LEN * HEAD_DIM) ** -0.5),
        'cmp_w2_k': nrm(21, (DEPTH, CMP_HID, HEAD_DIM), CMP_HID ** -0.5),
        'cmp_w1_v': nrm(22, (DEPTH, CMP_LEN, HEAD_DIM, CMP_HID), (CMP_LEN * HEAD_DIM) ** -0.5),
        'cmp_w2_v': nrm(23, (DEPTH, CMP_HID, HEAD_DIM), CMP_HID ** -0.5),
        'w_branch_a': nrm(24, (DEPTH, M_WIDTH, D_MODEL), M_WIDTH ** -0.5),
        'w_branch_b': nrm(25, (DEPTH, N_WIDTH, D_MODEL), N_WIDTH ** -0.5),
        'w_out': nrm(26, (DEPTH, D_MODEL, D_MODEL), D_MODEL ** -0.5),
        'norm2_g': 1.0 + nrm(27, (DEPTH, D_MODEL), 0.01),
        'w_ffn_up': nrm(28, (DEPTH, D_MODEL, 2 * D_FF), D_MODEL ** -0.5),
        'w_ffn_down': nrm(29, (DEPTH, D_FF, D_MODEL), D_FF ** -0.5),
        'final_norm_g': 1.0 + nrm(30, (D_MODEL,), 0.01),
    }


def reference(x_prompt, x_sample, cache_kv_pages, page_table, cache_win, state_mlstm_C, state_mlstm_n, state_mlstm_m,
              state_mlstm_conv, norm1_g, w_in, b_gates, conv_w, conv_b, w_mq, w_mk, mlstm_norm_g, cmp_pe_k, cmp_pe_v,
              cmp_w1_k, cmp_w2_k, cmp_w1_v, cmp_w2_v, w_branch_a, w_branch_b, w_out, norm2_g, w_ffn_up, w_ffn_down,
              final_norm_g):
    W = {'norm1_g': norm1_g, 'w_in': w_in, 'b_gates': b_gates, 'conv_w': conv_w, 'conv_b': conv_b, 'w_mq': w_mq,
         'w_mk': w_mk, 'mlstm_norm_g': mlstm_norm_g, 'w_branch_a': w_branch_a, 'w_branch_b': w_branch_b,
         'w_out': w_out, 'norm2_g': norm2_g, 'w_ffn_up': w_ffn_up, 'w_ffn_down': w_ffn_down}
    Bp, Tp, _ = x_prompt.shape
    Bs, Ts, _ = x_sample.shape
    n_pages = page_table.shape[1]
    past_len = n_pages * cache_kv_pages.shape[2]
    pos_p = jnp.arange(Tp)
    pos_s = past_len + jnp.arange(Ts)

    xp = x_prompt
    xs = x_sample
    p_kv, p_win, p_C, p_n, p_m, p_conv = [], [], [], [], [], []
    s_kv, s_win, s_C, s_n, s_m, s_conv = [], [], [], [], [], []
    for l in range(DEPTH):
        cmp = (cmp_pe_k[l], cmp_pe_v[l], cmp_w1_k[l], cmp_w2_k[l], cmp_w1_v[l], cmp_w2_v[l])
        xp, kv_r, win_r, C, n, m, cv = layer_step(
            xp, pos_p, W, l,
            jnp.zeros((Bp, M_CONV - 1, M_WIDTH), xp.dtype),
            jnp.zeros((Bp, M_HEADS, M_HEAD_DIM, M_HEAD_DIM), jnp.float32),
            jnp.zeros((Bp, M_HEADS, M_HEAD_DIM), jnp.float32),
            jnp.zeros((Bp, M_HEADS), jnp.float32),
            functools.partial(nsa_prompt, cmp=cmp))
        p_kv.append(kv_r); p_win.append(win_r); p_C.append(C); p_n.append(n); p_m.append(m); p_conv.append(cv)
        past = cache_kv_pages[l][page_table].reshape(Bs, past_len, 4, N_KV, HEAD_DIM)
        xs, kv_r, win_r, C, n, m, cv = layer_step(
            xs, pos_s, W, l, state_mlstm_conv[l], state_mlstm_C[l], state_mlstm_n[l], state_mlstm_m[l],
            functools.partial(nsa_sample, cmp=cmp, past=past, win_buf=cache_win[l]))
        s_kv.append(kv_r); s_win.append(win_r); s_C.append(C); s_n.append(n); s_m.append(m); s_conv.append(cv)

    y_prompt = rmsnorm(xp, final_norm_g)
    y_sample = rmsnorm(xs, final_norm_g)
    new_p_kv = jnp.stack(p_kv)
    new_p_win = jnp.stack(p_win)
    new_p_C = jnp.stack(p_C)
    new_p_n = jnp.stack(p_n)
    new_p_m = jnp.stack(p_m)
    new_p_conv = jnp.stack(p_conv)
    new_s_kv = jnp.stack(s_kv)
    new_s_win = jnp.stack(s_win)
    new_s_C = jnp.stack(s_C)
    new_s_n = jnp.stack(s_n)
    new_s_m = jnp.stack(s_m)
    new_s_conv = jnp.stack(s_conv)
    return (y_prompt, y_sample, new_p_kv, new_p_win, new_p_C, new_p_n, new_p_m, new_p_conv,
            new_s_kv, new_s_win, new_s_C, new_s_n, new_s_m, new_s_conv)
```

```cpp
#ifdef CPU_TEST
#include "cpu_shim.h"
#else
#include <hip/hip_runtime.h>
#endif
#include <stdint.h>
#include <stddef.h>

#ifndef CFG_BATCH
#define CFG_BATCH 4
#define CFG_SEQ 4096
#define CFG_DEC_BATCH 128
#define CFG_PAST_LEN 2048
#endif

namespace {
constexpr int BATCH = CFG_BATCH, SEQ = CFG_SEQ, DEC_BATCH = CFG_DEC_BATCH, PAST_LEN = CFG_PAST_LEN;
constexpr int D = 1024, DEPTH = 2, DEC_SEQ = 4, PAGE = 128;
constexpr int MH = 4, MW = 512, MHD = 128;
constexpr int HD = 64, NH = 8, NKV = 2;
constexpr int CHID = 128, SELB = 64, SELTOP = 16, WIN = 512;
constexpr int DFF = 2816, INW = 4896;
constexpr float EPS = 1e-6f, NEG = -1e30f, TINY = 1e-30f;
constexpr int NPT = BATCH * SEQ, NST = DEC_BATCH * DEC_SEQ, NTOK = NPT + NST, NSEQ = BATCH + DEC_BATCH;
constexpr int N_PAGES = PAST_LEN / PAGE, N_USED = DEC_BATCH * N_PAGES, N_POOL = N_USED + N_USED / 4;
constexpr int WB = (WIN < PAST_LEN ? WIN : PAST_LEN), WP = (WIN < SEQ ? WIN : SEQ);
constexpr int NCP = SEQ / 16 - 1, NCS = (PAST_LEN + DEC_SEQ) / 16 - 1, NCMAX = (NCP > NCS ? NCP : NCS);
constexpr int NBP = (SEQ + 63) / 64, NBS = (PAST_LEN + DEC_SEQ + 63) / 64;
constexpr int ZU = 0, ZV = 512, ZO = 1024, ZIG = 1536, ZFG = 1540, ZQ = 1544, ZKV = 2056, ZNG = 2824, ZGA = 2848, ZGB = 3872;
constexpr size_t O_YP = 0;
constexpr size_t O_YS = O_YP + (size_t)NPT * D;
constexpr size_t O_PKV = O_YS + (size_t)NST * D;
constexpr size_t O_PWIN = O_PKV + (size_t)DEPTH * BATCH * SEQ * 512;
constexpr size_t O_PC = O_PWIN + (size_t)DEPTH * BATCH * WP * 256;
constexpr size_t O_PN = O_PC + (size_t)DEPTH * BATCH * MH * MHD * MHD;
constexpr size_t O_PM = O_PN + (size_t)DEPTH * BATCH * MH * MHD;
constexpr size_t O_PCONV = O_PM + (size_t)DEPTH * BATCH * MH;
constexpr size_t O_SKV = O_PCONV + (size_t)DEPTH * BATCH * 3 * MW;
constexpr size_t O_SWIN = O_SKV + (size_t)DEPTH * DEC_BATCH * DEC_SEQ * 512;
constexpr size_t O_SC = O_SWIN + (size_t)DEPTH * DEC_BATCH * WB * 256;
constexpr size_t O_SN = O_SC + (size_t)DEPTH * DEC_BATCH * MH * MHD * MHD;
constexpr size_t O_SM = O_SN + (size_t)DEPTH * DEC_BATCH * MH * MHD;
constexpr size_t O_SCONV = O_SM + (size_t)DEPTH * DEC_BATCH * MH;
constexpr size_t O_END = O_SCONV + (size_t)DEPTH * DEC_BATCH * 3 * MW;

struct P {
    const float *x_prompt, *x_sample, *cache_kv;
    const int* page_table;
    const float *cache_win, *st_C, *st_n, *st_m, *st_conv, *norm1_g, *w_in, *b_gates, *conv_w, *conv_b, *w_mq, *w_mk, *mnorm_g,
        *pe_k, *pe_v, *w1_k, *w2_k, *w1_v, *w2_v, *w_a, *w_b, *w_out, *norm2_g, *w_up, *w_down, *final_g;
    float* out;
    float *X, *H, *Z, *RSTD, *KW, *QR, *CC, *IG, *LF, *QM, *KM, *NUMP, *MT, *HA, *HB, *HID, *KC, *VC, *PC, *OC, *OS, *OW, *SCORE,
        *PS, *PW, *TA, *TB, *MG, *GU, *ACT;
    int* SEL;
};

struct Tok { int seq, t, pos, b; bool sample; };
__device__ __forceinline__ Tok tokinfo(int tok) {
    Tok r;
    if (tok < NPT) { r.b = tok / SEQ; r.t = tok % SEQ; r.seq = r.b; r.pos = r.t; r.sample = false; }
    else { int q = tok - NPT; r.b = q / DEC_SEQ; r.t = q % DEC_SEQ; r.seq = BATCH + r.b; r.pos = PAST_LEN + r.t; r.sample = true; }
    return r;
}
__device__ __forceinline__ int seq_row0(int seq) { return seq < BATCH ? seq * SEQ : NPT + (seq - BATCH) * DEC_SEQ; }
__device__ __forceinline__ int seq_len(int seq) { return seq < BATCH ? SEQ : DEC_SEQ; }
__device__ __forceinline__ int seq_nc(int seq) { return seq < BATCH ? NCP : NCS; }
__device__ __forceinline__ size_t kc_base(int seq) { return seq < BATCH ? (size_t)seq * NCP : (size_t)BATCH * NCP + (size_t)(seq - BATCH) * NCS; }
constexpr size_t KC_ROWS = (size_t)BATCH * NCP + (size_t)DEC_BATCH * NCS;

__device__ __forceinline__ const float* kvrow(const P& p, int l, int seq, int pos, int j, int g) {
    if (seq < BATCH) return p.out + O_PKV + ((((size_t)l * BATCH + seq) * SEQ + pos) * 4 + j) * 128 + g * 64;
    int b = seq - BATCH;
    if (pos < PAST_LEN) {
        int pg = p.page_table[b * N_PAGES + pos / PAGE];
        return p.cache_kv + ((((size_t)l * N_POOL + pg) * PAGE + pos % PAGE) * 4 + j) * 128 + g * 64;
    }
    return p.out + O_SKV + ((((size_t)l * DEC_BATCH + b) * DEC_SEQ + (pos - PAST_LEN)) * 4 + j) * 128 + g * 64;
}
__device__ __forceinline__ const float* winrow(const P& p, int l, int seq, int pos, int kv, int g) {
    if (seq < BATCH) return p.KW + ((size_t)(seq * SEQ + pos) * 2 + kv) * 128 + g * 64;
    int b = seq - BATCH;
    if (pos < PAST_LEN) return p.cache_win + ((((size_t)l * DEC_BATCH + b) * WB + (pos - (PAST_LEN - WB))) * 2 + kv) * 128 + g * 64;
    return p.KW + ((size_t)(NPT + b * DEC_SEQ + (pos - PAST_LEN)) * 2 + kv) * 128 + g * 64;
}

__device__ __forceinline__ float sigmoidf_(float x) { return 1.f / (1.f + expf(-x)); }
__device__ __forceinline__ float siluf_(float x) { return x / (1.f + expf(-x)); }
__device__ __forceinline__ float log_sigmoidf_(float x) { return fminf(x, 0.f) - log1pf(expf(-fabsf(x))); }
__device__ __forceinline__ float geluf_(float x) { return 0.5f * x * (1.f + tanhf(0.7978845608028654f * (x + 0.044715f * x * x * x))); }
__device__ __forceinline__ float rope_inv(int i) { return powf(500000.0f, -(float)i / 8.0f); }
__device__ __forceinline__ float rope_elem(const float* x, int d, int pos) {
    if (d >= 16) return x[d];
    int i = d & 7;
    float ang = (float)pos * rope_inv(i);
    float c = cosf(ang), s = sinf(ang);
    return d < 8 ? x[d] * c - x[d + 8] * s : x[d] * c + x[d - 8] * s;
}

#define PLOOP(i, n) for (long i = gtid; i < (long)(n); i += gsz)

__device__ __forceinline__ void gemm_items(const float* A, int lda, const float* B, int ldb, float* C, int ldc, int M, int N, int K,
                                           int accumulate, long gtid, long gsz) {
    const int ng = N / 4;
    const long items = (long)(M / 4) * ng;
    for (long it = gtid; it < items; it += gsz) {
        const int mg = (int)(it / ng), n4 = (int)(it % ng) * 4;
        float acc[4][4];
#pragma unroll
        for (int i = 0; i < 4; ++i)
#pragma unroll
            for (int j = 0; j < 4; ++j) acc[i][j] = 0.f;
        const float* a0 = A + (size_t)(mg * 4) * lda;
        const float* b0 = B + n4;
        for (int k = 0; k < K; ++k) {
            const float4 b = *(const float4*)(b0 + (size_t)k * ldb);
#pragma unroll
            for (int i = 0; i < 4; ++i) {
                const float a = a0[(size_t)i * lda + k];
                acc[i][0] += a * b.x; acc[i][1] += a * b.y; acc[i][2] += a * b.z; acc[i][3] += a * b.w;
            }
        }
#pragma unroll
        for (int i = 0; i < 4; ++i) {
            float* c = C + (size_t)(mg * 4 + i) * ldc + n4;
#pragma unroll
            for (int j = 0; j < 4; ++j) c[j] = accumulate ? c[j] + acc[i][j] : acc[i][j];
        }
    }
}

__device__ void ph_load_x(const P& p, int l, long gtid, long gsz) {
    PLOOP(i, (size_t)NTOK * D) p.X[i] = i < (long)NPT * D ? p.x_prompt[i] : p.x_sample[i - (long)NPT * D];
}
__device__ void ph_rstd(const P& p, int l, long gtid, long gsz) {
    PLOOP(tok, NTOK) {
        const float* x = p.X + (size_t)tok * D;
        float ss = 0.f;
        for (int c = 0; c < D; ++c) ss += x[c] * x[c];
        p.RSTD[tok] = 1.f / sqrtf(ss / D + EPS);
    }
}
__device__ void ph_norm1(const P& p, int l, long gtid, long gsz) {
    PLOOP(i, (size_t)NTOK * D) { int tok = (int)(i / D), c = (int)(i % D); p.H[i] = p.X[i] * p.RSTD[tok] * p.norm1_g[l * D + c]; }
}
__device__ void ph_gemm_in(const P& p, int l, long gtid, long gsz) {
    gemm_items(p.H, D, p.w_in + (size_t)l * D * INW, INW, p.Z, INW, NTOK, INW, D, 0, gtid, gsz);
}
__device__ void ph_kv(const P& p, int l, long gtid, long gsz) {
    PLOOP(i, (size_t)NTOK * 768) {
        int tok = (int)(i / 768), c = (int)(i % 768);
        int j = c / 128, g = (c % 128) / 64, d = c % 64;
        Tok ti = tokinfo(tok);
        const float* x = p.Z + (size_t)tok * INW + ZKV + j * 128 + g * 64;
        float v = (j == 2 || j == 4) ? rope_elem(x, d, ti.pos) : x[d];
        if (j < 4) {
            size_t o = ti.sample ? O_SKV + ((((size_t)l * DEC_BATCH + ti.b) * DEC_SEQ + ti.t) * 4 + j) * 128 + g * 64 + d
                                 : O_PKV + ((((size_t)l * BATCH + ti.b) * SEQ + ti.t) * 4 + j) * 128 + g * 64 + d;
            p.out[o] = v;
        } else {
            int kv = j - 4;
            p.KW[((size_t)tok * 2 + kv) * 128 + g * 64 + d] = v;
            if (ti.sample) {
                p.out[O_SWIN + ((((size_t)l * DEC_BATCH + ti.b) * WB + (WB - DEC_SEQ + ti.t)) * 2 + kv) * 128 + g * 64 + d] = v;
            } else if (ti.t >= SEQ - WP) {
                p.out[O_PWIN + ((((size_t)l * BATCH + ti.b) * WP + (ti.t - (SEQ - WP))) * 2 + kv) * 128 + g * 64 + d] = v;
            }
        }
    }
}
__device__ void ph_swin_copy(const P& p, int l, long gtid, long gsz) {
    PLOOP(i, (size_t)DEC_BATCH * (WB - DEC_SEQ) * 256) {
        int b = (int)(i / ((WB - DEC_SEQ) * 256)); int r = (int)(i % ((WB - DEC_SEQ) * 256));
        p.out[O_SWIN + ((size_t)l * DEC_BATCH + b) * WB * 256 + r] = p.cache_win[((size_t)l * DEC_BATCH + b) * WB * 256 + DEC_SEQ * 256 + r];
    }
}
__device__ void ph_qrot(const P& p, int l, long gtid, long gsz) {
    PLOOP(i, (size_t)NTOK * 512) {
        int tok = (int)(i / 512), c = (int)(i % 512); int h = c / 64, d = c % 64;
        Tok ti = tokinfo(tok);
        p.QR[i] = rope_elem(p.Z + (size_t)tok * INW + ZQ + h * 64, d, ti.pos);
    }
}
__device__ __forceinline__ float conv_u(const P& p, int l, const Tok& ti, int tok, int dt, int c) {
    int t = ti.t + dt;
    if (t >= 0) return p.Z[(size_t)(tok + dt) * INW + ZU + c];
    if (!ti.sample) return 0.f;
    return p.st_conv[(((size_t)l * DEC_BATCH + ti.b) * 3 + (3 + t)) * MW + c];
}
__device__ void ph_conv(const P& p, int l, long gtid, long gsz) {
    PLOOP(i, (size_t)NTOK * 512) {
        int tok = (int)(i / 512), c = (int)(i % 512);
        Tok ti = tokinfo(tok);
        float y = p.conv_b[l * MW + c];
#pragma unroll
        for (int j = 0; j < 4; ++j) y += conv_u(p, l, ti, tok, j - 3, c) * p.conv_w[((size_t)l * 4 + j) * MW + c];
        p.CC[i] = siluf_(y);
    }
    PLOOP(i, (size_t)NSEQ * 3 * 512) {
        int seq = (int)(i / 1536), r = (int)((i % 1536) / 512), c = (int)(i % 512);
        int T = seq_len(seq), row0 = seq_row0(seq);
        Tok ti = tokinfo(row0 + T - 1);
        float v = conv_u(p, l, ti, row0 + T - 1, r - 2, c);
        if (seq < BATCH) p.out[O_PCONV + (((size_t)l * BATCH + seq) * 3 + r) * MW + c] = v;
        else p.out[O_SCONV + (((size_t)l * DEC_BATCH + (seq - BATCH)) * 3 + r) * MW + c] = v;
    }
    PLOOP(i, (size_t)NTOK * 4) {
        int tok = (int)(i / 4), h = (int)(i % 4);
        p.IG[i] = p.Z[(size_t)tok * INW + ZIG + h] + p.b_gates[l * 8 + h];
        p.LF[i] = log_sigmoidf_(p.Z[(size_t)tok * INW + ZFG + h] + p.b_gates[l * 8 + 4 + h]);
    }
}
__device__ void ph_mqk(const P& p, int l, long gtid, long gsz) {
    for (int h = 0; h < MH; ++h) {
        gemm_items(p.CC + h * MHD, MW, p.w_mq + ((size_t)l * MH + h) * MHD * MHD, MHD, p.QM + h * MHD, MW, NTOK, MHD, MHD, 0, gtid, gsz);
        gemm_items(p.CC + h * MHD, MW, p.w_mk + ((size_t)l * MH + h) * MHD * MHD, MHD, p.KM + h * MHD, MW, NTOK, MHD, MHD, 0, gtid, gsz);
    }
}
__device__ void ph_mlstm(const P& p, int l, long gtid, long gsz) {
    PLOOP(it, (size_t)NSEQ * MH * 4 * 129) {
        int e = (int)(it % 129); int part = (int)((it / 129) % 4); int h = (int)((it / (129 * 4)) % MH); int seq = (int)(it / (129 * 4 * MH));
        int T = seq_len(seq), row0 = seq_row0(seq);
        bool sample = seq >= BATCH; int b = sample ? seq - BATCH : seq;
        float C[32]; float m = 0.f;
#pragma unroll
        for (int i = 0; i < 32; ++i) C[i] = 0.f;
        if (sample) {
            m = p.st_m[((size_t)l * DEC_BATCH + b) * MH + h];
#pragma unroll
            for (int i = 0; i < 32; ++i) {
                int d = part * 32 + i;
                C[i] = e < 128 ? p.st_C[((((size_t)l * DEC_BATCH + b) * MH + h) * MHD + d) * MHD + e] : p.st_n[(((size_t)l * DEC_BATCH + b) * MH + h) * MHD + d];
            }
        }
        for (int t = 0; t < T; ++t) {
            int tok = row0 + t;
            float ig = p.IG[tok * 4 + h], lf = p.LF[tok * 4 + h];
            float mn = fmaxf(lf + m, ig);
            float dec = expf(lf + m - mn), w = expf(ig - mn);
            m = mn;
            float ve = e < 128 ? p.Z[(size_t)tok * INW + ZV + h * MHD + e] : 1.f;
            float wv = w * ve, acc = 0.f;
            const float* kk = p.KM + (size_t)tok * MW + h * MHD + part * 32;
            const float* qq = p.QM + (size_t)tok * MW + h * MHD + part * 32;
#pragma unroll
            for (int i = 0; i < 32; ++i) {
                C[i] = dec * C[i] + wv * (kk[i] * 0.08838834764831845f);
                acc += qq[i] * C[i];
            }
            p.NUMP[(((size_t)tok * MH + h) * 4 + part) * 129 + e] = acc;
            if (e == 0 && part == 0) p.MT[tok * 4 + h] = m;
        }
        size_t oC = sample ? O_SC + (((size_t)l * DEC_BATCH + b) * MH + h) * MHD * MHD : O_PC + (((size_t)l * BATCH + b) * MH + h) * MHD * MHD;
        size_t oN = sample ? O_SN + (((size_t)l * DEC_BATCH + b) * MH + h) * MHD : O_PN + (((size_t)l * BATCH + b) * MH + h) * MHD;
        size_t oM = sample ? O_SM + ((size_t)l * DEC_BATCH + b) * MH + h : O_PM + ((size_t)l * BATCH + b) * MH + h;
#pragma unroll
        for (int i = 0; i < 32; ++i) {
            int d = part * 32 + i;
            if (e < 128) p.out[oC + (size_t)d * MHD + e] = C[i]; else p.out[oN + d] = C[i];
        }
        if (e == 0 && part == 0) p.out[oM] = m;
    }
}
__device__ void ph_ha(const P& p, int l, long gtid, long gsz) {
    PLOOP(it, (size_t)NTOK * MH) {
        int tok = (int)(it / MH), h = (int)(it % MH);
        const float* np_ = p.NUMP + (size_t)it * 4 * 129;
        float den = np_[128] + np_[129 + 128] + np_[2 * 129 + 128] + np_[3 * 129 + 128];
        float dn = fmaxf(fabsf(den), expf(-p.MT[it]));
        float ss = 0.f;
        for (int e = 0; e < MHD; ++e) { float hv = (np_[e] + np_[129 + e] + np_[2 * 129 + e] + np_[3 * 129 + e]) / dn; ss += hv * hv; }
        float r = 1.f / sqrtf(ss / MHD + EPS);
        for (int e = 0; e < MHD; ++e) {
            float hv = (np_[e] + np_[129 + e] + np_[2 * 129 + e] + np_[3 * 129 + e]) / dn;
            float o = p.Z[(size_t)tok * INW + ZO + h * MHD + e];
            p.HA[(size_t)tok * MW + h * MHD + e] = hv * r * p.mnorm_g[l * MW + h * MHD + e] * sigmoidf_(o);
        }
    }
}
__device__ __forceinline__ void cmp_item(long item, int& seq, int& n, int& g, int& kind) {
    kind = (int)(item & 1); g = (int)((item >> 1) & 1); long r = item >> 2;
    if (r < (long)BATCH * NCP) { seq = (int)(r / NCP); n = (int)(r % NCP); }
    else { r -= (long)BATCH * NCP; seq = BATCH + (int)(r / NCS); n = (int)(r % NCS); }
}
__device__ void ph_cmp_hid(const P& p, int l, long gtid, long gsz) {
    PLOOP(i, KC_ROWS * 4 * CHID) {
        long item = i / CHID; int e = (int)(i % CHID);
        int seq, n, g, kind; cmp_item(item, seq, n, g, kind);
        const float* pe = (kind ? p.pe_v : p.pe_k) + (size_t)l * 32 * 64;
        const float* w1 = (kind ? p.w1_v : p.w1_k) + (size_t)l * 32 * 64 * CHID;
        float acc = 0.f;
        for (int r = 0; r < 32; ++r) {
            const float* row = kvrow(p, l, seq, n * 16 + r, kind, g);
            for (int d = 0; d < 64; ++d) acc += (row[d] + pe[r * 64 + d]) * w1[((size_t)r * 64 + d) * CHID + e];
        }
        p.HID[i] = geluf_(acc);
    }
}
__device__ void ph_cmp_out(const P& p, int l, long gtid, long gsz) {
    PLOOP(i, KC_ROWS * 4 * 64) {
        long item = i / 64; int f = (int)(i % 64);
        int seq, n, g, kind; cmp_item(item, seq, n, g, kind);
        const float* w2 = (kind ? p.w2_v : p.w2_k) + (size_t)l * CHID * 64;
        float acc = 0.f;
        for (int e = 0; e < CHID; ++e) acc += p.HID[item * CHID + e] * w2[e * 64 + f];
        (kind ? p.VC : p.KC)[((kc_base(seq) + n) * 2 + g) * 64 + f] = acc;
    }
}
__device__ void ph_sc(const P& p, int l, long gtid, long gsz) {
    PLOOP(i, (size_t)NTOK * NH * NCMAX) {
        int n = (int)(i % NCMAX); int h = (int)((i / NCMAX) % NH); int tok = (int)(i / ((long)NCMAX * NH));
        Tok ti = tokinfo(tok);
        int nc = seq_nc(ti.seq);
        float s = NEG;
        if (n < nc && n * 16 + 31 <= ti.pos) {
            const float* q = p.Z + (size_t)tok * INW + ZQ + h * 64;
            const float* k = p.KC + ((kc_base(ti.seq) + n) * 2 + h / 4) * 64;
            float acc = 0.f;
            for (int d = 0; d < 64; ++d) acc += q[d] * k[d];
            s = acc * 0.125f;
        }
        p.PC[i] = s;
    }
}
__device__ __forceinline__ void softmax_row(float* s, int len) {
    float mx = NEG;
    for (int i = 0; i < len; ++i) mx = fmaxf(mx, s[i]);
    float sum = 0.f;
    for (int i = 0; i < len; ++i) { if (s[i] > 0.5f * NEG) sum += expf(s[i] - mx); }
    float inv = 1.f / fmaxf(sum, TINY);
    for (int i = 0; i < len; ++i) s[i] = (s[i] > 0.5f * NEG) ? expf(s[i] - mx) * inv : 0.f;
}
__device__ void ph_sc_softmax(const P& p, int l, long gtid, long gsz) {
    PLOOP(i, (size_t)NTOK * NH) softmax_row(p.PC + (size_t)i * NCMAX, NCMAX);
}
__device__ void ph_oc(const P& p, int l, long gtid, long gsz) {
    PLOOP(i, (size_t)NTOK * 512) {
        int tok = (int)(i / 512), h = (int)((i % 512) / 64), d = (int)(i % 64);
        Tok ti = tokinfo(tok); int nc = seq_nc(ti.seq);
        const float* pc = p.PC + ((size_t)tok * NH + h) * NCMAX;
        float acc = 0.f;
        for (int n = 0; n < nc; ++n) acc += pc[n] * p.VC[((kc_base(ti.seq) + n) * 2 + h / 4) * 64 + d];
        p.OC[i] = acc;
    }
}
__device__ void ph_select(const P& p, int l, long gtid, long gsz) {
    PLOOP(i, (size_t)NTOK * NKV) {
        int tok = (int)(i / NKV), g = (int)(i % NKV);
        Tok ti = tokinfo(tok);
        int nc = seq_nc(ti.seq), nblk = ti.sample ? NBS : NBP;
        int cur = ti.pos / SELB;
        float* sc = p.SCORE + (size_t)i * 64;
        for (int j = 0; j < nblk; ++j) {
            float imp = 0.f;
            for (int n = 4 * j - 1; n <= 4 * j + 3; ++n) {
                if (n < 0 || n >= nc) continue;
                int lo = n * 16 > j * 64 ? n * 16 : j * 64;
                int hi = n * 16 + 32 < j * 64 + 64 ? n * 16 + 32 : j * 64 + 64;
                int ov = hi - lo; if (ov <= 0) continue;
                float w = (float)ov / 32.f;
                float sum = 0.f;
                for (int r = 0; r < 4; ++r) sum += p.PC[((size_t)tok * NH + g * 4 + r) * NCMAX + n];
                imp += sum * w;
            }
            bool forced = (j == 0) || (j == cur) || (j == cur - 1);
            sc[j] = j <= cur ? (forced ? 1e9f : imp) : -1.f;
        }
        int nsel = nblk < SELTOP ? nblk : SELTOP;
        for (int k = 0; k < nsel; ++k) {
            int best = 0; float bv = -3e38f;
            for (int j = 0; j < nblk; ++j) if (sc[j] > bv) { bv = sc[j]; best = j; }
            p.SEL[(size_t)i * SELTOP + k] = best;
            sc[best] = -3.4e38f;
        }
    }
}
__device__ void ph_ss(const P& p, int l, long gtid, long gsz) {
    PLOOP(i, (size_t)NTOK * NH * 1024) {
        int idx = (int)(i % 1024); int h = (int)((i / 1024) % NH); int tok = (int)(i / (1024 * NH));
        Tok ti = tokinfo(tok);
        int nblk = ti.sample ? NBS : NBP; int nsel = nblk < SELTOP ? nblk : SELTOP; int L = ti.sample ? PAST_LEN + DEC_SEQ : SEQ;
        int k = idx / 64, ii = idx % 64; int g = h / 4;
        float s = NEG;
        if (k < nsel) {
            int tk = p.SEL[((size_t)tok * NKV + g) * SELTOP + k] * 64 + ii;
            if (tk <= ti.pos) {
                int kp = tk < L - 1 ? tk : L - 1;
                const float* q = p.QR + (size_t)tok * 512 + h * 64;
                const float* kr = kvrow(p, l, ti.seq, kp, 2, g);
                float acc = 0.f;
                for (int d = 0; d < 64; ++d) acc += q[d] * kr[d];
                s = acc * 0.125f;
            }
        }
        p.PS[i] = s;
    }
}
__device__ void ph_ss_softmax(const P& p, int l, long gtid, long gsz) {
    PLOOP(i, (size_t)NTOK * NH) softmax_row(p.PS + (size_t)i * 1024, 1024);
}
__device__ void ph_os(const P& p, int l, long gtid, long gsz) {
    PLOOP(i, (size_t)NTOK * 512) {
        int tok = (int)(i / 512), h = (int)((i % 512) / 64), d = (int)(i % 64);
        Tok ti = tokinfo(tok); int g = h / 4;
        int nblk = ti.sample ? NBS : NBP; int nsel = nblk < SELTOP ? nblk : SELTOP; int L = ti.sample ? PAST_LEN + DEC_SEQ : SEQ;
        const float* ps = p.PS + ((size_t)tok * NH + h) * 1024;
        float acc = 0.f;
        for (int k = 0; k < nsel; ++k) {
            int blk = p.SEL[((size_t)tok * NKV + g) * SELTOP + k];
            for (int ii = 0; ii < 64; ++ii) {
                float w = ps[k * 64 + ii];
                if (w != 0.f) { int tk = blk * 64 + ii; int kp = tk < L - 1 ? tk : L - 1; acc += w * kvrow(p, l, ti.seq, kp, 3, g)[d]; }
            }
        }
        p.OS[i] = acc;
    }
}
__device__ void ph_sw(const P& p, int l, long gtid, long gsz) {
    PLOOP(i, (size_t)NTOK * NH * 512) {
        int w = (int)(i % 512); int h = (int)((i / 512) % NH); int tok = (int)(i / (512 * NH));
        Tok ti = tokinfo(tok);
        int kp = ti.pos - 511 + w;
        float s = NEG;
        if (kp >= 0) {
            const float* q = p.QR + (size_t)tok * 512 + h * 64;
            const float* kr = winrow(p, l, ti.seq, kp, 0, h / 4);
            float acc = 0.f;
            for (int d = 0; d < 64; ++d) acc += q[d] * kr[d];
            s = acc * 0.125f;
        }
        p.PW[i] = s;
    }
}
__device__ void ph_sw_softmax(const P& p, int l, long gtid, long gsz) {
    PLOOP(i, (size_t)NTOK * NH) softmax_row(p.PW + (size_t)i * 512, 512);
}
__device__ void ph_ow(const P& p, int l, long gtid, long gsz) {
    PLOOP(i, (size_t)NTOK * 512) {
        int tok = (int)(i / 512), h = (int)((i % 512) / 64), d = (int)(i % 64);
        Tok ti = tokinfo(tok);
        const float* pw = p.PW + ((size_t)tok * NH + h) * 512;
        float acc = 0.f;
        for (int w = 0; w < 512; ++w) {
            int kp = ti.pos - 511 + w;
            if (kp >= 0) acc += pw[w] * winrow(p, l, ti.seq, kp, 1, h / 4)[d];
        }
        p.OW[i] = acc;
    }
}
__device__ void ph_hb(const P& p, int l, long gtid, long gsz) {
    PLOOP(i, (size_t)NTOK * 512) {
        int tok = (int)(i / 512), h = (int)((i % 512) / 64);
        const float* ng = p.Z + (size_t)tok * INW + ZNG + h * 3;
        p.HB[i] = sigmoidf_(ng[0]) * p.OC[i] + sigmoidf_(ng[1]) * p.OS[i] + sigmoidf_(ng[2]) * p.OW[i];
    }
}
__device__ void ph_branch(const P& p, int l, long gtid, long gsz) {
    gemm_items(p.HA, MW, p.w_a + (size_t)l * MW * D, D, p.TA, D, NTOK, D, MW, 0, gtid, gsz);
    gemm_items(p.HB, 512, p.w_b + (size_t)l * 512 * D, D, p.TB, D, NTOK, D, 512, 0, gtid, gsz);
}
__device__ void ph_merge(const P& p, int l, long gtid, long gsz) {
    PLOOP(i, (size_t)NTOK * D) {
        int tok = (int)(i / D), c = (int)(i % D);
        const float* z = p.Z + (size_t)tok * INW;
        p.MG[i] = sigmoidf_(z[ZGA + c]) * p.TA[i] + sigmoidf_(z[ZGB + c]) * p.TB[i];
    }
}
__device__ void ph_out(const P& p, int l, long gtid, long gsz) {
    gemm_items(p.MG, D, p.w_out + (size_t)l * D * D, D, p.X, D, NTOK, D, D, 1, gtid, gsz);
}
__device__ void ph_norm2(const P& p, int l, long gtid, long gsz) {
    PLOOP(i, (size_t)NTOK * D) { int tok = (int)(i / D), c = (int)(i % D); p.H[i] = p.X[i] * p.RSTD[tok] * p.norm2_g[l * D + c]; }
}
__device__ void ph_up(const P& p, int l, long gtid, long gsz) {
    gemm_items(p.H, D, p.w_up + (size_t)l * D * 2 * DFF, 2 * DFF, p.GU, 2 * DFF, NTOK, 2 * DFF, D, 0, gtid, gsz);
}
__device__ void ph_act(const P& p, int l, long gtid, long gsz) {
    PLOOP(i, (size_t)NTOK * DFF) { int tok = (int)(i / DFF), c = (int)(i % DFF); const float* gu = p.GU + (size_t)tok * 2 * DFF; p.ACT[i] = siluf_(gu[c]) * gu[DFF + c]; }
}
__device__ void ph_down(const P& p, int l, long gtid, long gsz) {
    gemm_items(p.ACT, DFF, p.w_down + (size_t)l * DFF * D, D, p.X, D, NTOK, D, DFF, 1, gtid, gsz);
}
__device__ void ph_final(const P& p, int l, long gtid, long gsz) {
    PLOOP(i, (size_t)NTOK * D) { int tok = (int)(i / D), c = (int)(i % D); p.out[i] = p.X[i] * p.RSTD[tok] * p.final_g[c]; }
}

typedef void (*phase_fn)(const P&, int, long, long);
}

#define PHASES(X) \
    X(ph_rstd) X(ph_norm1) X(ph_gemm_in) X(ph_kv) X(ph_swin_copy) X(ph_qrot) X(ph_conv) X(ph_mqk) X(ph_mlstm) X(ph_ha) \
    X(ph_cmp_hid) X(ph_cmp_out) X(ph_sc) X(ph_sc_softmax) X(ph_oc) X(ph_select) X(ph_ss) X(ph_ss_softmax) X(ph_os) \
    X(ph_sw) X(ph_sw_softmax) X(ph_ow) X(ph_hb) X(ph_branch) X(ph_merge) X(ph_out) X(ph_rstd2) X(ph_norm2) X(ph_up) X(ph_act) X(ph_down)

namespace { __device__ void ph_rstd2(const P& p, int l, long gtid, long gsz) { ph_rstd(p, l, gtid, gsz); } }

#ifndef CPU_TEST
#define DEFK(name) __global__ void __launch_bounds__(256) k_##name(P p, int l) { name(p, l, (long)blockIdx.x * 256 + threadIdx.x, (long)gridDim.x * 256); }
DEFK(ph_load_x) DEFK(ph_final)
PHASES(DEFK)
#define RUN(name, l) k_##name<<<2048, 256, 0, stream>>>(p, l);
#else
#define RUN(name, l) cpu_run(name, p, l);
static void cpu_run(phase_fn f, const P& p, int l) {
    const long gsz = 1 << 14;
#pragma omp parallel for schedule(dynamic, 16)
    for (long g = 0; g < gsz; ++g) f(p, l, g, gsz);
}
#endif

extern "C" void kernel_launch(void* const* d_in, const int* in_sizes, int n_in, void* d_out, int out_size, void* d_ws, size_t ws_size,
                              hipStream_t stream) {
    P p{};
    const float* const* f = (const float* const*)d_in;
    p.x_prompt = f[0]; p.x_sample = f[1]; p.cache_kv = f[2]; p.page_table = (const int*)d_in[3]; p.cache_win = f[4];
    p.st_C = f[5]; p.st_n = f[6]; p.st_m = f[7]; p.st_conv = f[8]; p.norm1_g = f[9]; p.w_in = f[10]; p.b_gates = f[11];
    p.conv_w = f[12]; p.conv_b = f[13]; p.w_mq = f[14]; p.w_mk = f[15]; p.mnorm_g = f[16]; p.pe_k = f[17]; p.pe_v = f[18];
    p.w1_k = f[19]; p.w2_k = f[20]; p.w1_v = f[21]; p.w2_v = f[22]; p.w_a = f[23]; p.w_b = f[24]; p.w_out = f[25];
    p.norm2_g = f[26]; p.w_up = f[27]; p.w_down = f[28]; p.final_g = f[29];
    p.out = (float*)d_out;
    float* w = (float*)d_ws;
    auto take = [&](size_t n) { float* r = w; w += (n + 63) / 64 * 64; return r; };
    p.X = take((size_t)NTOK * D); p.H = take((size_t)NTOK * D); p.Z = take((size_t)NTOK * INW); p.RSTD = take(NTOK);
    p.KW = take((size_t)NTOK * 256); p.QR = take((size_t)NTOK * 512); p.CC = take((size_t)NTOK * 512);
    p.IG = take((size_t)NTOK * 4); p.LF = take((size_t)NTOK * 4); p.QM = take((size_t)NTOK * 512); p.KM = take((size_t)NTOK * 512);
    p.NUMP = take((size_t)NTOK * MH * 4 * 129); p.MT = take((size_t)NTOK * 4); p.HA = take((size_t)NTOK * 512); p.HB = take((size_t)NTOK * 512);
    p.HID = take(KC_ROWS * 4 * CHID); p.KC = take(KC_ROWS * 128); p.VC = take(KC_ROWS * 128);
    p.PC = take((size_t)NTOK * NH * NCMAX); p.OC = take((size_t)NTOK * 512); p.OS = take((size_t)NTOK * 512); p.OW = take((size_t)NTOK * 512);
    p.SCORE = take((size_t)NTOK * NKV * 64); p.PS = take((size_t)NTOK * NH * 1024); p.PW = take((size_t)NTOK * NH * 512);
    p.TA = take((size_t)NTOK * D); p.TB = take((size_t)NTOK * D); p.MG = take((size_t)NTOK * D);
    p.GU = take((size_t)NTOK * 2 * DFF); p.ACT = take((size_t)NTOK * DFF);
    p.SEL = (int*)take((size_t)NTOK * NKV * SELTOP);
    RUN(ph_load_x, 0)
    for (int l = 0; l < DEPTH; ++l) {
#define RUNL(name) RUN(name, l)
        PHASES(RUNL)
    }
    RUN(ph_rstd, 0)
    RUN(ph_final, 0)
}
```

```cpp
#ifdef CPU_TEST
#include "cpu_shim.h"
#else
#include <hip/hip_runtime.h>
#endif
#include <stdint.h>
#include <stddef.h>

#ifndef CFG_BATCH
#define CFG_BATCH 4
#define CFG_SEQ 4096
#define CFG_DEC_BATCH 128
#define CFG_PAST_LEN 2048
#endif

namespace {
constexpr int BATCH = CFG_BATCH, SEQ = CFG_SEQ, DEC_BATCH = CFG_DEC_BATCH, PAST_LEN = CFG_PAST_LEN;
constexpr int D = 1024, DEPTH = 2, DEC_SEQ = 4, PAGE = 128;
constexpr int MH = 4, MW = 512, MHD = 128;
constexpr int HD = 64, NH = 8, NKV = 2;
constexpr int CHID = 128, SELB = 64, SELTOP = 16, WIN = 512;
constexpr int DFF = 2816, INW = 4896;
constexpr float EPS = 1e-6f, NEG = -1e30f, TINY = 1e-30f;
constexpr int NPT = BATCH * SEQ, NST = DEC_BATCH * DEC_SEQ, NTOK = NPT + NST, NSEQ = BATCH + DEC_BATCH;
constexpr int N_PAGES = PAST_LEN / PAGE, N_USED = DEC_BATCH * N_PAGES, N_POOL = N_USED + N_USED / 4;
constexpr int WB = (WIN < PAST_LEN ? WIN : PAST_LEN), WP = (WIN < SEQ ? WIN : SEQ);
constexpr int NCP = SEQ / 16 - 1, NCS = (PAST_LEN + DEC_SEQ) / 16 - 1, NCMAX = (NCP > NCS ? NCP : NCS);
constexpr int NBP = (SEQ + 63) / 64, NBS = (PAST_LEN + DEC_SEQ + 63) / 64;
constexpr int ZU = 0, ZV = 512, ZO = 1024, ZIG = 1536, ZFG = 1540, ZQ = 1544, ZKV = 2056, ZNG = 2824, ZGA = 2848, ZGB = 3872;
constexpr size_t O_YP = 0;
constexpr size_t O_YS = O_YP + (size_t)NPT * D;
constexpr size_t O_PKV = O_YS + (size_t)NST * D;
constexpr size_t O_PWIN = O_PKV + (size_t)DEPTH * BATCH * SEQ * 512;
constexpr size_t O_PC = O_PWIN + (size_t)DEPTH * BATCH * WP * 256;
constexpr size_t O_PN = O_PC + (size_t)DEPTH * BATCH * MH * MHD * MHD;
constexpr size_t O_PM = O_PN + (size_t)DEPTH * BATCH * MH * MHD;
constexpr size_t O_PCONV = O_PM + (size_t)DEPTH * BATCH * MH;
constexpr size_t O_SKV = O_PCONV + (size_t)DEPTH * BATCH * 3 * MW;
constexpr size_t O_SWIN = O_SKV + (size_t)DEPTH * DEC_BATCH * DEC_SEQ * 512;
constexpr size_t O_SC = O_SWIN + (size_t)DEPTH * DEC_BATCH * WB * 256;
constexpr size_t O_SN = O_SC + (size_t)DEPTH * DEC_BATCH * MH * MHD * MHD;
constexpr size_t O_SM = O_SN + (size_t)DEPTH * DEC_BATCH * MH * MHD;
constexpr size_t O_SCONV = O_SM + (size_t)DEPTH * DEC_BATCH * MH;
constexpr size_t O_END = O_SCONV + (size_t)DEPTH * DEC_BATCH * 3 * MW;

struct P {
    const float *x_prompt, *x_sample, *cache_kv;
    const int* page_table;
    const float *cache_win, *st_C, *st_n, *st_m, *st_conv, *norm1_g, *w_in, *b_gates, *conv_w, *conv_b, *w_mq, *w_mk, *mnorm_g,
        *pe_k, *pe_v, *w1_k, *w2_k, *w1_v, *w2_v, *w_a, *w_b, *w_out, *norm2_g, *w_up, *w_down, *final_g;
    float* out;
    float *X, *H, *Z, *RSTD, *KW, *QR, *CC, *IG, *LF, *QM, *KM, *NUMP, *MT, *HA, *HB, *HID, *KC, *VC, *PC, *OC, *OS, *OW, *SCORE,
        *PS, *PW, *TA, *TB, *MG, *GU, *ACT;
    int* SEL;
};

struct Tok { int seq, t, pos, b; bool sample; };
__device__ __forceinline__ Tok tokinfo(int tok) {
    Tok r;
    if (tok < NPT) { r.b = tok / SEQ; r.t = tok % SEQ; r.seq = r.b; r.pos = r.t; r.sample = false; }
    else { int q = tok - NPT; r.b = q / DEC_SEQ; r.t = q % DEC_SEQ; r.seq = BATCH + r.b; r.pos = PAST_LEN + r.t; r.sample = true; }
    return r;
}
__device__ __forceinline__ int seq_row0(int seq) { return seq < BATCH ? seq * SEQ : NPT + (seq - BATCH) * DEC_SEQ; }
__device__ __forceinline__ int seq_len(int seq) { return seq < BATCH ? SEQ : DEC_SEQ; }
__device__ __forceinline__ int seq_nc(int seq) { return seq < BATCH ? NCP : NCS; }
__device__ __forceinline__ size_t kc_base(int seq) { return seq < BATCH ? (size_t)seq * NCP : (size_t)BATCH * NCP + (size_t)(seq - BATCH) * NCS; }
constexpr size_t KC_ROWS = (size_t)BATCH * NCP + (size_t)DEC_BATCH * NCS;

__device__ __forceinline__ const float* kvrow(const P& p, int l, int seq, int pos, int j, int g) {
    if (seq < BATCH) return p.out + O_PKV + ((((size_t)l * BATCH + seq) * SEQ + pos) * 4 + j) * 128 + g * 64;
    int b = seq - BATCH;
    if (pos < PAST_LEN) {
        int pg = p.page_table[b * N_PAGES + pos / PAGE];
        return p.cache_kv + ((((size_t)l * N_POOL + pg) * PAGE + pos % PAGE) * 4 + j) * 128 + g * 64;
    }
    return p.out + O_SKV + ((((size_t)l * DEC_BATCH + b) * DEC_SEQ + (pos - PAST_LEN)) * 4 + j) * 128 + g * 64;
}
__device__ __forceinline__ const float* winrow(const P& p, int l, int seq, int pos, int kv, int g) {
    if (seq < BATCH) return p.KW + ((size_t)(seq * SEQ + pos) * 2 + kv) * 128 + g * 64;
    int b = seq - BATCH;
    if (pos < PAST_LEN) return p.cache_win + ((((size_t)l * DEC_BATCH + b) * WB + (pos - (PAST_LEN - WB))) * 2 + kv) * 128 + g * 64;
    return p.KW + ((size_t)(NPT + b * DEC_SEQ + (pos - PAST_LEN)) * 2 + kv) * 128 + g * 64;
}

__device__ __forceinline__ float sigmoidf_(float x) { return 1.f / (1.f + expf(-x)); }
__device__ __forceinline__ float siluf_(float x) { return x / (1.f + expf(-x)); }
__device__ __forceinline__ float log_sigmoidf_(float x) { return fminf(x, 0.f) - log1pf(expf(-fabsf(x))); }
__device__ __forceinline__ float geluf_(float x) { return 0.5f * x * (1.f + tanhf(0.7978845608028654f * (x + 0.044715f * x * x * x))); }
__device__ __forceinline__ float rope_inv(int i) { return powf(500000.0f, -(float)i / 8.0f); }
__device__ __forceinline__ float rope_elem(const float* x, int d, int pos) {
    if (d >= 16) return x[d];
    int i = d & 7;
    float ang = (float)pos * rope_inv(i);
    float c = cosf(ang), s = sinf(ang);
    return d < 8 ? x[d] * c - x[d + 8] * s : x[d] * c + x[d - 8] * s;
}

#define PLOOP(i, n) for (long i = gtid; i < (long)(n); i += gsz)

__device__ __forceinline__ void gemm_items(const float* A, int lda, const float* B, int ldb, float* C, int ldc, int M, int N, int K,
                                           int accumulate, long gtid, long gsz) {
    const int ng = N / 4;
    const long items = (long)(M / 4) * ng;
    for (long it = gtid; it < items; it += gsz) {
        const int mg = (int)(it / ng), n4 = (int)(it % ng) * 4;
        float acc[4][4];
#pragma unroll
        for (int i = 0; i < 4; ++i)
#pragma unroll
            for (int j = 0; j < 4; ++j) acc[i][j] = 0.f;
        const float* a0 = A + (size_t)(mg * 4) * lda;
        const float* b0 = B + n4;
        for (int k = 0; k < K; ++k) {
            const float4 b = *(const float4*)(b0 + (size_t)k * ldb);
#pragma unroll
            for (int i = 0; i < 4; ++i) {
                const float a = a0[(size_t)i * lda + k];
                acc[i][0] += a * b.x; acc[i][1] += a * b.y; acc[i][2] += a * b.z; acc[i][3] += a * b.w;
            }
        }
#pragma unroll
        for (int i = 0; i < 4; ++i) {
            float* c = C + (size_t)(mg * 4 + i) * ldc + n4;
#pragma unroll
            for (int j = 0; j < 4; ++j) c[j] = accumulate ? c[j] + acc[i][j] : acc[i][j];
        }
    }
}

__device__ __forceinline__ void ph_load_x(const P& p, int l, long gtid, long gsz) {
    PLOOP(i, (size_t)NTOK * D) p.X[i] = i < (long)NPT * D ? p.x_prompt[i] : p.x_sample[i - (long)NPT * D];
}
__device__ __forceinline__ void ph_rstd(const P& p, int l, long gtid, long gsz) {
    PLOOP(tok, NTOK) {
        const float* x = p.X + (size_t)tok * D;
        float ss = 0.f;
        for (int c = 0; c < D; ++c) ss += x[c] * x[c];
        p.RSTD[tok] = 1.f / sqrtf(ss / D + EPS);
    }
}
__device__ __forceinline__ void ph_norm1(const P& p, int l, long gtid, long gsz) {
    PLOOP(i, (size_t)NTOK * D) { int tok = (int)(i / D), c = (int)(i % D); p.H[i] = p.X[i] * p.RSTD[tok] * p.norm1_g[l * D + c]; }
}
__device__ __forceinline__ void ph_gemm_in(const P& p, int l, long gtid, long gsz) {
    gemm_items(p.H, D, p.w_in + (size_t)l * D * INW, INW, p.Z, INW, NTOK, INW, D, 0, gtid, gsz);
}
__device__ __forceinline__ void ph_kv(const P& p, int l, long gtid, long gsz) {
    PLOOP(i, (size_t)NTOK * 768) {
        int tok = (int)(i / 768), c = (int)(i % 768);
        int j = c / 128, g = (c % 128) / 64, d = c % 64;
        Tok ti = tokinfo(tok);
        const float* x = p.Z + (size_t)tok * INW + ZKV + j * 128 + g * 64;
        float v = (j == 2 || j == 4) ? rope_elem(x, d, ti.pos) : x[d];
        if (j < 4) {
            size_t o = ti.sample ? O_SKV + ((((size_t)l * DEC_BATCH + ti.b) * DEC_SEQ + ti.t) * 4 + j) * 128 + g * 64 + d
                                 : O_PKV + ((((size_t)l * BATCH + ti.b) * SEQ + ti.t) * 4 + j) * 128 + g * 64 + d;
            p.out[o] = v;
        } else {
            int kv = j - 4;
            p.KW[((size_t)tok * 2 + kv) * 128 + g * 64 + d] = v;
            if (ti.sample) {
                p.out[O_SWIN + ((((size_t)l * DEC_BATCH + ti.b) * WB + (WB - DEC_SEQ + ti.t)) * 2 + kv) * 128 + g * 64 + d] = v;
            } else if (ti.t >= SEQ - WP) {
                p.out[O_PWIN + ((((size_t)l * BATCH + ti.b) * WP + (ti.t - (SEQ - WP))) * 2 + kv) * 128 + g * 64 + d] = v;
            }
        }
    }
}
__device__ __forceinline__ void ph_swin_copy(const P& p, int l, long gtid, long gsz) {
    PLOOP(i, (size_t)DEC_BATCH * (WB - DEC_SEQ) * 256) {
        int b = (int)(i / ((WB - DEC_SEQ) * 256)); int r = (int)(i % ((WB - DEC_SEQ) * 256));
        p.out[O_SWIN + ((size_t)l * DEC_BATCH + b) * WB * 256 + r] = p.cache_win[((size_t)l * DEC_BATCH + b) * WB * 256 + DEC_SEQ * 256 + r];
    }
}
__device__ __forceinline__ void ph_qrot(const P& p, int l, long gtid, long gsz) {
    PLOOP(i, (size_t)NTOK * 512) {
        int tok = (int)(i / 512), c = (int)(i % 512); int h = c / 64, d = c % 64;
        Tok ti = tokinfo(tok);
        p.QR[i] = rope_elem(p.Z + (size_t)tok * INW + ZQ + h * 64, d, ti.pos);
    }
}
__device__ __forceinline__ float conv_u(const P& p, int l, const Tok& ti, int tok, int dt, int c) {
    int t = ti.t + dt;
    if (t >= 0) return p.Z[(size_t)(tok + dt) * INW + ZU + c];
    if (!ti.sample) return 0.f;
    return p.st_conv[(((size_t)l * DEC_BATCH + ti.b) * 3 + (3 + t)) * MW + c];
}
__device__ __forceinline__ void ph_conv(const P& p, int l, long gtid, long gsz) {
    PLOOP(i, (size_t)NTOK * 512) {
        int tok = (int)(i / 512), c = (int)(i % 512);
        Tok ti = tokinfo(tok);
        float y = p.conv_b[l * MW + c];
#pragma unroll
        for (int j = 0; j < 4; ++j) y += conv_u(p, l, ti, tok, j - 3, c) * p.conv_w[((size_t)l * 4 + j) * MW + c];
        p.CC[i] = siluf_(y);
    }
    PLOOP(i, (size_t)NSEQ * 3 * 512) {
        int seq = (int)(i / 1536), r = (int)((i % 1536) / 512), c = (int)(i % 512);
        int T = seq_len(seq), row0 = seq_row0(seq);
        Tok ti = tokinfo(row0 + T - 1);
        float v = conv_u(p, l, ti, row0 + T - 1, r - 2, c);
        if (seq < BATCH) p.out[O_PCONV + (((size_t)l * BATCH + seq) * 3 + r) * MW + c] = v;
        else p.out[O_SCONV + (((size_t)l * DEC_BATCH + (seq - BATCH)) * 3 + r) * MW + c] = v;
    }
    PLOOP(i, (size_t)NTOK * 4) {
        int tok = (int)(i / 4), h = (int)(i % 4);
        p.IG[i] = p.Z[(size_t)tok * INW + ZIG + h] + p.b_gates[l * 8 + h];
        p.LF[i] = log_sigmoidf_(p.Z[(size_t)tok * INW + ZFG + h] + p.b_gates[l * 8 + 4 + h]);
    }
}
__device__ __forceinline__ void ph_mqk(const P& p, int l, long gtid, long gsz) {
    for (int h = 0; h < MH; ++h) {
        gemm_items(p.CC + h * MHD, MW, p.w_mq + ((size_t)l * MH + h) * MHD * MHD, MHD, p.QM + h * MHD, MW, NTOK, MHD, MHD, 0, gtid, gsz);
        gemm_items(p.CC + h * MHD, MW, p.w_mk + ((size_t)l * MH + h) * MHD * MHD, MHD, p.KM + h * MHD, MW, NTOK, MHD, MHD, 0, gtid, gsz);
    }
}
__device__ __forceinline__ void ph_mlstm(const P& p, int l, long gtid, long gsz) {
    PLOOP(it, (size_t)NSEQ * MH * 4 * 129) {
        int e = (int)(it % 129); int part = (int)((it / 129) % 4); int h = (int)((it / (129 * 4)) % MH); int seq = (int)(it / (129 * 4 * MH));
        int T = seq_len(seq), row0 = seq_row0(seq);
        bool sample = seq >= BATCH; int b = sample ? seq - BATCH : seq;
        float C[32]; float m = 0.f;
#pragma unroll
        for (int i = 0; i < 32; ++i) C[i] = 0.f;
        if (sample) {
            m = p.st_m[((size_t)l * DEC_BATCH + b) * MH + h];
#pragma unroll
            for (int i = 0; i < 32; ++i) {
                int d = part * 32 + i;
                C[i] = e < 128 ? p.st_C[((((size_t)l * DEC_BATCH + b) * MH + h) * MHD + d) * MHD + e] : p.st_n[(((size_t)l * DEC_BATCH + b) * MH + h) * MHD + d];
            }
        }
        for (int t = 0; t < T; ++t) {
            int tok = row0 + t;
            float ig = p.IG[tok * 4 + h], lf = p.LF[tok * 4 + h];
            float mn = fmaxf(lf + m, ig);
            float dec = expf(lf + m - mn), w = expf(ig - mn);
            m = mn;
            float ve = e < 128 ? p.Z[(size_t)tok * INW + ZV + h * MHD + e] : 1.f;
            float wv = w * ve, acc = 0.f;
            const float* kk = p.KM + (size_t)tok * MW + h * MHD + part * 32;
            const float* qq = p.QM + (size_t)tok * MW + h * MHD + part * 32;
#pragma unroll
            for (int i = 0; i < 32; ++i) {
                C[i] = dec * C[i] + wv * (kk[i] * 0.08838834764831845f);
                acc += qq[i] * C[i];
            }
            p.NUMP[(((size_t)tok * MH + h) * 4 + part) * 129 + e] = acc;
            if (e == 0 && part == 0) p.MT[tok * 4 + h] = m;
        }
        size_t oC = sample ? O_SC + (((size_t)l * DEC_BATCH + b) * MH + h) * MHD * MHD : O_PC + (((size_t)l * BATCH + b) * MH + h) * MHD * MHD;
        size_t oN = sample ? O_SN + (((size_t)l * DEC_BATCH + b) * MH + h) * MHD : O_PN + (((size_t)l * BATCH + b) * MH + h) * MHD;
        size_t oM = sample ? O_SM + ((size_t)l * DEC_BATCH + b) * MH + h : O_PM + ((size_t)l * BATCH + b) * MH + h;
#pragma unroll
        for (int i = 0; i < 32; ++i) {
            int d = part * 32 + i;
            if (e < 128) p.out[oC + (size_t)d * MHD + e] = C[i]; else p.out[oN + d] = C[i];
        }
        if (e == 0 && part == 0) p.out[oM] = m;
    }
}
__device__ __forceinline__ void ph_ha(const P& p, int l, long gtid, long gsz) {
    PLOOP(it, (size_t)NTOK * MH) {
        int tok = (int)(it / MH), h = (int)(it % MH);
        const float* np_ = p.NUMP + (size_t)it * 4 * 129;
        float den = np_[128] + np_[129 + 128] + np_[2 * 129 + 128] + np_[3 * 129 + 128];
        float dn = fmaxf(fabsf(den), expf(-p.MT[it]));
        float ss = 0.f;
        for (int e = 0; e < MHD; ++e) { float hv = (np_[e] + np_[129 + e] + np_[2 * 129 + e] + np_[3 * 129 + e]) / dn; ss += hv * hv; }
        float r = 1.f / sqrtf(ss / MHD + EPS);
        for (int e = 0; e < MHD; ++e) {
            float hv = (np_[e] + np_[129 + e] + np_[2 * 129 + e] + np_[3 * 129 + e]) / dn;
            float o = p.Z[(size_t)tok * INW + ZO + h * MHD + e];
            p.HA[(size_t)tok * MW + h * MHD + e] = hv * r * p.mnorm_g[l * MW + h * MHD + e] * sigmoidf_(o);
        }
    }
}
__device__ __forceinline__ void cmp_item(long item, int& seq, int& n, int& g, int& kind) {
    kind = (int)(item & 1); g = (int)((item >> 1) & 1); long r = item >> 2;
    if (r < (long)BATCH * NCP) { seq = (int)(r / NCP); n = (int)(r % NCP); }
    else { r -= (long)BATCH * NCP; seq = BATCH + (int)(r / NCS); n = (int)(r % NCS); }
}
__device__ __forceinline__ void ph_cmp_hid(const P& p, int l, long gtid, long gsz) {
    PLOOP(i, KC_ROWS * 4 * CHID) {
        long item = i / CHID; int e = (int)(i % CHID);
        int seq, n, g, kind; cmp_item(item, seq, n, g, kind);
        const float* pe = (kind ? p.pe_v : p.pe_k) + (size_t)l * 32 * 64;
        const float* w1 = (kind ? p.w1_v : p.w1_k) + (size_t)l * 32 * 64 * CHID;
        float acc = 0.f;
        for (int r = 0; r < 32; ++r) {
            const float* row = kvrow(p, l, seq, n * 16 + r, kind, g);
            for (int d = 0; d < 64; ++d) acc += (row[d] + pe[r * 64 + d]) * w1[((size_t)r * 64 + d) * CHID + e];
        }
        p.HID[i] = geluf_(acc);
    }
}
__device__ __forceinline__ void ph_cmp_out(const P& p, int l, long gtid, long gsz) {
    PLOOP(i, KC_ROWS * 4 * 64) {
        long item = i / 64; int f = (int)(i % 64);
        int seq, n, g, kind; cmp_item(item, seq, n, g, kind);
        const float* w2 = (kind ? p.w2_v : p.w2_k) + (size_t)l * CHID * 64;
        float acc = 0.f;
        for (int e = 0; e < CHID; ++e) acc += p.HID[item * CHID + e] * w2[e * 64 + f];
        (kind ? p.VC : p.KC)[((kc_base(seq) + n) * 2 + g) * 64 + f] = acc;
    }
}
__device__ __forceinline__ void ph_sc(const P& p, int l, long gtid, long gsz) {
    PLOOP(i, (size_t)NTOK * NH * NCMAX) {
        int n = (int)(i % NCMAX); int h = (int)((i / NCMAX) % NH); int tok = (int)(i / ((long)NCMAX * NH));
        Tok ti = tokinfo(tok);
        int nc = seq_nc(ti.seq);
        float s = NEG;
        if (n < nc && n * 16 + 31 <= ti.pos) {
            const float* q = p.Z + (size_t)tok * INW + ZQ + h * 64;
            const float* k = p.KC + ((kc_base(ti.seq) + n) * 2 + h / 4) * 64;
            float acc = 0.f;
            for (int d = 0; d < 64; ++d) acc += q[d] * k[d];
            s = acc * 0.125f;
        }
        p.PC[i] = s;
    }
}
__device__ __forceinline__ void softmax_row(float* s, int len) {
    float mx = NEG;
    for (int i = 0; i < len; ++i) mx = fmaxf(mx, s[i]);
    float sum = 0.f;
    for (int i = 0; i < len; ++i) { if (s[i] > 0.5f * NEG) sum += expf(s[i] - mx); }
    float inv = 1.f / fmaxf(sum, TINY);
    for (int i = 0; i < len; ++i) s[i] = (s[i] > 0.5f * NEG) ? expf(s[i] - mx) * inv : 0.f;
}
__device__ __forceinline__ void ph_sc_softmax(const P& p, int l, long gtid, long gsz) {
    PLOOP(i, (size_t)NTOK * NH) softmax_row(p.PC + (size_t)i * NCMAX, NCMAX);
}
__device__ __forceinline__ void ph_oc(const P& p, int l, long gtid, long gsz) {
    PLOOP(i, (size_t)NTOK * 512) {
        int tok = (int)(i / 512), h = (int)((i % 512) / 64), d = (int)(i % 64);
        Tok ti = tokinfo(tok); int nc = seq_nc(ti.seq);
        const float* pc = p.PC + ((size_t)tok * NH + h) * NCMAX;
        float acc = 0.f;
        for (int n = 0; n < nc; ++n) acc += pc[n] * p.VC[((kc_base(ti.seq) + n) * 2 + h / 4) * 64 + d];
        p.OC[i] = acc;
    }
}
__device__ __forceinline__ void ph_select(const P& p, int l, long gtid, long gsz) {
    PLOOP(i, (size_t)NTOK * NKV) {
        int tok = (int)(i / NKV), g = (int)(i % NKV);
        Tok ti = tokinfo(tok);
        int nc = seq_nc(ti.seq), nblk = ti.sample ? NBS : NBP;
        int cur = ti.pos / SELB;
        float* sc = p.SCORE + (size_t)i * 64;
        for (int j = 0; j < nblk; ++j) {
            float imp = 0.f;
            for (int n = 4 * j - 1; n <= 4 * j + 3; ++n) {
                if (n < 0 || n >= nc) continue;
                int lo = n * 16 > j * 64 ? n * 16 : j * 64;
                int hi = n * 16 + 32 < j * 64 + 64 ? n * 16 + 32 : j * 64 + 64;
                int ov = hi - lo; if (ov <= 0) continue;
                float w = (float)ov / 32.f;
                float sum = 0.f;
                for (int r = 0; r < 4; ++r) sum += p.PC[((size_t)tok * NH + g * 4 + r) * NCMAX + n];
                imp += sum * w;
            }
            bool forced = (j == 0) || (j == cur) || (j == cur - 1);
            sc[j] = j <= cur ? (forced ? 1e9f : imp) : -1.f;
        }
        int nsel = nblk < SELTOP ? nblk : SELTOP;
        for (int k = 0; k < nsel; ++k) {
            int best = 0; float bv = -3e38f;
            for (int j = 0; j < nblk; ++j) if (sc[j] > bv) { bv = sc[j]; best = j; }
            p.SEL[(size_t)i * SELTOP + k] = best;
            sc[best] = -3.4e38f;
        }
    }
}
__device__ __forceinline__ void ph_ss(const P& p, int l, long gtid, long gsz) {
    PLOOP(i, (size_t)NTOK * NH * 1024) {
        int idx = (int)(i % 1024); int h = (int)((i / 1024) % NH); int tok = (int)(i / (1024 * NH));
        Tok ti = tokinfo(tok);
        int nblk = ti.sample ? NBS : NBP; int nsel = nblk < SELTOP ? nblk : SELTOP; int L = ti.sample ? PAST_LEN + DEC_SEQ : SEQ;
        int k = idx / 64, ii = idx % 64; int g = h / 4;
        float s = NEG;
        if (k < nsel) {
            int tk = p.SEL[((size_t)tok * NKV + g) * SELTOP + k] * 64 + ii;
            if (tk <= ti.pos) {
                int kp = tk < L - 1 ? tk : L - 1;
                const float* q = p.QR + (size_t)tok * 512 + h * 64;
                const float* kr = kvrow(p, l, ti.seq, kp, 2, g);
                float acc = 0.f;
                for (int d = 0; d < 64; ++d) acc += q[d] * kr[d];
                s = acc * 0.125f;
            }
        }
        p.PS[i] = s;
    }
}
__device__ __forceinline__ void ph_ss_softmax(const P& p, int l, long gtid, long gsz) {
    PLOOP(i, (size_t)NTOK * NH) softmax_row(p.PS + (size_t)i * 1024, 1024);
}
__device__ __forceinline__ void ph_os(const P& p, int l, long gtid, long gsz) {
    PLOOP(i, (size_t)NTOK * 512) {
        int tok = (int)(i / 512), h = (int)((i % 512) / 64), d = (int)(i % 64);
        Tok ti = tokinfo(tok); int g = h / 4;
        int nblk = ti.sample ? NBS : NBP; int nsel = nblk < SELTOP ? nblk : SELTOP; int L = ti.sample ? PAST_LEN + DEC_SEQ : SEQ;
        const float* ps = p.PS + ((size_t)tok * NH + h) * 1024;
        float acc = 0.f;
        for (int k = 0; k < nsel; ++k) {
            int blk = p.SEL[((size_t)tok * NKV + g) * SELTOP + k];
            for (int ii = 0; ii < 64; ++ii) {
                float w = ps[k * 64 + ii];
                if (w != 0.f) { int tk = blk * 64 + ii; int kp = tk < L - 1 ? tk : L - 1; acc += w * kvrow(p, l, ti.seq, kp, 3, g)[d]; }
            }
        }
        p.OS[i] = acc;
    }
}
__device__ __forceinline__ void ph_sw(const P& p, int l, long gtid, long gsz) {
    PLOOP(i, (size_t)NTOK * NH * 512) {
        int w = (int)(i % 512); int h = (int)((i / 512) % NH); int tok = (int)(i / (512 * NH));
        Tok ti = tokinfo(tok);
        int kp = ti.pos - 511 + w;
        float s = NEG;
        if (kp >= 0) {
            const float* q = p.QR + (size_t)tok * 512 + h * 64;
            const float* kr = winrow(p, l, ti.seq, kp, 0, h / 4);
            float acc = 0.f;
            for (int d = 0; d < 64; ++d) acc += q[d] * kr[d];
            s = acc * 0.125f;
        }
        p.PW[i] = s;
    }
}
__device__ __forceinline__ void ph_sw_softmax(const P& p, int l, long gtid, long gsz) {
    PLOOP(i, (size_t)NTOK * NH) softmax_row(p.PW + (size_t)i * 512, 512);
}
__device__ __forceinline__ void ph_ow(const P& p, int l, long gtid, long gsz) {
    PLOOP(i, (size_t)NTOK * 512) {
        int tok = (int)(i / 512), h = (int)((i % 512) / 64), d = (int)(i % 64);
        Tok ti = tokinfo(tok);
        const float* pw = p.PW + ((size_t)tok * NH + h) * 512;
        float acc = 0.f;
        for (int w = 0; w < 512; ++w) {
            int kp = ti.pos - 511 + w;
            if (kp >= 0) acc += pw[w] * winrow(p, l, ti.seq, kp, 1, h / 4)[d];
        }
        p.OW[i] = acc;
    }
}
__device__ __forceinline__ void ph_hb(const P& p, int l, long gtid, long gsz) {
    PLOOP(i, (size_t)NTOK * 512) {
        int tok = (int)(i / 512), h = (int)((i % 512) / 64);
        const float* ng = p.Z + (size_t)tok * INW + ZNG + h * 3;
        p.HB[i] = sigmoidf_(ng[0]) * p.OC[i] + sigmoidf_(ng[1]) * p.OS[i] + sigmoidf_(ng[2]) * p.OW[i];
    }
}
__device__ __forceinline__ void ph_branch(const P& p, int l, long gtid, long gsz) {
    gemm_items(p.HA, MW, p.w_a + (size_t)l * MW * D, D, p.TA, D, NTOK, D, MW, 0, gtid, gsz);
    gemm_items(p.HB, 512, p.w_b + (size_t)l * 512 * D, D, p.TB, D, NTOK, D, 512, 0, gtid, gsz);
}
__device__ __forceinline__ void ph_merge(const P& p, int l, long gtid, long gsz) {
    PLOOP(i, (size_t)NTOK * D) {
        int tok = (int)(i / D), c = (int)(i % D);
        const float* z = p.Z + (size_t)tok * INW;
        p.MG[i] = sigmoidf_(z[ZGA + c]) * p.TA[i] + sigmoidf_(z[ZGB + c]) * p.TB[i];
    }
}
__device__ __forceinline__ void ph_out(const P& p, int l, long gtid, long gsz) {
    gemm_items(p.MG, D, p.w_out + (size_t)l * D * D, D, p.X, D, NTOK, D, D, 1, gtid, gsz);
}
__device__ __forceinline__ void ph_norm2(const P& p, int l, long gtid, long gsz) {
    PLOOP(i, (size_t)NTOK * D) { int tok = (int)(i / D), c = (int)(i % D); p.H[i] = p.X[i] * p.RSTD[tok] * p.norm2_g[l * D + c]; }
}
__device__ __forceinline__ void ph_up(const P& p, int l, long gtid, long gsz) {
    gemm_items(p.H, D, p.w_up + (size_t)l * D * 2 * DFF, 2 * DFF, p.GU, 2 * DFF, NTOK, 2 * DFF, D, 0, gtid, gsz);
}
__device__ __forceinline__ void ph_act(const P& p, int l, long gtid, long gsz) {
    PLOOP(i, (size_t)NTOK * DFF) { int tok = (int)(i / DFF), c = (int)(i % DFF); const float* gu = p.GU + (size_t)tok * 2 * DFF; p.ACT[i] = siluf_(gu[c]) * gu[DFF + c]; }
}
__device__ __forceinline__ void ph_down(const P& p, int l, long gtid, long gsz) {
    gemm_items(p.ACT, DFF, p.w_down + (size_t)l * DFF * D, D, p.X, D, NTOK, D, DFF, 1, gtid, gsz);
}
__device__ __forceinline__ void ph_final(const P& p, int l, long gtid, long gsz) {
    PLOOP(i, (size_t)NTOK * D) { int tok = (int)(i / D), c = (int)(i % D); p.out[i] = p.X[i] * p.RSTD[tok] * p.final_g[c]; }
}

typedef void (*phase_fn)(const P&, int, long, long);
}

#define PHASES(X) \
    X(ph_rstd) X(ph_norm1) X(ph_gemm_in) X(ph_kv) X(ph_swin_copy) X(ph_qrot) X(ph_conv) X(ph_mqk) X(ph_mlstm) X(ph_ha) \
    X(ph_cmp_hid) X(ph_cmp_out) X(ph_sc) X(ph_sc_softmax) X(ph_oc) X(ph_select) X(ph_ss) X(ph_ss_softmax) X(ph_os) \
    X(ph_sw) X(ph_sw_softmax) X(ph_ow) X(ph_hb) X(ph_branch) X(ph_merge) X(ph_out) X(ph_rstd2) X(ph_norm2) X(ph_up) X(ph_act) X(ph_down)

namespace { __device__ __forceinline__ void ph_rstd2(const P& p, int l, long gtid, long gsz) { ph_rstd(p, l, gtid, gsz); } }

#ifndef CPU_TEST
#define XB_TMO      128
#define XB_XCNT(j)  (256  + 64 * (j))
#define XB_XSUB(j)  (1280 + 64 * (j))
#define XB_XGEN(j)  (2304 + 64 * (j))
#define XB_TOP      3328
#define XB_TOPGEN   3392
#define XCD_BAR_WORDS 3456
#define XB_SPIN_CAP (1u << 18)
#define LAS __attribute__((address_space(3)))

__device__ __forceinline__ unsigned xb_ld(unsigned* p)              { return __hip_atomic_load(p, __ATOMIC_RELAXED, __HIP_MEMORY_SCOPE_AGENT); }
__device__ __forceinline__ unsigned xb_add(unsigned* p, unsigned v) { return __hip_atomic_fetch_add(p, v, __ATOMIC_RELAXED, __HIP_MEMORY_SCOPE_AGENT); }
__device__ __forceinline__ unsigned xb_xcc_id() { return (unsigned)__builtin_amdgcn_s_getreg((3 << 11) | 20) & 0xFu; }
#define XB_SPIN(cond, bar) do { unsigned _sp = 0; while (cond) { __builtin_amdgcn_s_sleep(1); \
    if ((++_sp & 255u) == 0u) { if (xb_ld(&(bar)[XB_TMO])) break; if (_sp > XB_SPIN_CAP) { atomicAdd(&(bar)[XB_TMO], 1u); break; } } } } while (0)

struct XcdBarrier {
    unsigned* bar; unsigned x;
    volatile LAS unsigned* st;
};

__device__ __forceinline__ XcdBarrier xcd_barrier_post(unsigned* bar, volatile LAS unsigned* st) {
    XcdBarrier b; b.bar = bar; b.x = xb_xcc_id(); b.st = st;
    if (threadIdx.x == 0) (void)xb_add(&bar[XB_XCNT(b.x)], 1u);
    return b;
}
__device__ __forceinline__ void xcd_barrier_complete(unsigned* bar, unsigned x, unsigned& nloc, unsigned& nx) {
    const unsigned G = gridDim.x * gridDim.y * gridDim.z;
    unsigned sum, cnt, mine, sp = 0u;
    for (;;) {
        sum = 0u; cnt = 0u; mine = 0u;
#pragma unroll
        for (unsigned j = 0; j < 16; ++j) { const unsigned c = xb_ld(&bar[XB_XCNT(j)]); sum += c; cnt += (c > 0u) ? 1u : 0u; mine = (j == x) ? c : mine; }
        if (sum == G) break;
        __builtin_amdgcn_s_sleep(1);
        if ((++sp & 255u) == 0u) { if (xb_ld(&bar[XB_TMO])) break; if (sp > XB_SPIN_CAP) { atomicAdd(&bar[XB_TMO], 1u); break; } }
    }
    nloc = mine > 0u ? mine : 1u; nx = cnt > 0u ? cnt : 1u;
}

__device__ __forceinline__ void xcd_barrier(const XcdBarrier& b) {
    asm volatile("s_waitcnt vmcnt(0)" ::: "memory");
    __syncthreads();
    if (threadIdx.x == 0) {
        unsigned* bar = b.bar;
        __builtin_amdgcn_s_waitcnt(0);
        unsigned nloc = b.st[0], nx = b.st[1];
        if (nloc == 0u) { xcd_barrier_complete(bar, b.x, nloc, nx); b.st[0] = nloc; b.st[1] = nx; }
        const unsigned old = xb_add(&bar[XB_XSUB(b.x)], 1u);
        const unsigned gen = old / nloc;
        if (old + 1u == (gen + 1u) * nloc) {
            __builtin_amdgcn_fence(__ATOMIC_RELEASE, "agent");
            asm volatile("s_waitcnt vmcnt(0)" ::: "memory");
            const unsigned og = xb_add(&bar[XB_TOP], 1u);
            const unsigned tg = og / nx;
            if (og + 1u == (tg + 1u) * nx) xb_add(&bar[XB_TOPGEN], 1u);
            else XB_SPIN(xb_ld(&bar[XB_TOPGEN]) == tg, bar);
            __builtin_amdgcn_fence(__ATOMIC_ACQUIRE, "agent");
            xb_add(&bar[XB_XGEN(b.x)], 1u);
            asm volatile("s_waitcnt vmcnt(0)" ::: "memory");
        } else {
            XB_SPIN(xb_ld(&bar[XB_XGEN(b.x)]) == gen, bar);
            __builtin_amdgcn_fence(__ATOMIC_ACQUIRE, "agent");
            asm volatile("s_waitcnt vmcnt(0)" ::: "memory");
        }
    }
    __syncthreads();
}


#define BARRIER_WORDS_BYTES (XCD_BAR_WORDS * sizeof(unsigned))
#define CALLPH(name) name(p, l, gtid, gsz); xcd_barrier(bar);
__global__ void __launch_bounds__(256, 2) mega_kernel(P p, unsigned* barw) {
    __shared__ uint4 xb_words;
    if (threadIdx.x == 0) xb_words = make_uint4(0u, 0u, 0u, 0u);
    __syncthreads();
    XcdBarrier bar = xcd_barrier_post(barw, (volatile LAS unsigned*)&xb_words);
    const long gtid = (long)blockIdx.x * 256 + threadIdx.x, gsz = (long)gridDim.x * 256;
    { const int l = 0; CALLPH(ph_load_x) }
    for (int l = 0; l < DEPTH; ++l) {
        PHASES(CALLPH)
    }
    { const int l = 0; CALLPH(ph_rstd) ph_final(p, l, gtid, gsz); }
}
#else
#define RUN(name, l) cpu_run(name, p, l);
static void cpu_run(phase_fn f, const P& p, int l) {
    const long gsz = 1 << 14;
#pragma omp parallel for schedule(dynamic, 16)
    for (long g = 0; g < gsz; ++g) f(p, l, g, gsz);
}
#endif

extern "C" void kernel_launch(void* const* d_in, const int* in_sizes, int n_in, void* d_out, int out_size, void* d_ws, size_t ws_size,
                              hipStream_t stream) {
    P p{};
    const float* const* f = (const float* const*)d_in;
    p.x_prompt = f[0]; p.x_sample = f[1]; p.cache_kv = f[2]; p.page_table = (const int*)d_in[3]; p.cache_win = f[4];
    p.st_C = f[5]; p.st_n = f[6]; p.st_m = f[7]; p.st_conv = f[8]; p.norm1_g = f[9]; p.w_in = f[10]; p.b_gates = f[11];
    p.conv_w = f[12]; p.conv_b = f[13]; p.w_mq = f[14]; p.w_mk = f[15]; p.mnorm_g = f[16]; p.pe_k = f[17]; p.pe_v = f[18];
    p.w1_k = f[19]; p.w2_k = f[20]; p.w1_v = f[21]; p.w2_v = f[22]; p.w_a = f[23]; p.w_b = f[24]; p.w_out = f[25];
    p.norm2_g = f[26]; p.w_up = f[27]; p.w_down = f[28]; p.final_g = f[29];
    p.out = (float*)d_out;
    float* w = (float*)d_ws;
    auto take = [&](size_t n) { float* r = w; w += (n + 63) / 64 * 64; return r; };
    p.X = take((size_t)NTOK * D); p.H = take((size_t)NTOK * D); p.Z = take((size_t)NTOK * INW); p.RSTD = take(NTOK);
    p.KW = take((size_t)NTOK * 256); p.QR = take((size_t)NTOK * 512); p.CC = take((size_t)NTOK * 512);
    p.IG = take((size_t)NTOK * 4); p.LF = take((size_t)NTOK * 4); p.QM = take((size_t)NTOK * 512); p.KM = take((size_t)NTOK * 512);
    p.NUMP = take((size_t)NTOK * MH * 4 * 129); p.MT = take((size_t)NTOK * 4); p.HA = take((size_t)NTOK * 512); p.HB = take((size_t)NTOK * 512);
    p.HID = take(KC_ROWS * 4 * CHID); p.KC = take(KC_ROWS * 128); p.VC = take(KC_ROWS * 128);
    p.PC = take((size_t)NTOK * NH * NCMAX); p.OC = take((size_t)NTOK * 512); p.OS = take((size_t)NTOK * 512); p.OW = take((size_t)NTOK * 512);
    p.SCORE = take((size_t)NTOK * NKV * 64); p.PS = take((size_t)NTOK * NH * 1024); p.PW = take((size_t)NTOK * NH * 512);
    p.TA = take((size_t)NTOK * D); p.TB = take((size_t)NTOK * D); p.MG = take((size_t)NTOK * D);
    p.GU = take((size_t)NTOK * 2 * DFF); p.ACT = take((size_t)NTOK * DFF);
    p.SEL = (int*)take((size_t)NTOK * NKV * SELTOP);
#ifdef CPU_TEST
    RUN(ph_load_x, 0)
    for (int l = 0; l < DEPTH; ++l) {
#define RUNL(name) RUN(name, l)
        PHASES(RUNL)
    }
    RUN(ph_rstd, 0)
    RUN(ph_final, 0)
#else
    unsigned* barw = (unsigned*)w;
    static int grid = 0;
    if (!grid) {
        int dev = 0, cus = 0, per_cu = 0;
        hipGetDevice(&dev);
        hipDeviceGetAttribute(&cus, hipDeviceAttributeMultiprocessorCount, dev);
        hipOccupancyMaxActiveBlocksPerMultiprocessor(&per_cu, mega_kernel, 256, 0);
        if (per_cu > 2) per_cu = 2;
        if (per_cu < 1) per_cu = 1;
        grid = cus * per_cu;
    }
    hipMemsetAsync(barw, 0, BARRIER_WORDS_BYTES, stream);
    mega_kernel<<<grid, 256, 0, stream>>>(p, barw);
#endif
}
```

```cpp
#ifdef CPU_TEST
#include "hipemu.h"
#else
#include <hip/hip_runtime.h>
#endif
#include <stdint.h>
#include <stddef.h>
#include <cstdio>

#ifndef CFG_BATCH
#define CFG_BATCH 4
#define CFG_SEQ 4096
#define CFG_DEC_BATCH 128
#define CFG_PAST_LEN 2048
#endif

#ifdef CPU_TEST
static inline int opaque_tid() { return (int)threadIdx.x; }
#else
__device__ __forceinline__ int my_lane() { unsigned z = 0u; asm volatile("" : "+v"(z)); return (int)__builtin_amdgcn_mbcnt_hi(~0u, __builtin_amdgcn_mbcnt_lo(~0u, z)); }
extern __shared__ __attribute__((aligned(16))) unsigned char g_dyn_lds[];
#define WTAB_LDS_OFF (131072 + 16)
__device__ __forceinline__ int hw_wave_key() { return (int)(__builtin_amdgcn_s_getreg((5 << 11) | (0 << 6) | 4) & 63u); }
__device__ __forceinline__ int opaque_tid() {
    const int wv = __builtin_amdgcn_readfirstlane(*(const __attribute__((address_space(3))) int*)(g_dyn_lds + WTAB_LDS_OFF + 4 * hw_wave_key()));
    int t = (wv << 6) | my_lane(); asm volatile("" : "+v"(t)); return t; }
template <class T> __device__ __forceinline__ T my_shfl_xor(T v, int m) { static_assert(sizeof(T) == 4, "32-bit shuffles only"); return __builtin_bit_cast(T, __builtin_amdgcn_ds_bpermute((my_lane() ^ m) << 2, __builtin_bit_cast(int, v))); }
template <class T> __device__ __forceinline__ T my_shfl_up(T v, int d) { static_assert(sizeof(T) == 4, "32-bit shuffles only"); const int l = my_lane(), s = l - d < 0 ? l : l - d; return __builtin_bit_cast(T, __builtin_amdgcn_ds_bpermute(s << 2, __builtin_bit_cast(int, v))); }
#define __shfl_xor my_shfl_xor
#define __shfl_up my_shfl_up
#endif
namespace pg8 {
#ifdef CPU_TEST
#define PG8_LAS
#else
#define PG8_LAS __attribute__((address_space(3)))
#endif
typedef unsigned short bf16_t;
typedef short bf16x8 __attribute__((ext_vector_type(8)));
typedef float f32x4 __attribute__((ext_vector_type(4)));
typedef unsigned u32x4 __attribute__((ext_vector_type(4)));
constexpr int BM = 256, BK = 64, HALF = 128, HTB = HALF * BK * 2  , STAGE_BYTES = 8 * HTB, NXCD = 8, WGM = 8;

__host__ __device__ __forceinline__ int lds_byte(int r, int c) { const int st = (r >> 4) * 2 + (c >> 5), rr = r & 15, cc = c & 31, ob = rr * 64 + cc * 2; return st * 1024 + (ob ^ (((ob >> 9) & 1) << 5)); }
__host__ __device__ __forceinline__ void stage_rc(int b, int& R, int& C) { const int st = b / 1024, sb = b % 1024, swz = sb ^ (((sb >> 9) & 1) << 5); R = (st >> 1) * 16 + swz / 64; C = (st & 1) * 32 + (swz % 64) / 2; }
__host__ __device__ __forceinline__ int perm32(int rho) { const int n = rho >> 4, i = rho & 15; return 8 * (i >> 2) + 4 * n + (i & 3); }

struct Unit { int pm, pn; };
struct Gemm { const bf16_t* A; const bf16_t* Bt; int M, N, K; };

struct StaticOrder {
    int nM, nN, nwg, G, c;
    __host__ __device__ void init(int M, int N, int G_, int c_) { nM = M / BM; nN = N / BM; nwg = nM * nN; G = G_; c = c_; }
    __host__ __device__ bool next(int i, Unit& u) const {
        const long L = (long)i * G + c; if (L >= nwg) return false;
        int wgid = (int)L; { const int q = nwg / NXCD, r = nwg % NXCD, xcd = wgid % NXCD, off = wgid / NXCD; wgid = (xcd < r ? xcd * (q + 1) : r * (q + 1) + (xcd - r) * q) + off; }
        const int nig = WGM * nN, gid = wgid / nig, fm = gid * WGM, gsz = (nM - fm) < WGM ? (nM - fm) : WGM;
        u.pm = fm + ((wgid % nig) % gsz); u.pn = (wgid % nig) / gsz; return true;
    }
    __device__ __forceinline__ void a_ready(const Unit&) const {}
    __device__ __forceinline__ void done(const Unit&) const {}
};
#ifdef CPU_TEST
__device__ __forceinline__ unsigned cvt_pk_bf16(float lo, float hi) { return (unsigned)emu_f2bf(lo) | ((unsigned)emu_f2bf(hi) << 16); }
#else
typedef float pk_f32x2 __attribute__((ext_vector_type(2))); typedef __bf16 pk_bf16x2 __attribute__((ext_vector_type(2)));
__device__ __forceinline__ unsigned cvt_pk_bf16(float lo, float hi) { pk_f32x2 v = {lo, hi}; pk_bf16x2 b = __builtin_convertvector(v, pk_bf16x2); return __builtin_bit_cast(unsigned, b); }
#endif
template <class Epi, class Sched, bool STAMP = false>
__device__ __forceinline__ void gemm_phase(PG8_LAS unsigned char* lds, const Gemm g, const Sched& S, const Epi& E, unsigned long long* stamps) {
    const int tid = opaque_tid(), wid = __builtin_amdgcn_readfirstlane(tid >> 6), lane = tid & 63, wr = wid >> 2, wc = wid & 3, fr = lane & 15, fq = lane >> 4;
    const int K = g.K, nt = K / BK;
#define PG8_STAMP() do {} while (0)
    PG8_STAMP();
    unsigned voffA[2], voffB[2];
#pragma unroll
    for (int i = 0; i < 2; ++i) { int R, C; stage_rc(tid * 16 + i * 8192, R, C); const int Rb = Epi::PERM ? ((R & ~31) + perm32(R & 31)) : R;
        voffA[i] = (unsigned)(R * K + C) * 2u; voffB[i] = (unsigned)(Rb * K + C) * 2u; }
    const size_t kstep = (size_t)(BK * 2);
    const size_t hstep = (size_t)HALF * K * 2;
    const size_t tstep = 2 * hstep;
    const unsigned ldsw = (unsigned)wid * 1024u;
    const int aoff = lds_byte(wr * 64 + fr, fq * 8), boff = lds_byte(wc * 32 + fr, fq * 8);
#define PG8_SA(b, h) (((b) * 2 + (h)) * HTB)
#define PG8_SB(b, h) ((4 + (b) * 2 + (h)) * HTB)
#define PG8_STAGE(bufoff, gbase, voff) do { _Pragma("unroll") for (int _i = 0; _i < 2; ++_i) \
        __builtin_amdgcn_global_load_lds((const unsigned*)((const char*)(gbase) + (voff)[_i]), (PG8_LAS unsigned*)(lds + (bufoff) + ldsw + _i * 8192), 16, 0, 0); } while (0)
#define PG8_LDA(dst, b, h) do { _Pragma("unroll") for (int m = 0; m < 4; ++m) _Pragma("unroll") for (int k = 0; k < 2; ++k) dst[m][k] = *(const PG8_LAS bf16x8*)(lds + PG8_SA(b, h) + aoff + m * 2048 + k * 1024); } while (0)
#define PG8_LDB(dst, b, h) do { _Pragma("unroll") for (int n = 0; n < 2; ++n) _Pragma("unroll") for (int k = 0; k < 2; ++k) dst[n][k] = *(const PG8_LAS bf16x8*)(lds + PG8_SB(b, h) + boff + n * 2048 + k * 1024); } while (0)
#define PG8_MMA(ai, bj, At, Bt) do { __builtin_amdgcn_s_setprio(1); _Pragma("unroll") for (int m = 0; m < 4; ++m) _Pragma("unroll") for (int n = 0; n < 2; ++n) _Pragma("unroll") for (int k = 0; k < 2; ++k) \
        acc[ai][bj][m][n] = __builtin_amdgcn_mfma_f32_16x16x32_bf16(Bt[n][k], At[m][k], acc[ai][bj][m][n], 0, 0, 0); __builtin_amdgcn_s_setprio(0); } while (0)
#ifdef CPU_TEST
#define PG8_WAIT_V(n) ((void)0)
#define PG8_WAIT_L(n) ((void)0)
#else
#define PG8_WAIT_V(n) asm volatile("s_waitcnt vmcnt(" #n ")" ::: "memory")
#define PG8_WAIT_L(n) asm volatile("s_waitcnt lgkmcnt(" #n ")" ::: "memory")
#endif
#define PG8_BAR __builtin_amdgcn_s_barrier()
#define PG8_SCHED __builtin_amdgcn_sched_barrier(0)
    Unit cur, nxt; int ui = 0;
    if (!S.next(0, cur)) return;
    f32x4 acc[2][2][4][2];
#pragma unroll
    for (int a = 0; a < 2; ++a)
#pragma unroll
        for (int b = 0; b < 2; ++b)
#pragma unroll
            for (int m = 0; m < 4; ++m)
#pragma unroll
                for (int n = 0; n < 2; ++n) acc[a][b][m][n] = (f32x4){0.f, 0.f, 0.f, 0.f};
    bf16x8 At[4][2], B0[2][2], B1[2][2];
    const char* cA = (const char*)g.A + (size_t)cur.pm * tstep; const char* cB = (const char*)g.Bt + (size_t)cur.pn * tstep;
    S.a_ready(cur);
    PG8_STAGE(PG8_SB(0, 0), cB, voffB); PG8_STAGE(PG8_SA(0, 0), cA, voffA); PG8_STAGE(PG8_SB(0, 1), cB + hstep, voffB); PG8_STAGE(PG8_SA(0, 1), cA + hstep, voffA);
    if (wr == 1) PG8_BAR;
    PG8_WAIT_V(4); PG8_BAR;
    PG8_STAGE(PG8_SB(1, 0), cB + kstep, voffB); PG8_STAGE(PG8_SA(1, 0), cA + kstep, voffA); PG8_STAGE(PG8_SB(1, 1), cB + hstep + kstep, voffB);
    PG8_WAIT_V(6); PG8_BAR;
    PG8_STAMP();
    for (;;) {
        const bool has_next = S.next(ui + 1, nxt);
        const char* nA = has_next ? (const char*)g.A + (size_t)nxt.pm * tstep : cA; const char* nB = has_next ? (const char*)g.Bt + (size_t)nxt.pn * tstep : cB;
        for (int t = 0; t < nt; t += 2) {
            const bool last = (t == nt - 2);
            const char* a1 = cA + (size_t)(t + 1) * kstep;
            const char* a2 = last ? nA : cA + (size_t)(t + 2) * kstep; const char* b2 = last ? nB : cB + (size_t)(t + 2) * kstep;
            const char* a3 = a2 + kstep; const char* b3 = b2 + kstep;
            if (last && has_next) S.a_ready(nxt);
            PG8_LDB(B0, 0, 0); PG8_SCHED; PG8_LDA(At, 0, 0); PG8_STAGE(PG8_SA(1, 1), a1 + hstep, voffA);
            PG8_WAIT_L(8); PG8_BAR; PG8_WAIT_L(0); PG8_MMA(0, 0, At, B0); PG8_BAR; PG8_SCHED;
            PG8_LDB(B1, 0, 1); PG8_STAGE(PG8_SB(0, 0), b2, voffB);
            PG8_BAR; PG8_WAIT_L(0); PG8_MMA(0, 1, At, B1); PG8_BAR;
            PG8_LDA(At, 0, 1); PG8_STAGE(PG8_SA(0, 0), a2, voffA);
            PG8_BAR; PG8_WAIT_L(0); PG8_MMA(1, 0, At, B0); PG8_BAR; PG8_SCHED;
            PG8_STAGE(PG8_SB(0, 1), b2 + hstep, voffB);
            PG8_WAIT_V(6); PG8_BAR; PG8_MMA(1, 1, At, B1); PG8_BAR;
            PG8_LDB(B0, 1, 0); PG8_SCHED; PG8_LDA(At, 1, 0); PG8_STAGE(PG8_SA(0, 1), a2 + hstep, voffA);
            PG8_WAIT_L(8); PG8_BAR; PG8_WAIT_L(0); PG8_MMA(0, 0, At, B0); PG8_BAR; PG8_SCHED;
            PG8_LDB(B1, 1, 1); PG8_STAGE(PG8_SB(1, 0), b3, voffB);
            PG8_BAR; PG8_WAIT_L(0); PG8_MMA(0, 1, At, B1); PG8_BAR;
            PG8_LDA(At, 1, 1); PG8_STAGE(PG8_SA(1, 0), a3, voffA);
            PG8_BAR; PG8_WAIT_L(0); PG8_MMA(1, 0, At, B0); PG8_BAR; PG8_SCHED;
            PG8_STAGE(PG8_SB(1, 1), b3 + hstep, voffB);
            PG8_WAIT_V(6); PG8_BAR; PG8_MMA(1, 1, At, B1); PG8_BAR;
        }
        PG8_STAMP();
        if constexpr (!Epi::AFTER_DRAIN) { E(acc, cur, wr, wc, fr, fq); S.done(cur); }
        PG8_STAMP();
        if (!has_next) break;
#pragma unroll
        for (int a = 0; a < 2; ++a)
#pragma unroll
            for (int b = 0; b < 2; ++b)
#pragma unroll
                for (int m = 0; m < 4; ++m)
#pragma unroll
                    for (int n = 0; n < 2; ++n) acc[a][b][m][n] = (f32x4){0.f, 0.f, 0.f, 0.f};
        cur = nxt; cA = nA; cB = nB; ++ui;
    }
    PG8_WAIT_V(0);
    if (wr == 0) PG8_BAR;
    PG8_BAR;
    if constexpr (Epi::AFTER_DRAIN) { E.fused(acc, cur, wr, wc, fr, fq, lds, wid, lane); S.done(cur); }
    PG8_STAMP();
#undef PG8_STAMP
#undef PG8_SA
#undef PG8_SB
#undef PG8_STAGE
#undef PG8_LDA
#undef PG8_LDB
#undef PG8_MMA
#undef PG8_WAIT_V
#undef PG8_WAIT_L
#undef PG8_BAR
#undef PG8_SCHED
}
template <class Epi, class Sched, bool ALIGN_EPI = false, bool SP2 = false>
__device__ __forceinline__ void gemm_phase2(PG8_LAS unsigned char* lds, const Gemm g, const Sched& S, const Epi& E) {
    const int tid = opaque_tid(), wid = __builtin_amdgcn_readfirstlane(tid >> 6), lane = tid & 63, wr = wid >> 2, wc = wid & 3, fr = lane & 15, fq = lane >> 4;
    const int K = g.K, nt = K / BK;
    unsigned voffA[2], voffB[2];
#pragma unroll
    for (int i = 0; i < 2; ++i) { int R, C; stage_rc(tid * 16 + i * 8192, R, C); const int Rb = Epi::PERM ? ((R & ~31) + perm32(R & 31)) : R;
        voffA[i] = (unsigned)(R * K + C) * 2u; voffB[i] = (unsigned)(Rb * K + C) * 2u; }
    const size_t kstep = (size_t)(BK * 2);
    const size_t hstep = (size_t)HALF * K * 2;
    const size_t tstep = 2 * hstep;
    const unsigned ldsw = (unsigned)wid * 1024u;
    const int aoff = lds_byte(wr * 64 + fr, fq * 8), boff = lds_byte(wc * 32 + fr, fq * 8);
#define PG8_SA(b, h) (((b) * 2 + (h)) * HTB)
#define PG8_SB(b, h) ((4 + (b) * 2 + (h)) * HTB)
#define PG8_STAGE(bufoff, gbase, voff) do { _Pragma("unroll") for (int _i = 0; _i < 2; ++_i) \
        __builtin_amdgcn_global_load_lds((const unsigned*)((const char*)(gbase) + (voff)[_i]), (PG8_LAS unsigned*)(lds + (bufoff) + ldsw + _i * 8192), 16, 0, 0); } while (0)
#define PG8_LDA(dst, b, h) do { _Pragma("unroll") for (int m = 0; m < 4; ++m) _Pragma("unroll") for (int k = 0; k < 2; ++k) dst[m][k] = *(const PG8_LAS bf16x8*)(lds + PG8_SA(b, h) + aoff + m * 2048 + k * 1024); } while (0)
#define PG8_LDB(dst, b, h) do { _Pragma("unroll") for (int n = 0; n < 2; ++n) _Pragma("unroll") for (int k = 0; k < 2; ++k) dst[n][k] = *(const PG8_LAS bf16x8*)(lds + PG8_SB(b, h) + boff + n * 2048 + k * 1024); } while (0)
#define PG8_MMA(ai, bj, At, Bt) do { __builtin_amdgcn_s_setprio(1); _Pragma("unroll") for (int m = 0; m < 4; ++m) _Pragma("unroll") for (int n = 0; n < 2; ++n) _Pragma("unroll") for (int k = 0; k < 2; ++k) \
        acc[ai][bj][m][n] = __builtin_amdgcn_mfma_f32_16x16x32_bf16(Bt[n][k], At[m][k], acc[ai][bj][m][n], 0, 0, 0); __builtin_amdgcn_s_setprio(0); } while (0)
#ifdef CPU_TEST
#define PG8_WAIT_V(n) ((void)0)
#define PG8_WAIT_L(n) ((void)0)
#else
#define PG8_WAIT_V(n) asm volatile("s_waitcnt vmcnt(" #n ")" ::: "memory")
#define PG8_WAIT_L(n) asm volatile("s_waitcnt lgkmcnt(" #n ")" ::: "memory")
#endif
#define PG8_BAR __builtin_amdgcn_s_barrier()
#define PG8_SCHED __builtin_amdgcn_sched_barrier(0)
    Unit cur, nxt; int ui = 0;
    if (!S.next(0, cur)) return;
    f32x4 acc[2][2][4][2];
#pragma unroll
    for (int a = 0; a < 2; ++a)
#pragma unroll
        for (int b = 0; b < 2; ++b)
#pragma unroll
            for (int m = 0; m < 4; ++m)
#pragma unroll
                for (int n = 0; n < 2; ++n) acc[a][b][m][n] = (f32x4){0.f, 0.f, 0.f, 0.f};
    bf16x8 At[4][2], B0[2][2], B1[2][2];
    const char* cA = (const char*)g.A + (size_t)cur.pm * tstep; const char* cB = (const char*)g.Bt + (size_t)cur.pn * tstep;
    S.a_ready(cur);
    if constexpr (SP2) {
        PG8_STAGE(PG8_SB(0, 0), cB, voffB); PG8_STAGE(PG8_SB(0, 1), cB + hstep, voffB); PG8_STAGE(PG8_SA(0, 0), cA, voffA); PG8_STAGE(PG8_SA(0, 1), cA + hstep, voffA);
        if (wr == 1) PG8_BAR;
        PG8_WAIT_V(2); PG8_BAR;
        PG8_STAGE(PG8_SB(1, 0), cB + kstep, voffB); PG8_STAGE(PG8_SA(1, 0), cA + kstep, voffA); PG8_STAGE(PG8_SB(1, 1), cB + hstep + kstep, voffB);
        PG8_WAIT_V(6); PG8_BAR;
    } else {
        PG8_STAGE(PG8_SB(0, 0), cB, voffB); PG8_STAGE(PG8_SA(0, 0), cA, voffA); PG8_STAGE(PG8_SB(0, 1), cB + hstep, voffB); PG8_STAGE(PG8_SA(0, 1), cA + hstep, voffA);
        if (wr == 1) PG8_BAR;
        PG8_WAIT_V(4); PG8_BAR;
        PG8_STAGE(PG8_SB(1, 0), cB + kstep, voffB); PG8_STAGE(PG8_SA(1, 0), cA + kstep, voffA); PG8_STAGE(PG8_SB(1, 1), cB + hstep + kstep, voffB);
        PG8_WAIT_V(6); PG8_BAR;
    }
    for (;;) {
        const bool has_next = S.next(ui + 1, nxt);
        const char* nA = has_next ? (const char*)g.A + (size_t)nxt.pm * tstep : cA; const char* nB = has_next ? (const char*)g.Bt + (size_t)nxt.pn * tstep : cB;
        for (int t = 0; t < nt; t += 2) {
            const bool last = (t == nt - 2);
            const char* a1 = cA + (size_t)(t + 1) * kstep;
            const char* a2 = last ? nA : cA + (size_t)(t + 2) * kstep; const char* b2 = last ? nB : cB + (size_t)(t + 2) * kstep;
            const char* a3 = a2 + kstep; const char* b3 = b2 + kstep;
            if (last && has_next) S.a_ready(nxt);
            if constexpr (SP2) {
            PG8_LDB(B0, 0, 0); PG8_LDB(B1, 0, 1); PG8_SCHED; PG8_LDA(At, 0, 0); PG8_STAGE(PG8_SA(1, 1), a1 + hstep, voffA);
            PG8_WAIT_V(8); PG8_WAIT_L(0); PG8_BAR; PG8_MMA(0, 0, At, B0); PG8_MMA(0, 1, At, B1); PG8_BAR; PG8_SCHED;
            PG8_LDA(At, 0, 1); PG8_STAGE(PG8_SB(0, 0), b2, voffB); PG8_STAGE(PG8_SB(0, 1), b2 + hstep, voffB); PG8_STAGE(PG8_SA(0, 0), a2, voffA);
            PG8_WAIT_V(8); PG8_WAIT_L(0); PG8_BAR; PG8_MMA(1, 0, At, B0); PG8_MMA(1, 1, At, B1); PG8_BAR; PG8_SCHED;
            PG8_LDB(B0, 1, 0); PG8_LDB(B1, 1, 1); PG8_SCHED; PG8_LDA(At, 1, 0); PG8_STAGE(PG8_SA(0, 1), a2 + hstep, voffA);
            PG8_WAIT_V(8); PG8_WAIT_L(0); PG8_BAR; PG8_MMA(0, 0, At, B0); PG8_MMA(0, 1, At, B1); PG8_BAR; PG8_SCHED;
            PG8_LDA(At, 1, 1); PG8_STAGE(PG8_SB(1, 0), b3, voffB); PG8_STAGE(PG8_SB(1, 1), b3 + hstep, voffB); PG8_STAGE(PG8_SA(1, 0), a3, voffA);
            PG8_WAIT_V(8); PG8_WAIT_L(0); PG8_BAR; PG8_MMA(1, 0, At, B0); PG8_MMA(1, 1, At, B1); PG8_BAR; PG8_SCHED;
            } else {
            PG8_LDB(B0, 0, 0); PG8_SCHED; PG8_LDA(At, 0, 0); PG8_STAGE(PG8_SA(1, 1), a1 + hstep, voffA);
            PG8_WAIT_L(8); PG8_BAR; PG8_WAIT_L(0); PG8_MMA(0, 0, At, B0); PG8_BAR; PG8_SCHED;
            PG8_LDB(B1, 0, 1); PG8_STAGE(PG8_SB(0, 0), b2, voffB);
            PG8_BAR; PG8_WAIT_L(0); PG8_MMA(0, 1, At, B1); PG8_BAR;
            PG8_LDA(At, 0, 1); PG8_STAGE(PG8_SA(0, 0), a2, voffA);
            PG8_BAR; PG8_WAIT_L(0); PG8_MMA(1, 0, At, B0); PG8_BAR; PG8_SCHED;
            PG8_STAGE(PG8_SB(0, 1), b2 + hstep, voffB);
            PG8_WAIT_V(6); PG8_BAR; PG8_MMA(1, 1, At, B1); PG8_BAR;
            PG8_LDB(B0, 1, 0); PG8_SCHED; PG8_LDA(At, 1, 0); PG8_STAGE(PG8_SA(0, 1), a2 + hstep, voffA);
            PG8_WAIT_L(8); PG8_BAR; PG8_WAIT_L(0); PG8_MMA(0, 0, At, B0); PG8_BAR; PG8_SCHED;
            PG8_LDB(B1, 1, 1); PG8_STAGE(PG8_SB(1, 0), b3, voffB);
            PG8_BAR; PG8_WAIT_L(0); PG8_MMA(0, 1, At, B1); PG8_BAR;
            PG8_LDA(At, 1, 1); PG8_STAGE(PG8_SA(1, 0), a3, voffA);
            PG8_BAR; PG8_WAIT_L(0); PG8_MMA(1, 0, At, B0); PG8_BAR; PG8_SCHED;
            PG8_STAGE(PG8_SB(1, 1), b3 + hstep, voffB);
            PG8_WAIT_V(6); PG8_BAR; PG8_MMA(1, 1, At, B1); PG8_BAR;
            }
        }
        if constexpr (ALIGN_EPI) { if (wr == 0) PG8_BAR; }
        if constexpr (!Epi::AFTER_DRAIN) { E(acc, cur, wr, wc, fr, fq); S.done(cur); }
        if (!has_next) break;
#pragma unroll
        for (int a = 0; a < 2; ++a)
#pragma unroll
            for (int b = 0; b < 2; ++b)
#pragma unroll
                for (int m = 0; m < 4; ++m)
#pragma unroll
                    for (int n = 0; n < 2; ++n) acc[a][b][m][n] = (f32x4){0.f, 0.f, 0.f, 0.f};
        cur = nxt; cA = nA; cB = nB; ++ui;
        if constexpr (ALIGN_EPI) { if (wr == 1) PG8_BAR; }
    }
    PG8_WAIT_V(0);
    if constexpr (!ALIGN_EPI) { if (wr == 0) PG8_BAR; }
    PG8_BAR;
    if constexpr (Epi::AFTER_DRAIN) { E.fused(acc, cur, wr, wc, fr, fq, lds, wid, lane); S.done(cur); }
#undef PG8_SA
#undef PG8_SB
#undef PG8_STAGE
#undef PG8_LDA
#undef PG8_LDB
#undef PG8_MMA
#undef PG8_WAIT_V
#undef PG8_WAIT_L
#undef PG8_BAR
#undef PG8_SCHED
}

}


namespace {
using pg8::bf16_t; using pg8::bf16x8; using pg8::f32x4;
#define LDSP PG8_LAS unsigned char*
constexpr int BATCH = CFG_BATCH, SEQ = CFG_SEQ, DEC_BATCH = CFG_DEC_BATCH, PAST_LEN = CFG_PAST_LEN;
constexpr int D = 1024, DEPTH = 2, DEC_SEQ = 4, PAGE = 128;
constexpr int MH = 4, MW = 512, MHD = 128;
constexpr int HD = 64, NH = 8, NKV = 2;
constexpr int CHID = 128, SELB = 64, SELTOP = 16, WIN = 512;
constexpr int DFF = 2816, INW = 4896, INP = 4864;
constexpr float EPS = 1e-6f, NEG = -1e30f, TINY = 1e-30f;
constexpr int NPT = BATCH * SEQ, NST = DEC_BATCH * DEC_SEQ, NTOK = NPT + NST, NSEQ = BATCH + DEC_BATCH;
constexpr int MPAD = (NTOK + 255) / 256 * 256;
constexpr int N_PAGES = PAST_LEN / PAGE, N_USED = DEC_BATCH * N_PAGES, N_POOL = N_USED + N_USED / 4;
constexpr int WB = (WIN < PAST_LEN ? WIN : PAST_LEN), WP = (WIN < SEQ ? WIN : SEQ);
constexpr int NCP = SEQ / 16 - 1, NCS = (PAST_LEN + DEC_SEQ) / 16 - 1, NCMAX = (NCP > NCS ? NCP : NCS);
constexpr int NBP = (SEQ + 63) / 64, NBS = (PAST_LEN + DEC_SEQ + 63) / 64;
constexpr int ZU = 0, ZV = 512, ZO = 1024, ZIG = 1536, ZFG = 1540, ZQ = 1544, ZKV = 2056, ZNG = 2824, ZGA = 2848, ZGB = 3872;
constexpr size_t O_YP = 0;
constexpr size_t O_YS = O_YP + (size_t)NPT * D;
constexpr size_t O_PKV = O_YS + (size_t)NST * D;
constexpr size_t O_PWIN = O_PKV + (size_t)DEPTH * BATCH * SEQ * 512;
constexpr size_t O_PC = O_PWIN + (size_t)DEPTH * BATCH * WP * 256;
constexpr size_t O_PN = O_PC + (size_t)DEPTH * BATCH * MH * MHD * MHD;
constexpr size_t O_PM = O_PN + (size_t)DEPTH * BATCH * MH * MHD;
constexpr size_t O_PCONV = O_PM + (size_t)DEPTH * BATCH * MH;
constexpr size_t O_SKV = O_PCONV + (size_t)DEPTH * BATCH * 3 * MW;
constexpr size_t O_SWIN = O_SKV + (size_t)DEPTH * DEC_BATCH * DEC_SEQ * 512;
constexpr size_t O_SC = O_SWIN + (size_t)DEPTH * DEC_BATCH * WB * 256;
constexpr size_t O_SN = O_SC + (size_t)DEPTH * DEC_BATCH * MH * MHD * MHD;
constexpr size_t O_SM = O_SN + (size_t)DEPTH * DEC_BATCH * MH * MHD;
constexpr size_t O_SCONV = O_SM + (size_t)DEPTH * DEC_BATCH * MH;
constexpr size_t O_END = O_SCONV + (size_t)DEPTH * DEC_BATCH * 3 * MW;
constexpr int NT = 512;

struct P {
    const float *x_prompt, *x_sample, *cache_kv;
    const int* page_table;
    const float *cache_win, *st_C, *st_n, *st_m, *st_conv, *norm1_g, *w_in, *b_gates, *conv_w, *conv_b, *w_mq, *w_mk, *mnorm_g,
        *pe_k, *pe_v, *w1_k, *w2_k, *w1_v, *w2_v, *w_a, *w_b, *w_out, *norm2_g, *w_up, *w_down, *final_g;
    float* out;
    float *ROPE, *CBIAS, *DC, *DN, *GSUM, *NS, *MS, *X, *Z, *KW, *QR, *CC, *IG, *LF, *QM, *KM, *NUMP, *MT, *HID, *KC, *VC, *PC, *OC, *OS, *OW, *SCORE, *PS, *PW, *MGF;
    bf16_t *XB, *HAB, *HBB, *MGB, *ACTB, *QCB, *QRB, *KSB, *VSB, *KWB, *VWB, *QMB, *KMB, *CSB, *WMQ_T, *WMK_T, *W1T, *W2T, *WSM_T, *SGB, *KCB, *VCB, *WIN_T, *WA_T, *WB_T, *WOUT_T, *WUP_T, *WDOWN_T;
    int* SEL; int* DIAGF; int* QCTR;
    unsigned long long* RSS;
    unsigned* bar;
};

__device__ __forceinline__ float bf2f(bf16_t b) { unsigned u = ((unsigned)b) << 16; float f; __builtin_memcpy(&f, &u, 4); return f; }
__device__ __forceinline__ bf16_t f2bf(float f) { unsigned u; __builtin_memcpy(&u, &f, 4); u += 0x7fffu + ((u >> 16) & 1u); return (bf16_t)(u >> 16); }

struct Tok { int seq, t, pos, b; bool sample; };
__device__ __forceinline__ Tok tokinfo(int tok) {
    Tok r;
    if (tok < NPT) { r.b = tok / SEQ; r.t = tok % SEQ; r.seq = r.b; r.pos = r.t; r.sample = false; }
    else { int q = tok - NPT; r.b = q / DEC_SEQ; r.t = q % DEC_SEQ; r.seq = BATCH + r.b; r.pos = PAST_LEN + r.t; r.sample = true; }
    return r;
}
__device__ __forceinline__ int seq_row0(int seq) { return seq < BATCH ? seq * SEQ : NPT + (seq - BATCH) * DEC_SEQ; }
__device__ __forceinline__ int seq_len(int seq) { return seq < BATCH ? SEQ : DEC_SEQ; }
__device__ __forceinline__ int seq_nc(int seq) { return seq < BATCH ? NCP : NCS; }
__device__ __forceinline__ size_t kc_base(int seq) { return seq < BATCH ? (size_t)seq * NCP : (size_t)BATCH * NCP + (size_t)(seq - BATCH) * NCS; }
constexpr size_t KC_ROWS = (size_t)BATCH * NCP + (size_t)DEC_BATCH * NCS;

__device__ __forceinline__ const float* kvrow(const P& p, int l, int seq, int pos, int j, int g) {
    if (seq < BATCH) return p.out + O_PKV + ((((size_t)l * BATCH + seq) * SEQ + pos) * 4 + j) * 128 + g * 64;
    int b = seq - BATCH;
    if (pos < PAST_LEN) {
        int pg = p.page_table[b * N_PAGES + pos / PAGE];
        return p.cache_kv + ((((size_t)l * N_POOL + pg) * PAGE + pos % PAGE) * 4 + j) * 128 + g * 64;
    }
    return p.out + O_SKV + ((((size_t)l * DEC_BATCH + b) * DEC_SEQ + (pos - PAST_LEN)) * 4 + j) * 128 + g * 64;
}
__device__ __forceinline__ const float* winrow(const P& p, int l, int seq, int pos, int kv, int g) {
    if (seq < BATCH) return p.KW + ((size_t)(seq * SEQ + pos) * 2 + kv) * 128 + g * 64;
    int b = seq - BATCH;
    if (pos < PAST_LEN) return p.cache_win + ((((size_t)l * DEC_BATCH + b) * WB + (pos - (PAST_LEN - WB))) * 2 + kv) * 128 + g * 64;
    return p.KW + ((size_t)(NPT + b * DEC_SEQ + (pos - PAST_LEN)) * 2 + kv) * 128 + g * 64;
}

__device__ __forceinline__ float sigmoidf_(float x) { return 1.f / (1.f + expf(-x)); }
__device__ __forceinline__ float siluf_(float x) { return x / (1.f + expf(-x)); }
__device__ __forceinline__ float log_sigmoidf_(float x) { return fminf(x, 0.f) - log1pf(expf(-fabsf(x))); }
__device__ __forceinline__ float geluf_(float x) { return 0.5f * x * (1.f + tanhf(0.7978845608028654f * (x + 0.044715f * x * x * x))); }
__device__ __forceinline__ float rope_inv(int i) { return powf(500000.0f, -(float)i / 8.0f); }
__device__ __forceinline__ float rope_elem(const float* x, int d, int pos) {
    if (d >= 16) return x[d];
    int i = d & 7;
    float ang = (float)pos * rope_inv(i);
    float c = cosf(ang), s = sinf(ang);
    return d < 8 ? x[d] * c - x[d + 8] * s : x[d] * c + x[d - 8] * s;
}

#define PLOOP(i, n) for (long i = gtid; i < (long)(n); i += gsz)


__device__ __forceinline__ void gemm_items(const float* A, int lda, const float* B, int ldb, float* C, int ldc, int M, int N, int K,
                                           int accumulate, long gtid, long gsz) {
    const int ng = N / 4;
    const long items = (long)(M / 4) * ng;
    for (long it = gtid; it < items; it += gsz) {
        const int mg = (int)(it / ng), n4 = (int)(it % ng) * 4;
        float acc[4][4];
#pragma unroll
        for (int i = 0; i < 4; ++i)
#pragma unroll
            for (int j = 0; j < 4; ++j) acc[i][j] = 0.f;
        const float* a0 = A + (size_t)(mg * 4) * lda;
        const float* b0 = B + n4;
        for (int k = 0; k < K; ++k) {
            const float4 b = *(const float4*)(b0 + (size_t)k * ldb);
#pragma unroll
            for (int i = 0; i < 4; ++i) {
                const float a = a0[(size_t)i * lda + k];
                acc[i][0] += a * b.x; acc[i][1] += a * b.y; acc[i][2] += a * b.z; acc[i][3] += a * b.w;
            }
        }
#pragma unroll
        for (int i = 0; i < 4; ++i) {
            float* c = C + (size_t)(mg * 4 + i) * ldc + n4;
#pragma unroll
            for (int j = 0; j < 4; ++j) c[j] = accumulate ? c[j] + acc[i][j] : acc[i][j];
        }
    }
}


constexpr float QSCALE = 0.125f * 1.4426950408889634f;
#ifdef BISECT_A
constexpr int ML_SEQ0 = 0, ML_TOK0 = 0;
#else
constexpr int ML_SEQ0 = BATCH, ML_TOK0 = NPT;
#endif
constexpr int NSA_TOK0 = NPT;
#define PLOOP_FROM(i, s, n) for (long i = (long)(s) + gtid; i < (long)(n); i += gsz)

constexpr int ROPE_POS = (SEQ > PAST_LEN + DEC_SEQ ? SEQ : PAST_LEN + DEC_SEQ);
constexpr float RSS_SCALE = 16777216.f;
__device__ __forceinline__ float rstd_of(unsigned long long q) { return 1.f / sqrtf((float)q * (1.f / (RSS_SCALE * D)) + EPS); }
__host__ __device__ __forceinline__ int unperm16(int pos) { return pos < 16 ? (pos & 3) + ((pos >> 2) & 1) * 8 + ((pos >> 3) & 1) * 4 : pos; }
__host__ __device__ __forceinline__ int in_col_map(int n) {
    const int tile = n >> 8, cl = n & 255;
    if (tile < 6) return n;
    if (tile < 8) return ZQ + ((tile - 6) * 4 + (cl >> 6)) * 64 + unperm16(cl & 63);
    if (tile == 8) return ZKV + cl;
    if (tile < 11) { const int base = ZKV + (tile - 8) * 256; return cl < 128 ? base + (cl >> 6) * 64 + unperm16(cl & 63) : base + cl; }
    if (tile < 15) return ZGA + (tile - 11) * 256 + cl;
    return ZGB + (tile - 15) * 256 + cl;
}
__host__ __device__ __forceinline__ int up_col_map(int n) { const int c = (n >> 3) * 4 + (n & 3); return ((n >> 2) & 1) * DFF + c; }

#ifdef CPU_TEST
__device__ __forceinline__ float fast_sigmoid(float x) { return 1.f / (1.f + expf(-x)); }
#else
__device__ __forceinline__ float fast_sigmoid(float x) { return __builtin_amdgcn_rcpf(1.f + __builtin_amdgcn_exp2f(-1.4426950408889634f * x)); }
#endif
struct EpiIn {
    static constexpr bool PERM = true, AFTER_DRAIN = false;
    float* Z; const unsigned long long* rss; const float* rope; float* out; bf16_t *QCB, *QRB, *KSB, *VSB, *KWB, *VWB, *SGB; int l;
    __device__ __forceinline__ void operator()(const f32x4 (&acc)[2][2][4][2], const pg8::Unit& u, int wr, int wc, int fr, int fq) const {
#pragma unroll
        for (int ai = 0; ai < 2; ++ai)
#pragma unroll
            for (int m = 0; m < 4; ++m) {
                const int row = u.pm * 256 + ai * 128 + wr * 64 + m * 16 + fr;
                const float rs = rstd_of(rss[row]);
                if (u.pn >= 11) {
#pragma unroll
                    for (int bj = 0; bj < 2; ++bj) {
                        const int c = (u.pn - 11) * 256 + bj * 128 + wc * 32 + fq * 8;
                        const f32x4 v0 = acc[ai][bj][m][0] * rs, v1 = acc[ai][bj][m][1] * rs;
                        pg8::u32x4 o; o[0] = pg8::cvt_pk_bf16(fast_sigmoid(v0[0]), fast_sigmoid(v0[1])); o[1] = pg8::cvt_pk_bf16(fast_sigmoid(v0[2]), fast_sigmoid(v0[3]));
                        o[2] = pg8::cvt_pk_bf16(fast_sigmoid(v1[0]), fast_sigmoid(v1[1])); o[3] = pg8::cvt_pk_bf16(fast_sigmoid(v1[2]), fast_sigmoid(v1[3]));
                        *(pg8::u32x4*)(SGB + (size_t)row * 2048 + c) = o;
                    }
                    continue;
                }
                if (u.pn < 6) {
                    float* zr = Z + (size_t)row * INW;
#pragma unroll
                    for (int bj = 0; bj < 2; ++bj) {
                        const int n0 = u.pn * 256 + bj * 128 + wc * 32 + fq * 8;
                        const int o0 = in_col_map(n0);
                        *(f32x4*)(zr + o0) = acc[ai][bj][m][0] * rs;
                        *(f32x4*)(zr + o0 + 4) = acc[ai][bj][m][1] * rs;
                    }
                    continue;
                }
                if (row >= NTOK) continue;
                const bool sample = row >= NPT;
                const int bb = sample ? (row - NPT) / DEC_SEQ : row / SEQ, tt = sample ? (row - NPT) % DEC_SEQ : row % SEQ, pos = sample ? PAST_LEN + tt : tt;
#pragma unroll
                for (int bj = 0; bj < 2; ++bj) {
                    const int cl = bj * 128 + wc * 32 + fq * 8, hp = cl & 63;
                    f32x4 v0 = acc[ai][bj][m][0] * rs, v1 = acc[ai][bj][m][1] * rs;
                    const bool roped = (u.pn <= 7) || (u.pn >= 9 && cl < 128);
                    f32x4 r0 = v0, r1 = v1;
                    const bool split = roped && hp < 16;
                    const int dl = hp >> 1;
                    if (split) {
                        const f32x4 cs0 = *(const f32x4*)(rope + (size_t)pos * 16 + 2 * dl), cs1 = *(const f32x4*)(rope + (size_t)pos * 16 + 2 * dl + 4);
                        const float c[4] = {cs0[0], cs0[2], cs1[0], cs1[2]}, s[4] = {cs0[1], cs0[3], cs1[1], cs1[3]};
#pragma unroll
                        for (int i = 0; i < 4; ++i) { r0[i] = v0[i] * c[i] - v1[i] * s[i]; r1[i] = v1[i] * c[i] + v0[i] * s[i]; }
                    }
                    const int dA = split ? dl : hp, dB = split ? dl + 8 : hp + 4;
                    if (u.pn <= 7) {
                        const int head = (u.pn - 6) * 4 + (cl >> 6);
                        bf16_t* qc = QCB + (size_t)row * 512 + head * 64; bf16_t* qr = QRB + (size_t)row * 512 + head * 64;
                        uint2 a, b2, c2, d2;
                        a.x = pg8::cvt_pk_bf16(v0[0] * QSCALE, v0[1] * QSCALE); a.y = pg8::cvt_pk_bf16(v0[2] * QSCALE, v0[3] * QSCALE);
                        b2.x = pg8::cvt_pk_bf16(v1[0] * QSCALE, v1[1] * QSCALE); b2.y = pg8::cvt_pk_bf16(v1[2] * QSCALE, v1[3] * QSCALE);
                        c2.x = pg8::cvt_pk_bf16(r0[0] * QSCALE, r0[1] * QSCALE); c2.y = pg8::cvt_pk_bf16(r0[2] * QSCALE, r0[3] * QSCALE);
                        d2.x = pg8::cvt_pk_bf16(r1[0] * QSCALE, r1[1] * QSCALE); d2.y = pg8::cvt_pk_bf16(r1[2] * QSCALE, r1[3] * QSCALE);
                        *(uint2*)(qc + dA) = a; *(uint2*)(qc + dB) = b2; *(uint2*)(qr + dA) = c2; *(uint2*)(qr + dB) = d2;
                    } else {
                        const int j = (u.pn - 8) * 2 + (cl >> 7), g = (cl >> 6) & 1;
                        if (j < 4) {
                            float* o = out + (sample ? O_SKV + ((((size_t)l * DEC_BATCH + bb) * DEC_SEQ + tt) * 4 + j) * 128 : O_PKV + ((((size_t)l * BATCH + bb) * SEQ + tt) * 4 + j) * 128) + g * 64;
                            *(f32x4*)(o + dA) = r0; *(f32x4*)(o + dB) = r1;
                        } else {
                            const int kv = j - 4;
                            if (sample) { float* o = out + O_SWIN + ((((size_t)l * DEC_BATCH + bb) * WB + (WB - DEC_SEQ + tt)) * 2 + kv) * 128 + g * 64; *(f32x4*)(o + dA) = r0; *(f32x4*)(o + dB) = r1; }
                            else if (tt >= SEQ - WP) { float* o = out + O_PWIN + ((((size_t)l * BATCH + bb) * WP + (tt - (SEQ - WP))) * 2 + kv) * 128 + g * 64; *(f32x4*)(o + dA) = r0; *(f32x4*)(o + dB) = r1; }
                        }
                        if (j >= 2) {
                            bf16_t* dstb = (j == 2 ? KSB : (j == 3 ? VSB : (j == 4 ? KWB : VWB))) + ((size_t)g * MPAD + row) * 64;
                            uint2 a, b2; a.x = pg8::cvt_pk_bf16(r0[0], r0[1]); a.y = pg8::cvt_pk_bf16(r0[2], r0[3]); b2.x = pg8::cvt_pk_bf16(r1[0], r1[1]); b2.y = pg8::cvt_pk_bf16(r1[2], r1[3]);
                            *(uint2*)(dstb + dA) = a; *(uint2*)(dstb + dB) = b2;
                        }
                    }
                }
            }
    }
};
template <int SECOND> struct EpiBranch {
    static constexpr bool PERM = true, AFTER_DRAIN = false;
    const bf16_t* SGB; float* MGF; bf16_t* MGB;
    __device__ __forceinline__ void operator()(const f32x4 (&acc)[2][2][4][2], const pg8::Unit& u, int wr, int wc, int fr, int fq) const {
#pragma unroll
        for (int ai = 0; ai < 2; ++ai)
#pragma unroll
            for (int m = 0; m < 4; ++m) {
                const int row = u.pm * 256 + ai * 128 + wr * 64 + m * 16 + fr;
#pragma unroll
                for (int bj = 0; bj < 2; ++bj) {
                    const int c = u.pn * 256 + bj * 128 + wc * 32 + fq * 8;
                    const pg8::u32x4 gs = *(const pg8::u32x4*)(SGB + (size_t)row * 2048 + (SECOND ? 1024 : 0) + c);
                    f32x4 v0, v1;
#pragma unroll
                    for (int i = 0; i < 2; ++i) { v0[2 * i] = acc[ai][bj][m][0][2 * i] * __builtin_bit_cast(float, gs[i] << 16); v0[2 * i + 1] = acc[ai][bj][m][0][2 * i + 1] * __builtin_bit_cast(float, gs[i] & 0xffff0000u);
                        v1[2 * i] = acc[ai][bj][m][1][2 * i] * __builtin_bit_cast(float, gs[2 + i] << 16); v1[2 * i + 1] = acc[ai][bj][m][1][2 * i + 1] * __builtin_bit_cast(float, gs[2 + i] & 0xffff0000u); }
                    bf16_t* mgh = (bf16_t*)MGF + (size_t)row * D + c;
                    if (!SECOND) { pg8::u32x4 o; o[0] = pg8::cvt_pk_bf16(v0[0], v0[1]); o[1] = pg8::cvt_pk_bf16(v0[2], v0[3]); o[2] = pg8::cvt_pk_bf16(v1[0], v1[1]); o[3] = pg8::cvt_pk_bf16(v1[2], v1[3]); *(pg8::u32x4*)mgh = o; }
                    else {
                        const pg8::u32x4 pv = *(const pg8::u32x4*)mgh;
#pragma unroll
                        for (int i = 0; i < 2; ++i) { v0[2 * i] += __builtin_bit_cast(float, pv[i] << 16); v0[2 * i + 1] += __builtin_bit_cast(float, pv[i] & 0xffff0000u); v1[2 * i] += __builtin_bit_cast(float, pv[2 + i] << 16); v1[2 * i + 1] += __builtin_bit_cast(float, pv[2 + i] & 0xffff0000u); }
                        pg8::u32x4 o; o[0] = pg8::cvt_pk_bf16(v0[0], v0[1]); o[1] = pg8::cvt_pk_bf16(v0[2], v0[3]); o[2] = pg8::cvt_pk_bf16(v1[0], v1[1]); o[3] = pg8::cvt_pk_bf16(v1[2], v1[3]);
                        *(pg8::u32x4*)(MGB + (size_t)row * D + c) = o;
                    }
                }
            }
    }
};
struct EpiResid {
    static constexpr bool PERM = true, AFTER_DRAIN = false;
    const float* Xs; float* X; bf16_t* XB; unsigned long long* rss;
    __device__ __forceinline__ void operator()(const f32x4 (&acc)[2][2][4][2], const pg8::Unit& u, int wr, int wc, int fr, int fq) const {
#pragma unroll
        for (int ai = 0; ai < 2; ++ai)
#pragma unroll
            for (int m = 0; m < 4; ++m) {
                const int row = u.pm * 256 + ai * 128 + wr * 64 + m * 16 + fr;
                float ss = 0.f;
#pragma unroll
                for (int bj = 0; bj < 2; ++bj) {
                    const int c = u.pn * 256 + bj * 128 + wc * 32 + fq * 8;
                    float* xp = X + (size_t)row * D + c; const float* xs = Xs + (size_t)row * D + c;
                    f32x4 v0 = *(const f32x4*)xs + acc[ai][bj][m][0], v1 = *(const f32x4*)(xs + 4) + acc[ai][bj][m][1];
                    *(f32x4*)xp = v0; *(f32x4*)(xp + 4) = v1;
                    pg8::u32x4 o; o[0] = pg8::cvt_pk_bf16(v0[0], v0[1]); o[1] = pg8::cvt_pk_bf16(v0[2], v0[3]); o[2] = pg8::cvt_pk_bf16(v1[0], v1[1]); o[3] = pg8::cvt_pk_bf16(v1[2], v1[3]);
                    *(pg8::u32x4*)(XB + (size_t)row * D + c) = o;
#pragma unroll
                    for (int i = 0; i < 4; ++i) ss += v0[i] * v0[i] + v1[i] * v1[i];
                }
                ss += __shfl_xor(ss, 16); ss += __shfl_xor(ss, 32);
                if (fq == 0) atomicAdd(rss + row, (unsigned long long)(ss * RSS_SCALE + 0.5f));
            }
    }
};
struct EpiUp {
    static constexpr bool PERM = true, AFTER_DRAIN = false;
    bf16_t* ACT; const unsigned long long* rss;
    __device__ __forceinline__ void operator()(const f32x4 (&acc)[2][2][4][2], const pg8::Unit& u, int wr, int wc, int fr, int fq) const {
#pragma unroll
        for (int ai = 0; ai < 2; ++ai)
#pragma unroll
            for (int m = 0; m < 4; ++m) {
                const int row = u.pm * 256 + ai * 128 + wr * 64 + m * 16 + fr;
                const float rs = rstd_of(rss[row]);
#pragma unroll
                for (int bj = 0; bj < 2; ++bj) {
                    const int n0 = u.pn * 256 + bj * 128 + wc * 32 + fq * 8;
                    const int c = n0 >> 1;
                    float a[4];
#pragma unroll
                    for (int i = 0; i < 4; ++i) { const float g = acc[ai][bj][m][0][i] * rs, uu = acc[ai][bj][m][1][i] * rs; a[i] = g * fast_sigmoid(g) * uu; }
                    uint2 o; o.x = pg8::cvt_pk_bf16(a[0], a[1]); o.y = pg8::cvt_pk_bf16(a[2], a[3]);
                    *(uint2*)(ACT + (size_t)row * DFF + c) = o;
                }
            }
    }
};

template <int MAP> __device__ __forceinline__ void wconv_tile(const float* src, int ldsrc, const float* gain, bf16_t* dst, int K, int k0, int n0, LDSP lds) {
    PG8_LAS float* tile = (PG8_LAS float*)lds;
    const int tid = opaque_tid();
    {
        const int n4 = (tid & 15) * 4, kk = tid >> 4;
        const int oc = MAP == 1 ? in_col_map(n0 + n4) : (MAP == 2 ? up_col_map(n0 + n4) : n0 + n4);
#pragma unroll
        for (int r = 0; r < 2; ++r) { const int k = kk + 32 * r; f32x4 v = *(const f32x4*)(src + (size_t)(k0 + k) * ldsrc + oc); if (gain) v *= gain[k0 + k]; *(PG8_LAS f32x4*)(tile + k * 68 + n4) = v; }
    }
    __syncthreads();
    {
        const int nn = tid >> 3, k8 = (tid & 7) * 8;
        pg8::u32x4 o;
#pragma unroll
        for (int i = 0; i < 4; ++i) o[i] = pg8::cvt_pk_bf16(tile[(k8 + 2 * i) * 68 + nn], tile[(k8 + 2 * i + 1) * 68 + nn]);
        *(pg8::u32x4*)(dst + (size_t)(n0 + nn) * K + k0 + k8) = o;
    }
    __syncthreads();
}
template <int MAP> __device__ __forceinline__ void wconv_strip(const float* src, int ldsrc, const float* gain, bf16_t* dst, int K, int k0, int n0, LDSP lds) {
    PG8_LAS float* tile = (PG8_LAS float*)lds;
    const int tid = opaque_tid();
    {
        const int n4 = (tid & 15) * 4, kk = tid >> 4;
        f32x4 v[4][2];
#pragma unroll
        for (int t = 0; t < 4; ++t) { const int nb = n0 + 64 * t + n4; const int oc = MAP == 1 ? in_col_map(nb) : (MAP == 2 ? up_col_map(nb) : nb);
#pragma unroll
            for (int r = 0; r < 2; ++r) v[t][r] = *(const f32x4*)(src + (size_t)(k0 + kk + 32 * r) * ldsrc + oc); }
#pragma unroll
        for (int t = 0; t < 4; ++t)
#pragma unroll
            for (int r = 0; r < 2; ++r) { f32x4 x = v[t][r]; if (gain) x *= gain[k0 + kk + 32 * r]; *(PG8_LAS f32x4*)(tile + t * 64 * 68 + (kk + 32 * r) * 68 + n4) = x; }
    }
    __syncthreads();
    {
        const int nn = tid >> 3, k8 = (tid & 7) * 8;
#pragma unroll
        for (int t = 0; t < 4; ++t) { pg8::u32x4 o;
#pragma unroll
            for (int i = 0; i < 4; ++i) o[i] = pg8::cvt_pk_bf16(tile[t * 64 * 68 + (k8 + 2 * i) * 68 + nn], tile[t * 64 * 68 + (k8 + 2 * i + 1) * 68 + nn]);
            *(pg8::u32x4*)(dst + (size_t)(n0 + 64 * t + nn) * K + k0 + k8) = o; }
    }
    __syncthreads();
}
__device__ __forceinline__ void ph_prologue(const P& p, int l_unused, LDSP lds) {
    const int tid_ = opaque_tid(); const long gtid = (long)blockIdx.x * NT + tid_, gsz = (long)gridDim.x * NT;
    for (long i = MPAD + gtid; i < 5L * MPAD; i += gsz) p.RSS[i] = 0ull;
    for (long i = gtid; i < (long)ROPE_POS * 8; i += gsz) { const int pos = (int)(i >> 3), f = (int)(i & 7); const float ang = (float)pos * rope_inv(f); p.ROPE[i * 2] = cosf(ang); p.ROPE[i * 2 + 1] = sinf(ang); }
    for (long i = gtid; i < (long)DEPTH * 32 * D; i += gsz) { const int k = (int)(i % D), j = (int)((i / D) % 32), l2 = (int)(i / (32 * D));
        const int col = j < 4 ? ZIG + j : (j < 8 ? ZFG + j - 4 : ZNG + j - 8);
        p.WSM_T[i] = f2bf(p.norm1_g[l2 * D + k] * p.w_in[((size_t)l2 * D + k) * INW + col]); }
    for (int it = (int)gridDim.x - 1 - (int)blockIdx.x; it < DEPTH * 2; it += gridDim.x) { const int kind = it & 1, l2 = it >> 1;
        const float* pe = (kind ? p.pe_v : p.pe_k) + (size_t)l2 * 2048; const float* w1 = (kind ? p.w1_v : p.w1_k) + (size_t)l2 * 2048 * 128;
        const int e4 = (tid_ & 31) * 4, kr = tid_ >> 5;
        f32x4 s = {0.f, 0.f, 0.f, 0.f};
#pragma unroll 8
        for (int k = kr; k < 2048; k += 16) { const f32x4 w = *(const f32x4*)(w1 + (size_t)k * 128 + e4); s += pe[k] * w; }
#pragma unroll
        for (int c = 0; c < 4; ++c) s[c] += __shfl_xor(s[c], 32);
        PG8_LAS float* red = (PG8_LAS float*)lds;
        if ((tid_ & 63) < 32) *(PG8_LAS f32x4*)(red + (tid_ >> 6) * 128 + e4) = s;
        __syncthreads();
        if (tid_ < 128) { float a = 0.f;
#pragma unroll
            for (int w = 0; w < 8; ++w) a += red[w * 128 + tid_];
            p.CBIAS[(size_t)it * 128 + tid_] = a; }
        __syncthreads(); }
    constexpr int T_IN = (D / 64) * (INP / 256), T_A = (MW / 64) * (D / 256), T_OUT = (D / 64) * (D / 256), T_UP = (D / 64) * (2 * DFF / 256), T_DOWN = (DFF / 64) * (D / 256);
    static_assert(INP % 256 == 0 && D % 256 == 0 && (2 * DFF) % 256 == 0, "strip widths");
    constexpr int T_W1 = 2 * (2048 / 64) * (128 / 64), T_W2 = 2 * (128 / 64) * (64 / 64);
    constexpr int T_MQK = 2 * MH * 4;
    constexpr int T_LAYER = T_IN + 2 * T_A + T_OUT + T_UP + T_DOWN + T_MQK + T_W1 + T_W2;
    for (int t = blockIdx.x; t < DEPTH * T_LAYER; t += gridDim.x) {
        const int l = t / T_LAYER; int r = t % T_LAYER;
        if (r < T_IN) { const int kt = r % (D / 64), nt = r / (D / 64); wconv_strip<1>(p.w_in + (size_t)l * D * INW, INW, p.norm1_g + l * D, p.WIN_T + (size_t)l * INP * D, D, kt * 64, nt * 256, lds); continue; }
        r -= T_IN;
        if (r < T_A) { const int kt = r % (MW / 64), nt = r / (MW / 64); wconv_strip<0>(p.w_a + (size_t)l * MW * D, D, nullptr, p.WA_T + (size_t)l * D * MW, MW, kt * 64, nt * 256, lds); continue; }
        r -= T_A;
        if (r < T_A) { const int kt = r % (MW / 64), nt = r / (MW / 64); wconv_strip<0>(p.w_b + (size_t)l * MW * D, D, nullptr, p.WB_T + (size_t)l * D * MW, MW, kt * 64, nt * 256, lds); continue; }
        r -= T_A;
        if (r < T_OUT) { const int kt = r % (D / 64), nt = r / (D / 64); wconv_strip<0>(p.w_out + (size_t)l * D * D, D, nullptr, p.WOUT_T + (size_t)l * D * D, D, kt * 64, nt * 256, lds); continue; }
        r -= T_OUT;
        if (r < T_UP) { const int kt = r % (D / 64), nt = r / (D / 64); wconv_strip<2>(p.w_up + (size_t)l * D * 2 * DFF, 2 * DFF, p.norm2_g + l * D, p.WUP_T + (size_t)l * 2 * DFF * D, D, kt * 64, nt * 256, lds); continue; }
        r -= T_UP;
        if (r >= T_DOWN + T_MQK) { r -= T_DOWN + T_MQK;
            if (r < T_W1) { const int kind = r / (T_W1 / 2), q = r % (T_W1 / 2), kt = q % 32, nt = q / 32;
                wconv_tile<0>((kind ? p.w1_v : p.w1_k) + (size_t)l * 2048 * 128, 128, nullptr, p.W1T + ((size_t)l * 2 + kind) * 128 * 2048, 2048, kt * 64, nt * 64, lds); }
            else { r -= T_W1; const int kind = r / 2, kt = r & 1;
                wconv_tile<0>((kind ? p.w2_v : p.w2_k) + (size_t)l * 128 * 64, 64, nullptr, p.W2T + ((size_t)l * 2 + kind) * 64 * 128, 128, kt * 64, 0, lds); }
            continue; }
        if (r >= T_DOWN) { r -= T_DOWN; const int which = r / (MH * 4), hd = (r / 4) % MH, kt = r & 1, nt = (r >> 1) & 1;
            wconv_tile<0>((which ? p.w_mk : p.w_mq) + ((size_t)l * MH + hd) * MHD * MHD, MHD, nullptr, (which ? p.WMK_T : p.WMQ_T) + ((size_t)l * MH + hd) * MHD * MHD, MHD, kt * 64, nt * 64, lds); continue; }
        { const int kt = r % (DFF / 64), nt = r / (DFF / 64); wconv_strip<0>(p.w_down + (size_t)l * DFF * D, D, nullptr, p.WDOWN_T + (size_t)l * D * DFF, DFF, kt * 64, nt * 256, lds); }
    }
    const int wave = tid_ >> 6, lane = tid_ & 63;
    for (int row = blockIdx.x * 8 + wave; row < MPAD; row += gridDim.x * 8) {
        float ss = 0.f;
        for (int c = lane * 4; c < D; c += 256) {
            float4 v = make_float4(0.f, 0.f, 0.f, 0.f);
            if (row < NTOK) v = *(const float4*)((row < NPT ? p.x_prompt + (size_t)row * D : p.x_sample + (size_t)(row - NPT) * D) + c);
            uint2 o; o.x = pg8::cvt_pk_bf16(v.x, v.y); o.y = pg8::cvt_pk_bf16(v.z, v.w);
            *(uint2*)(p.XB + (size_t)row * D + c) = o;
            ss += v.x * v.x + v.y * v.y + v.z * v.z + v.w * v.w;
        }
#pragma unroll
        for (int s = 32; s >= 1; s >>= 1) ss += __shfl_xor(ss, s);
        if (lane == 0) p.RSS[row] = (unsigned long long)(ss * RSS_SCALE + 0.5f);
    }
}

#ifndef GP_ALIGN
#define GP_ALIGN true
#endif
#ifndef GP_SP2
#define GP_SP2 true
#endif
__device__ __forceinline__ void ph_gemm_in(const P& p, int l, LDSP lds) {
    pg8::Gemm g{p.XB, p.WIN_T + (size_t)l * INP * D, MPAD, INP, D};
    pg8::StaticOrder S; S.init(MPAD, INP, gridDim.x, blockIdx.x);
    EpiIn E{p.Z, p.RSS + (size_t)(2 * l) * MPAD, p.ROPE, p.out, p.QCB, p.QRB, p.KSB, p.VSB, p.KWB, p.VWB, p.SGB, l};
    pg8::gemm_phase2<EpiIn, pg8::StaticOrder, GP_ALIGN, GP_SP2>(lds, g, S, E);
}
__device__ __forceinline__ void ph_small(const P& p, int l, long gtid, long gsz) {
    PLOOP(i, (size_t)NTOK * 32) {
        const int tok = (int)(i >> 5), j = (int)(i & 31);
        const int col = j < 4 ? ZIG + j : (j < 8 ? ZFG + j - 4 : ZNG + j - 8);
        const float* x = p.X + (size_t)tok * D; const float* w = p.w_in + (size_t)l * D * INW + col; const float* g = p.norm1_g + l * D;
        float acc = 0.f;
        for (int k = 0; k < D; ++k) acc += x[k] * g[k] * w[(size_t)k * INW];
        p.Z[(size_t)tok * INW + col] = acc * rstd_of(p.RSS[(size_t)(2 * l) * MPAD + tok]);
    }
}
constexpr int TAIL_ROWS = MPAD - NPT;
static_assert(NPT % 256 == 0 && TAIL_ROWS % 64 == 0 && D % 32 == 0, "tail tiling");
template <int KDIM> __device__ __forceinline__ void tail_partial(f32x4 (&acc)[8], const bf16_t* A, const bf16_t* W, int row0, int col0, int wv, int lr, int kq) {
    constexpr int KW = KDIM / 8; static_assert(KW % 32 == 0, "K slice per wave");
    const bf16_t* ap = A + (size_t)(row0 + lr) * KDIM + wv * KW + 8 * kq; const bf16_t* wp = W + (size_t)(col0 + lr) * KDIM + wv * KW + 8 * kq;
#pragma unroll
    for (int t = 0; t < 8; ++t) acc[t] = f32x4{0.f, 0.f, 0.f, 0.f};
#pragma unroll 2
    for (int s = 0; s < KW / 32; ++s) {
        bf16x8 af[4], wf[2];
#pragma unroll
        for (int a = 0; a < 4; ++a) af[a] = *(const bf16x8*)(ap + (size_t)a * 16 * KDIM + 32 * s);
#pragma unroll
        for (int b = 0; b < 2; ++b) wf[b] = *(const bf16x8*)(wp + (size_t)b * 16 * KDIM + 32 * s);
#pragma unroll
        for (int b = 0; b < 2; ++b)
#pragma unroll
            for (int a = 0; a < 4; ++a) acc[b * 4 + a] = __builtin_amdgcn_mfma_f32_16x16x32_bf16(af[a], wf[b], acc[b * 4 + a], 0, 0, 0);
    }
}
__device__ __forceinline__ f32x4 tail_reduce(LDSP lds, const f32x4 (&acc)[8], int wv, int lane) {
    PG8_LAS float* rb = (PG8_LAS float*)lds;
    __syncthreads();
#pragma unroll
    for (int t = 0; t < 8; ++t)
#pragma unroll
        for (int i = 0; i < 4; ++i) rb[(wv * 32 + t * 4 + i) * 64 + lane] = acc[t][i];
    __syncthreads();
    f32x4 r = {0.f, 0.f, 0.f, 0.f};
#pragma unroll
    for (int v = 0; v < 8; ++v)
#pragma unroll
        for (int i = 0; i < 4; ++i) r[i] += rb[(v * 32 + wv * 4 + i) * 64 + lane];
    return r;
}
#define TAIL_LOOP const int tid = opaque_tid(), wv = tid >> 6, lane = tid & 63, lr = tid & 15, kq = (tid >> 4) & 3; \
    for (int t = blockIdx.x; t < (TAIL_ROWS / 64) * (D / 32); t += gridDim.x) { const int rowb = NPT + (t / (D / 32)) * 64, colb = (t % (D / 32)) * 32, row0 = rowb + (wv & 3) * 16, col0 = colb + (wv >> 2) * 16;
template <int KDIM, bool FIRST> __device__ __forceinline__ void tail_resid(LDSP lds, const bf16_t* A, const bf16_t* W, const float* Xs, float* X, bf16_t* XB, unsigned long long* rss) {
    TAIL_LOOP
        f32x4 acc[8]; tail_partial<KDIM>(acc, A, W, rowb, colb, wv, lr, kq);
        const f32x4 a = tail_reduce(lds, acc, wv, lane);
#pragma unroll
        for (int i = 0; i < 4; ++i) { const int row = row0 + 4 * kq + i; const size_t o = (size_t)row * D + col0 + lr;
            const float x = ((FIRST && row >= NTOK) ? 0.f : Xs[o]) + a[i]; X[o] = x; XB[o] = f2bf(x);
            float ss = x * x; ss += __shfl_xor(ss, 1); ss += __shfl_xor(ss, 2); ss += __shfl_xor(ss, 4); ss += __shfl_xor(ss, 8);
            if (lr == 0) atomicAdd(rss + row, (unsigned long long)(ss * RSS_SCALE + 0.5f)); }
    }
}
__device__ __forceinline__ void tail_branch(const P& p, int l, LDSP lds) {
    TAIL_LOOP
        f32x4 acc[8]; tail_partial<MW>(acc, p.HAB, p.WA_T + (size_t)l * D * MW, rowb, colb, wv, lr, kq);
        const f32x4 a = tail_reduce(lds, acc, wv, lane);
        tail_partial<MW>(acc, p.HBB, p.WB_T + (size_t)l * D * MW, rowb, colb, wv, lr, kq);
        const f32x4 b = tail_reduce(lds, acc, wv, lane);
#pragma unroll
        for (int i = 0; i < 4; ++i) { const int row = row0 + 4 * kq + i, c = col0 + lr;
            const float v = a[i] * bf2f(p.SGB[(size_t)row * 2048 + c]) + b[i] * bf2f(p.SGB[(size_t)row * 2048 + 1024 + c]);
            p.MGB[(size_t)row * D + c] = f2bf(v); }
    }
}
__device__ __forceinline__ void ph_gemm_branch(const P& p, int l, LDSP lds) {
    pg8::StaticOrder S; S.init(NPT, D, gridDim.x, blockIdx.x);
    { pg8::Gemm g{p.HAB, p.WA_T + (size_t)l * D * MW, NPT, D, MW}; EpiBranch<0> E{p.SGB, p.MGF, p.MGB}; pg8::gemm_phase2<EpiBranch<0>, pg8::StaticOrder, GP_ALIGN, GP_SP2>(lds, g, S, E); }
    __syncthreads();
    { pg8::Gemm g{p.HBB, p.WB_T + (size_t)l * D * MW, NPT, D, MW}; EpiBranch<1> E{p.SGB, p.MGF, p.MGB}; pg8::gemm_phase2<EpiBranch<1>, pg8::StaticOrder, GP_ALIGN, GP_SP2>(lds, g, S, E); }
    tail_branch(p, l, lds);
}
__device__ __forceinline__ void ph_gemm_out(const P& p, int l, LDSP lds) {
    pg8::Gemm g{p.MGB, p.WOUT_T + (size_t)l * D * D, NPT, D, D};
    pg8::StaticOrder S; S.init(NPT, D, gridDim.x, blockIdx.x);
    EpiResid E{l == 0 ? p.x_prompt : p.X, p.X, p.XB, p.RSS + (size_t)(2 * l + 1) * MPAD};
    pg8::gemm_phase2<EpiResid, pg8::StaticOrder, GP_ALIGN, GP_SP2>(lds, g, S, E);
    if (l == 0) tail_resid<D, true>(lds, p.MGB, p.WOUT_T + (size_t)l * D * D, p.x_sample - (size_t)NPT * D, p.X, p.XB, p.RSS + (size_t)(2 * l + 1) * MPAD);
    else tail_resid<D, false>(lds, p.MGB, p.WOUT_T + (size_t)l * D * D, p.X, p.X, p.XB, p.RSS + (size_t)(2 * l + 1) * MPAD);
}
__device__ __forceinline__ void swin_shift_light(const P& p, int l, int nunits) {
    const int G = (int)gridDim.x, nfull = nunits % G;
    const int nl = nfull ? G - nfull : G, li = nfull ? (int)blockIdx.x - nfull : (int)blockIdx.x;
    if (li < 0) return;
    constexpr unsigned PER_B = (unsigned)(WB - DEC_SEQ) * 64u, NV = (unsigned)DEC_BATCH * PER_B;
    const unsigned stride = (unsigned)nl * NT;
    const float4* src0 = (const float4*)(p.cache_win + (size_t)l * DEC_BATCH * WB * 256 + DEC_SEQ * 256); float4* dst0 = (float4*)(p.out + O_SWIN + (size_t)l * DEC_BATCH * WB * 256);
    for (unsigned i0 = (unsigned)li * NT + (unsigned)opaque_tid(); i0 < NV; i0 += 8u * stride) {
        float4 v0, v1, v2, v3, v4, v5, v6, v7;
#define SWL(u, v) { const unsigned i = i0 + u * stride; if (i < NV) v = src0[(size_t)(i / PER_B) * (WB * 64) + i % PER_B]; }
        SWL(0u, v0) SWL(1u, v1) SWL(2u, v2) SWL(3u, v3) SWL(4u, v4) SWL(5u, v5) SWL(6u, v6) SWL(7u, v7)
#undef SWL
#define SWS(u, v) { const unsigned i = i0 + u * stride; if (i < NV) dst0[(size_t)(i / PER_B) * (WB * 64) + i % PER_B] = v; }
        SWS(0u, v0) SWS(1u, v1) SWS(2u, v2) SWS(3u, v3) SWS(4u, v4) SWS(5u, v5) SWS(6u, v6) SWS(7u, v7)
#undef SWS
    }
}
__device__ __forceinline__ void ph_gemm_up(const P& p, int l, LDSP lds) {
    pg8::Gemm g{p.XB, p.WUP_T + (size_t)l * 2 * DFF * D, MPAD, 2 * DFF, D};
    pg8::StaticOrder S; S.init(MPAD, 2 * DFF, gridDim.x, blockIdx.x);
    EpiUp E{p.ACTB, p.RSS + (size_t)(2 * l + 1) * MPAD};
    pg8::gemm_phase2<EpiUp, pg8::StaticOrder, GP_ALIGN, GP_SP2>(lds, g, S, E);
    swin_shift_light(p, l, (MPAD / 256) * (2 * DFF / 256));
}
__device__ __forceinline__ void ph_gemm_down(const P& p, int l, LDSP lds) {
    pg8::Gemm g{p.ACTB, p.WDOWN_T + (size_t)l * D * DFF, NPT, D, DFF};
    pg8::StaticOrder S; S.init(NPT, D, gridDim.x, blockIdx.x);
    EpiResid E{p.X, p.X, p.XB, p.RSS + (size_t)(2 * l + 2) * MPAD};
    pg8::gemm_phase2<EpiResid, pg8::StaticOrder, GP_ALIGN, GP_SP2>(lds, g, S, E);
    tail_resid<DFF, false>(lds, p.ACTB, p.WDOWN_T + (size_t)l * D * DFF, p.X, p.X, p.XB, p.RSS + (size_t)(2 * l + 2) * MPAD);
}
__device__ __forceinline__ void ph_final(const P& p, int l, long gtid, long gsz) {
    constexpr unsigned NV = (unsigned)((size_t)NTOK * D / 4);
    const unsigned stride = (unsigned)gsz;
    for (unsigned i0 = (unsigned)gtid; i0 < NV; i0 += 4u * stride) {
        float4 x0, x1, x2, x3; unsigned long long r0 = 0, r1 = 0, r2 = 0, r3 = 0;
#define FL(u, vv, r) { const unsigned i = i0 + u * stride; if (i < NV) { vv = *(const float4*)(p.X + (size_t)i * 4); r = p.RSS[(size_t)(2 * DEPTH) * MPAD + i / (D / 4)]; } }
        FL(0u, x0, r0) FL(1u, x1, r1) FL(2u, x2, r2) FL(3u, x3, r3)
#undef FL
#define FS(u, vv, r) { const unsigned i = i0 + u * stride; if (i < NV) { const float rs = rstd_of(r); const float4 g = *(const float4*)(p.final_g + (i % (D / 4)) * 4); \
            *(float4*)(p.out + (size_t)i * 4) = make_float4(vv.x * rs * g.x, vv.y * rs * g.y, vv.z * rs * g.z, vv.w * rs * g.w); } }
        FS(0u, x0, r0) FS(1u, x1, r1) FS(2u, x2, r2) FS(3u, x3, r3)
#undef FS
    }
}

__device__ __forceinline__ void ph_kv(const P& p, int l, long gtid, long gsz) {
    PLOOP(i, (size_t)NTOK * 768) {
        int tok = (int)(i / 768), c = (int)(i % 768);
        int j = c / 128, g = (c % 128) / 64, d = c % 64;
        Tok ti = tokinfo(tok);
        const float* x = p.Z + (size_t)tok * INW + ZKV + j * 128 + g * 64;
        float v = (j == 2 || j == 4) ? rope_elem(x, d, ti.pos) : x[d];
        if (j >= 2) { bf16_t* dstb = (j == 2 ? p.KSB : (j == 3 ? p.VSB : (j == 4 ? p.KWB : p.VWB))); dstb[((size_t)g * MPAD + tok) * 64 + d] = f2bf(v); }
        if (j < 4) {
            size_t o = ti.sample ? O_SKV + ((((size_t)l * DEC_BATCH + ti.b) * DEC_SEQ + ti.t) * 4 + j) * 128 + g * 64 + d
                                 : O_PKV + ((((size_t)l * BATCH + ti.b) * SEQ + ti.t) * 4 + j) * 128 + g * 64 + d;
            p.out[o] = v;
        } else {
            int kv = j - 4;
            p.KW[((size_t)tok * 2 + kv) * 128 + g * 64 + d] = v;
            if (ti.sample) {
                p.out[O_SWIN + ((((size_t)l * DEC_BATCH + ti.b) * WB + (WB - DEC_SEQ + ti.t)) * 2 + kv) * 128 + g * 64 + d] = v;
            } else if (ti.t >= SEQ - WP) {
                p.out[O_PWIN + ((((size_t)l * BATCH + ti.b) * WP + (ti.t - (SEQ - WP))) * 2 + kv) * 128 + g * 64 + d] = v;
            }
        }
    }
}
__device__ __forceinline__ void ph_swin_copy(const P& p, int l, long gtid, long gsz) {
    PLOOP(i, (size_t)DEC_BATCH * (WB - DEC_SEQ) * 256) {
        int b = (int)(i / ((WB - DEC_SEQ) * 256)); int r = (int)(i % ((WB - DEC_SEQ) * 256));
        p.out[O_SWIN + ((size_t)l * DEC_BATCH + b) * WB * 256 + r] = p.cache_win[((size_t)l * DEC_BATCH + b) * WB * 256 + DEC_SEQ * 256 + r];
    }
}
__device__ __forceinline__ void ph_qrot(const P& p, int l, long gtid, long gsz) {
    PLOOP(i, (size_t)NTOK * 512) {
        int tok = (int)(i / 512), c = (int)(i % 512); int h = c / 64, d = c % 64;
        Tok ti = tokinfo(tok);
        p.QR[i] = rope_elem(p.Z + (size_t)tok * INW + ZQ + h * 64, d, ti.pos);
        p.QRB[i] = f2bf(p.QR[i] * QSCALE); p.QCB[i] = f2bf(p.Z[(size_t)tok * INW + ZQ + h * 64 + d] * QSCALE);
    }
}
__device__ __forceinline__ float conv_u(const P& p, int l, const Tok& ti, int tok, int dt, int c) {
    int t = ti.t + dt;
    if (t >= 0) return p.Z[(size_t)(tok + dt) * INW + ZU + c];
    if (!ti.sample) return 0.f;
    return p.st_conv[(((size_t)l * DEC_BATCH + ti.b) * 3 + (3 + t)) * MW + c];
}
__device__ __forceinline__ void ph_conv(const P& p, int l, long gtid, long gsz) {
    PLOOP_FROM(i, (size_t)ML_TOK0 * 512, (size_t)NTOK * 512) {
        int tok = (int)(i / 512), c = (int)(i % 512);
        Tok ti = tokinfo(tok);
        float y = p.conv_b[l * MW + c];
#pragma unroll
        for (int j = 0; j < 4; ++j) y += conv_u(p, l, ti, tok, j - 3, c) * p.conv_w[((size_t)l * 4 + j) * MW + c];
        p.CC[i] = siluf_(y);
    }
    PLOOP(i, (size_t)NSEQ * 3 * 512) {
        int seq = (int)(i / 1536), r = (int)((i % 1536) / 512), c = (int)(i % 512);
        int T = seq_len(seq), row0 = seq_row0(seq);
        Tok ti = tokinfo(row0 + T - 1);
        float v = conv_u(p, l, ti, row0 + T - 1, r - 2, c);
        if (seq < BATCH) p.out[O_PCONV + (((size_t)l * BATCH + seq) * 3 + r) * MW + c] = v;
        else p.out[O_SCONV + (((size_t)l * DEC_BATCH + (seq - BATCH)) * 3 + r) * MW + c] = v;
    }
    PLOOP(i, (size_t)NTOK * 4) {
        int tok = (int)(i / 4), h = (int)(i % 4);
        p.IG[i] = p.Z[(size_t)tok * INW + ZIG + h] + p.b_gates[l * 8 + h];
        p.LF[i] = log_sigmoidf_(p.Z[(size_t)tok * INW + ZFG + h] + p.b_gates[l * 8 + 4 + h]);
    }
}
__device__ __forceinline__ void ph_mqk(const P& p, int l, long gtid, long gsz) {
    for (int h = 0; h < MH; ++h) {
        gemm_items(p.CC + (size_t)ML_TOK0 * MW + h * MHD, MW, p.w_mq + ((size_t)l * MH + h) * MHD * MHD, MHD, p.QM + (size_t)ML_TOK0 * MW + h * MHD, MW, NTOK - ML_TOK0, MHD, MHD, 0, gtid, gsz);
        gemm_items(p.CC + (size_t)ML_TOK0 * MW + h * MHD, MW, p.w_mk + ((size_t)l * MH + h) * MHD * MHD, MHD, p.KM + (size_t)ML_TOK0 * MW + h * MHD, MW, NTOK - ML_TOK0, MHD, MHD, 0, gtid, gsz);
    }
}
__device__ __forceinline__ void ph_mlstm(const P& p, int l, long gtid, long gsz) {
    PLOOP_FROM(it, (size_t)ML_SEQ0 * MH * 4 * 129, (size_t)NSEQ * MH * 4 * 129) {
        int e = (int)(it % 129); int part = (int)((it / 129) % 4); int h = (int)((it / (129 * 4)) % MH); int seq = (int)(it / (129 * 4 * MH));
        int T = seq_len(seq), row0 = seq_row0(seq);
        bool sample = seq >= BATCH; int b = sample ? seq - BATCH : seq;
        float C[32]; float m = 0.f;
#pragma unroll
        for (int i = 0; i < 32; ++i) C[i] = 0.f;
        if (sample) {
            m = p.st_m[((size_t)l * DEC_BATCH + b) * MH + h];
#pragma unroll
            for (int i = 0; i < 32; ++i) {
                int d = part * 32 + i;
                C[i] = e < 128 ? p.st_C[((((size_t)l * DEC_BATCH + b) * MH + h) * MHD + d) * MHD + e] : p.st_n[(((size_t)l * DEC_BATCH + b) * MH + h) * MHD + d];
            }
        }
        for (int t = 0; t < T; ++t) {
            int tok = row0 + t;
            float ig = p.IG[tok * 4 + h], lf = p.LF[tok * 4 + h];
            float mn = fmaxf(lf + m, ig);
            float dec = expf(lf + m - mn), w = expf(ig - mn);
            m = mn;
            float ve = e < 128 ? p.Z[(size_t)tok * INW + ZV + h * MHD + e] : 1.f;
            float wv = w * ve, acc = 0.f;
            const float* kk = p.KM + (size_t)tok * MW + h * MHD + part * 32;
            const float* qq = p.QM + (size_t)tok * MW + h * MHD + part * 32;
#pragma unroll
            for (int i = 0; i < 32; ++i) {
                C[i] = dec * C[i] + wv * (kk[i] * 0.08838834764831845f);
                acc += qq[i] * C[i];
            }
            p.NUMP[(((size_t)tok * MH + h) * 4 + part) * 129 + e] = acc;
            if (e == 0 && part == 0) p.MT[tok * 4 + h] = m;
        }
        size_t oC = sample ? O_SC + (((size_t)l * DEC_BATCH + b) * MH + h) * MHD * MHD : O_PC + (((size_t)l * BATCH + b) * MH + h) * MHD * MHD;
        size_t oN = sample ? O_SN + (((size_t)l * DEC_BATCH + b) * MH + h) * MHD : O_PN + (((size_t)l * BATCH + b) * MH + h) * MHD;
        size_t oM = sample ? O_SM + ((size_t)l * DEC_BATCH + b) * MH + h : O_PM + ((size_t)l * BATCH + b) * MH + h;
#pragma unroll
        for (int i = 0; i < 32; ++i) {
            int d = part * 32 + i;
            if (e < 128) p.out[oC + (size_t)d * MHD + e] = C[i]; else p.out[oN + d] = C[i];
        }
        if (e == 0 && part == 0) p.out[oM] = m;
    }
}
__device__ __forceinline__ void ph_ha(const P& p, int l, long gtid, long gsz) {
    PLOOP_FROM(it, (size_t)ML_TOK0 * MH, (size_t)NTOK * MH) {
        int tok = (int)(it / MH), h = (int)(it % MH);
        const float* np_ = p.NUMP + (size_t)it * 4 * 129;
        float den = np_[128] + np_[129 + 128] + np_[2 * 129 + 128] + np_[3 * 129 + 128];
        float dn = fmaxf(fabsf(den), expf(-p.MT[it]));
        float ss = 0.f;
        for (int e = 0; e < MHD; ++e) { float hv = (np_[e] + np_[129 + e] + np_[2 * 129 + e] + np_[3 * 129 + e]) / dn; ss += hv * hv; }
        float r = 1.f / sqrtf(ss / MHD + EPS);
        for (int e = 0; e < MHD; ++e) {
            float hv = (np_[e] + np_[129 + e] + np_[2 * 129 + e] + np_[3 * 129 + e]) / dn;
            float o = p.Z[(size_t)tok * INW + ZO + h * MHD + e];
            p.HAB[(size_t)tok * MW + h * MHD + e] = f2bf(hv * r * p.mnorm_g[l * MW + h * MHD + e] * sigmoidf_(o));
        }
    }
}
__device__ __forceinline__ void cmp_item(long item, int& seq, int& n, int& g, int& kind) {
    kind = (int)(item & 1); g = (int)((item >> 1) & 1); long r = item >> 2;
    if (r < (long)BATCH * NCP) { seq = (int)(r / NCP); n = (int)(r % NCP); }
    else { r -= (long)BATCH * NCP; seq = BATCH + (int)(r / NCS); n = (int)(r % NCS); }
}
__device__ __forceinline__ void ph_cmp_hid(const P& p, int l, long gtid, long gsz) {
    PLOOP(i, KC_ROWS * 4 * CHID) {
        long item = i / CHID; int e = (int)(i % CHID);
        int seq, n, g, kind; cmp_item(item, seq, n, g, kind);
        const float* pe = (kind ? p.pe_v : p.pe_k) + (size_t)l * 32 * 64;
        const float* w1 = (kind ? p.w1_v : p.w1_k) + (size_t)l * 32 * 64 * CHID;
        float acc = 0.f;
        for (int r = 0; r < 32; ++r) {
            const float* row = kvrow(p, l, seq, n * 16 + r, kind, g);
            for (int d = 0; d < 64; ++d) acc += (row[d] + pe[r * 64 + d]) * w1[((size_t)r * 64 + d) * CHID + e];
        }
        p.HID[i] = geluf_(acc);
    }
}
__device__ __forceinline__ void ph_cmp_out(const P& p, int l, long gtid, long gsz) {
    PLOOP(i, KC_ROWS * 4 * 64) {
        long item = i / 64; int f = (int)(i % 64);
        int seq, n, g, kind; cmp_item(item, seq, n, g, kind);
        const float* w2 = (kind ? p.w2_v : p.w2_k) + (size_t)l * CHID * 64;
        float acc = 0.f;
        for (int e = 0; e < CHID; ++e) acc += p.HID[item * CHID + e] * w2[e * 64 + f];
        (kind ? p.VC : p.KC)[((kc_base(seq) + n) * 2 + g) * 64 + f] = acc;
    }
}
__device__ __forceinline__ void ph_sc(const P& p, int l, long gtid, long gsz) {
    PLOOP_FROM(i, (size_t)NSA_TOK0 * NH * NCMAX, (size_t)NTOK * NH * NCMAX) {
        int n = (int)(i % NCMAX); int h = (int)((i / NCMAX) % NH); int tok = (int)(i / ((long)NCMAX * NH));
        Tok ti = tokinfo(tok);
        int nc = seq_nc(ti.seq);
        float s = NEG;
        if (n < nc && n * 16 + 31 <= ti.pos) {
            const float* q = p.Z + (size_t)tok * INW + ZQ + h * 64;
            const float* k = p.KC + ((kc_base(ti.seq) + n) * 2 + h / 4) * 64;
            float acc = 0.f;
            for (int d = 0; d < 64; ++d) acc += q[d] * k[d];
            s = acc * 0.125f;
        }
        p.PC[i] = s;
    }
}
__device__ __forceinline__ void softmax_row(float* s, int len) {
    float mx = NEG;
    for (int i = 0; i < len; ++i) mx = fmaxf(mx, s[i]);
    float sum = 0.f;
    for (int i = 0; i < len; ++i) { if (s[i] > 0.5f * NEG) sum += expf(s[i] - mx); }
    float inv = 1.f / fmaxf(sum, TINY);
    for (int i = 0; i < len; ++i) s[i] = (s[i] > 0.5f * NEG) ? expf(s[i] - mx) * inv : 0.f;
}
__device__ __forceinline__ void ph_sc_softmax(const P& p, int l, long gtid, long gsz) {
    PLOOP_FROM(i, (size_t)NSA_TOK0 * NH, (size_t)NTOK * NH) softmax_row(p.PC + (size_t)i * NCMAX, NCMAX);
}
__device__ __forceinline__ void ph_oc(const P& p, int l, long gtid, long gsz) {
    PLOOP_FROM(i, (size_t)NSA_TOK0 * 512, (size_t)NTOK * 512) {
        int tok = (int)(i / 512), h = (int)((i % 512) / 64), d = (int)(i % 64);
        Tok ti = tokinfo(tok); int nc = seq_nc(ti.seq);
        const float* pc = p.PC + ((size_t)tok * NH + h) * NCMAX;
        float acc = 0.f;
        for (int n = 0; n < nc; ++n) acc += pc[n] * p.VC[((kc_base(ti.seq) + n) * 2 + h / 4) * 64 + d];
        p.OC[i] = acc;
    }
}
__device__ __forceinline__ void ph_select(const P& p, int l, long gtid, long gsz) {
    PLOOP_FROM(i, (size_t)NSA_TOK0 * NKV, (size_t)NTOK * NKV) {
        int tok = (int)(i / NKV), g = (int)(i % NKV);
        Tok ti = tokinfo(tok);
        int nc = seq_nc(ti.seq), nblk = ti.sample ? NBS : NBP;
        int cur = ti.pos / SELB;
        float* sc = p.SCORE + (size_t)i * 64;
        for (int j = 0; j < nblk; ++j) {
            float imp = 0.f;
            for (int n = 4 * j - 1; n <= 4 * j + 3; ++n) {
                if (n < 0 || n >= nc) continue;
                int lo = n * 16 > j * 64 ? n * 16 : j * 64;
                int hi = n * 16 + 32 < j * 64 + 64 ? n * 16 + 32 : j * 64 + 64;
                int ov = hi - lo; if (ov <= 0) continue;
                float w = (float)ov / 32.f;
                float sum = 0.f;
                for (int r = 0; r < 4; ++r) sum += p.PC[((size_t)tok * NH + g * 4 + r) * NCMAX + n];
                imp += sum * w;
            }
            bool forced = (j == 0) || (j == cur) || (j == cur - 1);
            sc[j] = j <= cur ? (forced ? 1e9f : imp) : -1.f;
        }
        int nsel = nblk < SELTOP ? nblk : SELTOP;
        for (int k = 0; k < nsel; ++k) {
            int best = 0; float bv = -3e38f;
            for (int j = 0; j < nblk; ++j) if (sc[j] > bv) { bv = sc[j]; best = j; }
            p.SEL[(size_t)i * SELTOP + k] = best;
            sc[best] = -3.4e38f;
        }
    }
}
__device__ __forceinline__ void ph_ss(const P& p, int l, long gtid, long gsz) {
    PLOOP_FROM(i, (size_t)NSA_TOK0 * NH * 1024, (size_t)NTOK * NH * 1024) {
        int idx = (int)(i % 1024); int h = (int)((i / 1024) % NH); int tok = (int)(i / (1024 * NH));
        Tok ti = tokinfo(tok);
        int nblk = ti.sample ? NBS : NBP; int nsel = nblk < SELTOP ? nblk : SELTOP; int L = ti.sample ? PAST_LEN + DEC_SEQ : SEQ;
        int k = idx / 64, ii = idx % 64; int g = h / 4;
        float s = NEG;
        if (k < nsel) {
            int tk = p.SEL[((size_t)tok * NKV + g) * SELTOP + k] * 64 + ii;
            if (tk <= ti.pos) {
                int kp = tk < L - 1 ? tk : L - 1;
                const float* q = p.QR + (size_t)tok * 512 + h * 64;
                const float* kr = kvrow(p, l, ti.seq, kp, 2, g);
                float acc = 0.f;
                for (int d = 0; d < 64; ++d) acc += q[d] * kr[d];
                s = acc * 0.125f;
            }
        }
        p.PS[i] = s;
    }
}
__device__ __forceinline__ void ph_ss_softmax(const P& p, int l, long gtid, long gsz) {
    PLOOP_FROM(i, (size_t)NSA_TOK0 * NH, (size_t)NTOK * NH) softmax_row(p.PS + (size_t)i * 1024, 1024);
}
__device__ __forceinline__ void ph_os(const P& p, int l, long gtid, long gsz) {
    PLOOP_FROM(i, (size_t)NSA_TOK0 * 512, (size_t)NTOK * 512) {
        int tok = (int)(i / 512), h = (int)((i % 512) / 64), d = (int)(i % 64);
        Tok ti = tokinfo(tok); int g = h / 4;
        int nblk = ti.sample ? NBS : NBP; int nsel = nblk < SELTOP ? nblk : SELTOP; int L = ti.sample ? PAST_LEN + DEC_SEQ : SEQ;
        const float* ps = p.PS + ((size_t)tok * NH + h) * 1024;
        float acc = 0.f;
        for (int k = 0; k < nsel; ++k) {
            int blk = p.SEL[((size_t)tok * NKV + g) * SELTOP + k];
            for (int ii = 0; ii < 64; ++ii) {
                float w = ps[k * 64 + ii];
                if (w != 0.f) { int tk = blk * 64 + ii; int kp = tk < L - 1 ? tk : L - 1; acc += w * kvrow(p, l, ti.seq, kp, 3, g)[d]; }
            }
        }
        p.OS[i] = acc;
    }
}
__device__ __forceinline__ void ph_sw(const P& p, int l, long gtid, long gsz) {
    PLOOP_FROM(i, (size_t)NSA_TOK0 * NH * 512, (size_t)NTOK * NH * 512) {
        int w = (int)(i % 512); int h = (int)((i / 512) % NH); int tok = (int)(i / (512 * NH));
        Tok ti = tokinfo(tok);
        int kp = ti.pos - 511 + w;
        float s = NEG;
        if (kp >= 0) {
            const float* q = p.QR + (size_t)tok * 512 + h * 64;
            const float* kr = winrow(p, l, ti.seq, kp, 0, h / 4);
            float acc = 0.f;
            for (int d = 0; d < 64; ++d) acc += q[d] * kr[d];
            s = acc * 0.125f;
        }
        p.PW[i] = s;
    }
}
__device__ __forceinline__ void ph_sw_softmax(const P& p, int l, long gtid, long gsz) {
    PLOOP_FROM(i, (size_t)NSA_TOK0 * NH, (size_t)NTOK * NH) softmax_row(p.PW + (size_t)i * 512, 512);
}
__device__ __forceinline__ void ph_ow(const P& p, int l, long gtid, long gsz) {
    PLOOP_FROM(i, (size_t)NSA_TOK0 * 512, (size_t)NTOK * 512) {
        int tok = (int)(i / 512), h = (int)((i % 512) / 64), d = (int)(i % 64);
        Tok ti = tokinfo(tok);
        const float* pw = p.PW + ((size_t)tok * NH + h) * 512;
        float acc = 0.f;
        for (int w = 0; w < 512; ++w) {
            int kp = ti.pos - 511 + w;
            if (kp >= 0) acc += pw[w] * winrow(p, l, ti.seq, kp, 1, h / 4)[d];
        }
        p.OW[i] = acc;
    }
}
__device__ __forceinline__ void ph_hb(const P& p, int l, long gtid, long gsz) {
    PLOOP_FROM(i, (size_t)NSA_TOK0 * 512, (size_t)NTOK * 512) {
        int tok = (int)(i / 512), h = (int)((i % 512) / 64);
        const float* ng = p.Z + (size_t)tok * INW + ZNG + h * 3;
        p.HBB[i] = f2bf(sigmoidf_(ng[0]) * p.OC[i] + sigmoidf_(ng[1]) * p.OS[i] + sigmoidf_(ng[2]) * p.OW[i]);
    }
}

constexpr int KSTR = 72;
constexpr int NSA_K_OFF = 0, NSA_V_OFF = 64 * KSTR * 2, NSA_IMPA_OFF = 32768  , NSA_IMPB_OFF = NSA_IMPA_OFF + 64 * 65 * 4,
              NSA_MASK_OFF = NSA_IMPB_OFF + 64 * 65 * 4, NSA_QPARK_OFF = NSA_MASK_OFF + 64 * 8, NSA_LDS_END = NSA_QPARK_OFF + 4 * 8192;
typedef float f32x16 __attribute__((ext_vector_type(16)));
typedef short s16x4 __attribute__((ext_vector_type(4)));

#ifdef CPU_TEST
static inline s16x4 lds_tr16_b64(const unsigned char* p) {
    const unsigned char* a = p; auto s = emu_exchange(&a, sizeof(a));
    const int lane = threadIdx.x & 63, g0 = lane & ~15, i = lane & 15; s16x4 r;
    for (int q = 0; q < 4; ++q) { const unsigned char* sp; memcpy(&sp, s[g0 + 4 * q + (i >> 2)], sizeof(sp)); short v; memcpy(&v, sp + 2 * (i & 3), 2); r[q] = v; }
    return r;
}
static inline int readlane_i(int v, int i) { return emu_shfl(v, i); }
static inline float fast_exp2(float x) { return exp2f(x); }
#else
typedef short v4i16_t __attribute__((ext_vector_type(4)));
__device__ __forceinline__ s16x4 lds_tr16_b64(PG8_LAS const unsigned char* p) { return __builtin_bit_cast(s16x4, __builtin_amdgcn_ds_read_tr16_b64_v4i16((PG8_LAS v4i16_t*)p)); }
__device__ __forceinline__ int readlane_i(int v, int i) { return __builtin_amdgcn_readlane(v, i); }
__device__ __forceinline__ float fast_exp2(float x) { return __builtin_amdgcn_exp2f(x); }
#endif
#ifdef CPU_TEST
static inline f32x16 zero16() { f32x16 r; for (int i = 0; i < 16; ++i) r[i] = 0.f; return r; }
#else
__device__ __forceinline__ f32x16 zero16() { float z = 0.f; asm volatile("" : "+v"(z)); f32x16 r;
#pragma unroll
    for (int i = 0; i < 16; ++i) r[i] = z;
    return r; }
#endif
__device__ __forceinline__ unsigned pack_bf16(float lo, float hi) { return pg8::cvt_pk_bf16(lo, hi); }
__device__ __forceinline__ float bf_lo(unsigned u) { return __builtin_bit_cast(float, u << 16); }
__device__ __forceinline__ float bf_hi(unsigned u) { return __builtin_bit_cast(float, u & 0xffff0000u); }

__device__ __forceinline__ void nsa_load_tile_bf16(LDSP dst, const bf16_t* src, int src_ld, int nvalid, int tid) {
    const int key = tid >> 3, ch = tid & 7;
    pg8::u32x4 v = {0u, 0u, 0u, 0u};
    if (key < nvalid) v = *(const pg8::u32x4*)(src + (size_t)key * src_ld + ch * 8);
    *(PG8_LAS pg8::u32x4*)(dst + (key * KSTR + ch * 8) * 2) = v;
}
__device__ __forceinline__ void nsa_load_tile_f32(LDSP dst, const float* src, int src_ld, int nvalid, int tid) {
    const int key = tid >> 3, ch = tid & 7;
    pg8::u32x4 v = {0u, 0u, 0u, 0u};
    if (key < nvalid) { const f32x4 a = *(const f32x4*)(src + (size_t)key * src_ld + ch * 8), b = *(const f32x4*)(src + (size_t)key * src_ld + ch * 8 + 4);
        v[0] = pack_bf16(a[0], a[1]); v[1] = pack_bf16(a[2], a[3]); v[2] = pack_bf16(b[0], b[1]); v[3] = pack_bf16(b[2], b[3]); }
    *(PG8_LAS pg8::u32x4*)(dst + (key * KSTR + ch * 8) * 2) = v;
}
__device__ __forceinline__ void nsa_qk(f32x16& p0, f32x16& p1, LDSP Kt, const bf16x8 (&q)[4], int rw, int hh) {
    p0 = zero16(); p1 = zero16();
#pragma unroll
    for (int s = 0; s < 4; ++s) {
        const bf16x8 a0 = *(PG8_LAS const bf16x8*)(Kt + (rw * KSTR + 16 * s + 8 * hh) * 2);
        const bf16x8 a1 = *(PG8_LAS const bf16x8*)(Kt + ((rw + 32) * KSTR + 16 * s + 8 * hh) * 2);
        p0 = __builtin_amdgcn_mfma_f32_32x32x16_bf16(a0, q[s], p0, 0, 0, 0);
        p1 = __builtin_amdgcn_mfma_f32_32x32x16_bf16(a1, q[s], p1, 0, 0, 0);
    }
}
__device__ __forceinline__ void nsa_pv(f32x16 (&o)[2], LDSP Vt, const f32x16& p0, const f32x16& p1, int lane) {
    const int G = lane >> 4, ig = lane & 15;
    LDSP vb = Vt + ((4 * (G >> 1) + (ig >> 2)) * KSTR + 16 * (G & 1) + 4 * (ig & 3)) * 2;
#pragma unroll
    for (int kh = 0; kh < 2; ++kh)
#pragma unroll
        for (int ks = 0; ks < 2; ++ks) {
            const f32x16& pp = kh ? p1 : p0;
            pg8::u32x4 pb;
            pb[0] = pack_bf16(pp[8 * ks + 0], pp[8 * ks + 1]); pb[1] = pack_bf16(pp[8 * ks + 2], pp[8 * ks + 3]);
            pb[2] = pack_bf16(pp[8 * ks + 4], pp[8 * ks + 5]); pb[3] = pack_bf16(pp[8 * ks + 6], pp[8 * ks + 7]);
            const bf16x8 bfrag = __builtin_bit_cast(bf16x8, pb);
#pragma unroll
            for (int e = 0; e < 2; ++e) {
                const s16x4 lo = lds_tr16_b64(vb + ((32 * kh + 16 * ks) * KSTR + 32 * e) * 2);
                const s16x4 hi = lds_tr16_b64(vb + ((32 * kh + 16 * ks + 8) * KSTR + 32 * e) * 2);
                const bf16x8 afrag = {lo[0], lo[1], lo[2], lo[3], hi[0], hi[1], hi[2], hi[3]};
                o[e] = __builtin_amdgcn_mfma_f32_32x32x16_bf16(afrag, bfrag, o[e], 0, 0, 0);
            }
        }
}
__device__ __forceinline__ int nsa_kl(int kh, int i, int hh) { return 32 * kh + (i & 3) + 8 * (i >> 2) + 4 * hh; }
__device__ __forceinline__ void nsa_online(f32x16& p0, f32x16& p1, int lo, int hi, int hh, float& m, float& l, f32x16 (&o)[2]) {
    const bool rowall = (lo <= 0 && hi >= 63), rownone = hi < lo;
    if (!__all(rowall || rownone)) {
        const unsigned span = (unsigned)(hi - lo);
#pragma unroll
        for (int i = 0; i < 16; ++i) { const int k0 = nsa_kl(0, i, hh), k1 = nsa_kl(1, i, hh);
            p0[i] = ((unsigned)(k0 - lo) <= span && !rownone) ? p0[i] : -3e30f; p1[i] = ((unsigned)(k1 - lo) <= span && !rownone) ? p1[i] : -3e30f; }
    }
    float a = fmaxf(fmaxf(p0[0], p0[1]), p1[0]), b2 = fmaxf(fmaxf(p0[2], p0[3]), p1[1]);
    a = fmaxf(fmaxf(a, p1[2]), p1[3]);
#pragma unroll
    for (int r = 4; r < 16; r += 4) { a = fmaxf(fmaxf(a, p0[r]), p0[r + 1]); b2 = fmaxf(fmaxf(b2, p0[r + 2]), p0[r + 3]); a = fmaxf(fmaxf(a, p1[r]), p1[r + 1]); b2 = fmaxf(fmaxf(b2, p1[r + 2]), p1[r + 3]); }
    float mx = rownone ? -3e30f : fmaxf(a, b2);
    mx = fmaxf(mx, __shfl_xor(mx, 32));
    const float mn = fmaxf(m, mx);
    const float c = (rownone ? -3e30f : 0.f) - mn;
    float sum = 0.f;
#pragma unroll
    for (int i = 0; i < 16; ++i) { p0[i] = fast_exp2(p0[i] + c); p1[i] = fast_exp2(p1[i] + c); sum += p0[i] + p1[i]; }
    if (__any(mn != m)) {
        const float alpha = fast_exp2(m - mn);
        l *= alpha;
#pragma unroll
        for (int i = 0; i < 16; ++i) { o[0][i] *= alpha; o[1][i] *= alpha; }
    }
    m = mn;
    l += sum;
}
constexpr int NSA_DBUF = 16384;
__device__ __forceinline__ void nsa_dma_rows(LDSP dst, const bf16_t* src, int row_stride, int w, int lane) {
    const int r = 8 * w + (lane >> 3), c = (lane & 7) ^ (r & 7);
    __builtin_amdgcn_global_load_lds((const unsigned*)(src + (size_t)r * row_stride + c * 8), (PG8_LAS unsigned*)(dst + w * 1024), 16, 0, 0);
}
__device__ __forceinline__ void nsa_dma_tile(LDSP dstK, LDSP dstV, const bf16_t* srcK, const bf16_t* srcV, int w, int lane) {
    const int r = 8 * w + (lane >> 3), c = (lane & 7) ^ (r & 7);
    __builtin_amdgcn_global_load_lds((const unsigned*)(srcK + r * 64 + c * 8), (PG8_LAS unsigned*)(dstK + w * 1024), 16, 0, 0);
    __builtin_amdgcn_global_load_lds((const unsigned*)(srcV + r * 64 + c * 8), (PG8_LAS unsigned*)(dstV + w * 1024), 16, 0, 0);
}
__device__ __forceinline__ void nsa_qk_swz(f32x16& p0, f32x16& p1, LDSP Kt, LDSP qpark, int rw, int hh) {
    p0 = zero16(); p1 = zero16();
#pragma unroll
    for (int s = 0; s < 4; ++s) {
        const int off = rw * 128 + (((2 * s + hh) ^ (rw & 7)) * 16);
        const bf16x8 a0 = *(PG8_LAS const bf16x8*)(Kt + off);
        const bf16x8 a1 = *(PG8_LAS const bf16x8*)(Kt + off + 32 * 128);
        const bf16x8 qs = *(PG8_LAS const bf16x8*)(qpark + s * 8192);
        p0 = __builtin_amdgcn_mfma_f32_32x32x16_bf16(a0, qs, p0, 0, 0, 0);
        p1 = __builtin_amdgcn_mfma_f32_32x32x16_bf16(a1, qs, p1, 0, 0, 0);
    }
}
__device__ __forceinline__ void nsa_pv_swz(f32x16 (&o)[2], LDSP Vt, const f32x16& p0, const f32x16& p1, int lane) {
    const int G = lane >> 4, ig = lane & 15, rowb = 4 * (G >> 1) + (ig >> 2), x = rowb & 7, cb = 2 * (G & 1) + ((ig & 3) >> 1), half = ig & 1;
    LDSP vb0 = Vt + rowb * 128 + (((cb ^ (x & 3)) | (0 ^ (x & 4))) * 16) + half * 8;
    LDSP vb1 = Vt + rowb * 128 + (((cb ^ (x & 3)) | (4 ^ (x & 4))) * 16) + half * 8;
#pragma unroll
    for (int kh = 0; kh < 2; ++kh)
#pragma unroll
        for (int ks = 0; ks < 2; ++ks) {
            const f32x16& pp = kh ? p1 : p0;
            pg8::u32x4 pb;
            pb[0] = pack_bf16(pp[8 * ks + 0], pp[8 * ks + 1]); pb[1] = pack_bf16(pp[8 * ks + 2], pp[8 * ks + 3]);
            pb[2] = pack_bf16(pp[8 * ks + 4], pp[8 * ks + 5]); pb[3] = pack_bf16(pp[8 * ks + 6], pp[8 * ks + 7]);
            const bf16x8 bfrag = __builtin_bit_cast(bf16x8, pb);
#pragma unroll
            for (int e = 0; e < 2; ++e) {
                LDSP vb = e ? vb1 : vb0;
                const s16x4 lo = lds_tr16_b64(vb + (32 * kh + 16 * ks) * 128);
                const s16x4 hi = lds_tr16_b64(vb + (32 * kh + 16 * ks + 8) * 128);
                const bf16x8 afrag = {lo[0], lo[1], lo[2], lo[3], hi[0], hi[1], hi[2], hi[3]};
                o[e] = __builtin_amdgcn_mfma_f32_32x32x16_bf16(afrag, bfrag, o[e], 0, 0, 0);
            }
        }
}
#ifdef CPU_TEST
#define NSA_DMA_WAIT() ((void)0)
#else
#define NSA_DMA_WAIT() asm volatile("s_waitcnt vmcnt(0)" ::: "memory")
#endif
template <bool SAMPLE> __device__ __forceinline__ void nsa_load_sel(const P& p, int l, int b, int g, int j, LDSP Kt, LDSP Vt, int tid) {
    if (!SAMPLE) {
        nsa_load_tile_bf16(Kt, p.KSB + ((size_t)g * MPAD + (size_t)b * SEQ + 64 * j) * 64, 64, 64, tid);
        nsa_load_tile_bf16(Vt, p.VSB + ((size_t)g * MPAD + (size_t)b * SEQ + 64 * j) * 64, 64, 64, tid);
    } else {
        const int pos0 = 64 * j;
        if (pos0 < PAST_LEN) {
            const int pg = p.page_table[b * N_PAGES + pos0 / PAGE];
            const float* base = p.cache_kv + (((size_t)l * N_POOL + pg) * PAGE + pos0 % PAGE) * 512 + g * 64;
            nsa_load_tile_f32(Kt, base + 2 * 128, 512, 64, tid); nsa_load_tile_f32(Vt, base + 3 * 128, 512, 64, tid);
        } else {
            const float* base = p.out + O_SKV + (((size_t)l * DEC_BATCH + b) * DEC_SEQ) * 512 + g * 64;
            nsa_load_tile_f32(Kt, base + 2 * 128, 512, DEC_SEQ, tid); nsa_load_tile_f32(Vt, base + 3 * 128, 512, DEC_SEQ, tid);
        }
    }
}
template <bool SAMPLE> __device__ __forceinline__ void nsa_load_win(const P& p, int l, int b, int g, int j, LDSP Kt, LDSP Vt, int tid) {
    if (!SAMPLE) {
        nsa_load_tile_bf16(Kt, p.KWB + ((size_t)g * MPAD + (size_t)b * SEQ + 64 * j) * 64, 64, 64, tid);
        nsa_load_tile_bf16(Vt, p.VWB + ((size_t)g * MPAD + (size_t)b * SEQ + 64 * j) * 64, 64, 64, tid);
    } else {
        const int pos0 = 64 * j;
        if (pos0 < PAST_LEN) {
            const float* base = p.cache_win + (((size_t)l * DEC_BATCH + b) * WB + (pos0 - (PAST_LEN - WB))) * 256 + g * 64;
            nsa_load_tile_f32(Kt, base, 256, 64, tid); nsa_load_tile_f32(Vt, base + 128, 256, 64, tid);
        } else {
            const float* base = p.out + O_SWIN + (((size_t)l * DEC_BATCH + b) * WB + (WB - DEC_SEQ)) * 256 + g * 64;
            nsa_load_tile_f32(Kt, base, 256, DEC_SEQ, tid); nsa_load_tile_f32(Vt, base + 128, 256, DEC_SEQ, tid);
        }
    }
}
constexpr int NSA_NW = 6, NSA_WREG = 2 * 64 * KSTR * 2;
static_assert(3 * NSA_WREG <= NSA_MASK_OFF && NSA_MASK_OFF + 64 * 8 <= 67584 && 67584 + 3 * NSA_WREG <= 131072 && NSA_NW * 34 * 256 <= NSA_MASK_OFF, "worker buffers");
#ifdef CPU_TEST
#define NSA_WAVE_FENCE() emu_wave_sync(emu_wave())
#else
#define NSA_WAVE_FENCE() __builtin_amdgcn_wave_barrier()
#endif
__device__ __forceinline__ void nsa_load_wave_f32(LDSP Kt, const float* src, int ld, int nvalid, int lane) {
    const int key0 = lane >> 3, ch = lane & 7;
    const unsigned boff = ((unsigned)key0 * (unsigned)ld + (unsigned)ch * 8u) * 4u;
    const char* sb = (const char*)src;
    LDSP d = Kt + (key0 * KSTR + ch * 8) * 2;
#pragma unroll 2
    for (int c = 0; c < 8; ++c) {
        pg8::u32x4 k = {0u, 0u, 0u, 0u}, v = {0u, 0u, 0u, 0u};
        if (key0 + 8 * c < nvalid) { const char* q = sb + boff;
            const f32x4 k0 = *(const f32x4*)q, k1 = *(const f32x4*)(q + 16), v0 = *(const f32x4*)(q + 512), v1 = *(const f32x4*)(q + 528);
            k[0] = pack_bf16(k0[0], k0[1]); k[1] = pack_bf16(k0[2], k0[3]); k[2] = pack_bf16(k1[0], k1[1]); k[3] = pack_bf16(k1[2], k1[3]);
            v[0] = pack_bf16(v0[0], v0[1]); v[1] = pack_bf16(v0[2], v0[3]); v[2] = pack_bf16(v1[0], v1[1]); v[3] = pack_bf16(v1[2], v1[3]); }
        *(PG8_LAS pg8::u32x4*)(d + c * 8 * KSTR * 2) = k; *(PG8_LAS pg8::u32x4*)(d + 64 * KSTR * 2 + c * 8 * KSTR * 2) = v;
        sb += (size_t)8 * ld * 4;
    }
}
template <bool SEL> __device__ __forceinline__ void nsa_load_wave(const P& p, int l, int b, int g, int j, LDSP Kt, LDSP Vt, int lane) {
    NSA_WAVE_FENCE();
    const int pos0 = 64 * j; const bool past = pos0 < PAST_LEN;
    const float* src;
    if (SEL) { const int pg = p.page_table[b * N_PAGES + (past ? pos0 / PAGE : 0)];
        src = past ? p.cache_kv + (((size_t)l * N_POOL + pg) * PAGE + pos0 % PAGE) * 512 + g * 64 + 2 * 128 : p.out + O_SKV + (((size_t)l * DEC_BATCH + b) * DEC_SEQ) * 512 + g * 64 + 2 * 128; }
    else src = past ? p.cache_win + (((size_t)l * DEC_BATCH + b) * WB + (pos0 - (PAST_LEN - WB))) * 256 + g * 64 : p.out + O_SWIN + (((size_t)l * DEC_BATCH + b) * WB + (WB - DEC_SEQ)) * 256 + g * 64;
    nsa_load_wave_f32(Kt, src, SEL ? 512 : 256, past ? 64 : DEC_SEQ, lane);
    NSA_WAVE_FENCE();
}
__device__ __forceinline__ void nsa_combine(LDSP lds, int ws, int lane, float& m, float& l, f32x16 (&o)[2]) {
    PG8_LAS float* cb = (PG8_LAS float*)lds;
    __syncthreads();
    if (ws < NSA_NW) { PG8_LAS float* c = cb + ws * 34 * 64 + lane; c[0] = m; c[64] = l;
#pragma unroll
        for (int i = 0; i < 16; ++i) { c[(2 + i) * 64] = o[0][i]; c[(18 + i) * 64] = o[1][i]; } }
    __syncthreads();
    float M = -1e30f;
#pragma unroll
    for (int v = 0; v < NSA_NW; ++v) M = fmaxf(M, cb[v * 34 * 64 + lane]);
    float L = 0.f; o[0] = zero16(); o[1] = zero16();
#pragma unroll 1
    for (int v = 0; v < NSA_NW; ++v) { const PG8_LAS float* c = cb + v * 34 * 64 + lane; const float al = fast_exp2(c[0] - M); L += c[64] * al;
#pragma unroll
        for (int i = 0; i < 16; ++i) { o[0][i] += c[(2 + i) * 64] * al; o[1][i] += c[(18 + i) * 64] * al; } }
    m = M; l = L;
    __syncthreads();
}
template <bool SAMPLE> __device__ __forceinline__ void ph_nsa_t(const P& p, int l, LDSP lds) {
    constexpr int NQT = SEQ / 64, NITEM = SAMPLE ? DEC_BATCH * NKV : BATCH * NKV * NQT, NC = SAMPLE ? NCS : NCP, NTC = (NC + 63) / 64;
    static_assert(WB == WIN && PAST_LEN % 64 == 0 && PAST_LEN >= WIN, "sample window tiling");
    const int tid = opaque_tid(), w = tid >> 6, lane = tid & 63, rw = lane & 31, hh = lane >> 5;
    LDSP Kt = lds + NSA_K_OFF; LDSP Vt = lds + NSA_V_OFF;
    PG8_LAS float* impA = (PG8_LAS float*)(lds + NSA_IMPA_OFF); PG8_LAS float* impB = (PG8_LAS float*)(lds + NSA_IMPB_OFF);
    PG8_LAS unsigned long long* selmask = (PG8_LAS unsigned long long*)(lds + NSA_MASK_OFF);
    for (int it2 = blockIdx.x; it2 < NITEM; it2 += gridDim.x) {
        const int item = SAMPLE ? it2 : ((it2 & 1) ? NITEM - 1 - (it2 >> 1) : (it2 >> 1));
        int qt, b, g;
        if (SAMPLE) { b = item / NKV; g = item % NKV; qt = PAST_LEN / 64; }
        else { qt = NQT - 1 - item / (BATCH * NKV); const int bg = item % (BATCH * NKV); b = bg / NKV; g = bg % NKV; }
        const int q0 = SAMPLE ? PAST_LEN : 64 * qt;
        const int tl = SAMPLE ? (rw & 3) : 8 * w + (rw & 7), r = SAMPLE ? ((rw >> 2) & 3) : (rw >> 3);
        const int head = 4 * g + r, qpos = q0 + tl, tok = SAMPLE ? NPT + b * DEC_SEQ + tl : b * SEQ + qpos, seq = SAMPLE ? BATCH + b : b;
        const int cur = qpos >> 6;
        bf16x8 qc[4], qr[4];
#pragma unroll
        for (int s = 0; s < 4; ++s) { qc[s] = *(const bf16x8*)(p.QCB + (size_t)tok * 512 + head * 64 + 16 * s + 8 * hh); if (SAMPLE) qr[s] = *(const bf16x8*)(p.QRB + (size_t)tok * 512 + head * 64 + 16 * s + 8 * hh); }
        const float* ngp = p.Z + (size_t)tok * INW + ZNG + head * 3;
        const float g0 = sigmoidf_(ngp[0]);
        f32x16 o[2], p0, p1;
        unsigned outp[2][8];
        const int nmax = qpos >= 31 ? (qpos - 31) >> 4 : -1;
        const bf16_t* kcb = p.KCB + (kc_base(seq) * 2 + g) * 64; const bf16_t* vcb = p.VCB + (kc_base(seq) * 2 + g) * 64;
        LDSP qpark = lds + NSA_QPARK_OFF + tid * 16;
#pragma unroll
        for (int s = 0; s < 4; ++s) *(PG8_LAS bf16x8*)(qpark + s * 8192) = qc[s];
        float m = -1e30f, lsum = 0.f, inv_lc = 0.f;
        o[0] = zero16(); o[1] = zero16();
        nsa_dma_rows(lds, kcb, 128, w, lane);
        for (int st = 0, buf = 0; st < 2 * NTC; ++st, buf ^= 1) {
            LDSP Kc = lds + buf * NSA_DBUF; LDSP Vc = Kc + 8192;
            NSA_DMA_WAIT(); __syncthreads();
            if (st + 1 < 2 * NTC) { const int cn = (st + 1) % NTC; LDSP Kn = lds + (buf ^ 1) * NSA_DBUF;
                nsa_dma_rows(Kn, kcb + (size_t)cn * 64 * 128, 128, w, lane);
                if (st + 1 >= NTC) nsa_dma_rows(Kn + 8192, vcb + (size_t)cn * 64 * 128, 128, w, lane); }
            const int c = st % NTC;
            nsa_qk_swz(p0, p1, Kc, qpark, rw, hh);
            int hi = nmax - 64 * c; if (hi > NC - 1 - 64 * c) hi = NC - 1 - 64 * c;
            if (st < NTC) {
                nsa_online(p0, p1, 0, hi, hh, m, lsum, o);
                if (st == NTC - 1) { lsum += __shfl_xor(lsum, 32); inv_lc = 1.f / fmaxf(lsum, TINY); }
            } else {
#pragma unroll
                for (int i = 0; i < 16; ++i) { const int k0 = nsa_kl(0, i, hh), k1 = nsa_kl(1, i, hh);
                    p0[i] = k0 <= hi ? fast_exp2(p0[i] - m) : 0.f; p1[i] = k1 <= hi ? fast_exp2(p1[i] - m) : 0.f; }
#pragma unroll
                for (int kh = 0; kh < 2; ++kh)
#pragma unroll
                    for (int q4 = 0; q4 < 4; ++q4) {
                        const f32x16& pp = kh ? p1 : p0;
                        float a = (pp[4 * q4] + pp[4 * q4 + 1] + pp[4 * q4 + 2] + 0.5f * pp[4 * q4 + 3]) * inv_lc, bb = 0.5f * pp[4 * q4 + 3] * inv_lc;
                        if (SAMPLE) { a += __shfl_xor(a, 4); a += __shfl_xor(a, 8); bb += __shfl_xor(bb, 4); bb += __shfl_xor(bb, 8); }
                        else { a += __shfl_xor(a, 8); a += __shfl_xor(a, 16); bb += __shfl_xor(bb, 8); bb += __shfl_xor(bb, 16); }
                        const int jp = 16 * c + 8 * kh + 2 * q4 + hh;
                        if (rw < (SAMPLE ? 4 : 8) && (!SAMPLE || w == 0)) { impA[tl * 65 + jp] = a; impB[tl * 65 + jp + 1] = bb; }
                    }
                nsa_pv_swz(o, Vc, p0, p1, lane);
            }
        }
#pragma unroll
        for (int e = 0; e < 2; ++e)
#pragma unroll
            for (int i = 0; i < 8; ++i) outp[e][i] = pack_bf16(o[e][2 * i] * (g0 * inv_lc), o[e][2 * i + 1] * (g0 * inv_lc));
        __syncthreads();
        if (!SAMPLE || w == 0) {
            for (int t8 = 0; t8 < (SAMPLE ? DEC_SEQ : 8); ++t8) {
                const int tt = SAMPLE ? t8 : 8 * w + t8, j = lane;
                float sc;
                if (j > cur) sc = -1.f; else if (j == 0 || j == cur || j == cur - 1) sc = 1e9f; else sc = impA[tt * 65 + j] + impB[tt * 65 + j];
                int rank = 0; const int sci = __builtin_bit_cast(int, sc);
                for (int i = 0; i < 64; ++i) { const float si = __builtin_bit_cast(float, readlane_i(sci, i)); rank += (si > sc || (si == sc && i < j)) ? 1 : 0; }
                const unsigned long long msk = __ballot(rank < SELTOP);
                if (lane == 0) selmask[tt] = msk;
            }
        }
        __syncthreads();
        unsigned long long un = selmask[SAMPLE ? (lane & 3) : lane];
#pragma unroll
        for (int s = 32; s >= 1; s >>= 1) { unsigned lo32 = (unsigned)un, hi32 = (unsigned)(un >> 32); lo32 |= __shfl_xor(lo32, s); hi32 |= __shfl_xor(hi32, s); un = ((unsigned long long)hi32 << 32) | lo32; }
        if (SAMPLE) un = ((unsigned long long)(unsigned)__builtin_amdgcn_readfirstlane((int)(un >> 32)) << 32) | (unsigned)__builtin_amdgcn_readfirstlane((int)un);
        if (!SAMPLE) {
#pragma unroll
            for (int s = 0; s < 4; ++s) *(PG8_LAS bf16x8*)(qpark + s * 8192) = *(const bf16x8*)(p.QRB + (size_t)tok * 512 + head * 64 + 16 * s + 8 * hh);
        }
        m = -1e30f; lsum = 0.f;
        o[0] = zero16(); o[1] = zero16();
        if (SAMPLE) {
        const int ws = __builtin_amdgcn_readfirstlane(w);
        LDSP Kw = lds + (ws < 3 ? ws * NSA_WREG : 67584 + (ws - 3) * NSA_WREG); LDSP Vw = Kw + 64 * KSTR * 2;
        int kk = 0;
        for (int j = 0; j <= cur; ++j) {
            if (!((un >> j) & 1ull)) continue;
            const bool mine = (kk % NSA_NW) == ws; ++kk;
            if (!mine) continue;
            nsa_load_wave<true>(p, l, b, g, j, Kw, Vw, lane);
            nsa_qk(p0, p1, Kw, qr, rw, hh);
            int hi = qpos - 64 * j; if (hi > 63) hi = 63; if (!((selmask[tl] >> j) & 1ull)) hi = -1;
            nsa_online(p0, p1, 0, hi, hh, m, lsum, o);
            nsa_pv(o, Vw, p0, p1, lane);
        }
        nsa_combine(lds, ws, lane, m, lsum, o);
        } else {
            unsigned long long rem = un & ((cur >= 63) ? ~0ull : ((2ull << cur) - 1ull));
            int j = rem ? __builtin_ctzll(rem) : -1, buf = 0;
            const bf16_t* ks0 = p.KSB + ((size_t)g * MPAD + (size_t)b * SEQ) * 64; const bf16_t* vs0 = p.VSB + ((size_t)g * MPAD + (size_t)b * SEQ) * 64;
            __syncthreads();
            if (j >= 0) nsa_dma_tile(lds, lds + 8192, ks0 + (size_t)j * 4096, vs0 + (size_t)j * 4096, w, lane);
            while (j >= 0) {
                LDSP Kc = lds + buf * NSA_DBUF; LDSP Vc = Kc + 8192;
                NSA_DMA_WAIT(); __syncthreads();
                rem &= rem - 1ull; const int jn = rem ? __builtin_ctzll(rem) : -1;
                if (jn >= 0) nsa_dma_tile(lds + (buf ^ 1) * NSA_DBUF, lds + (buf ^ 1) * NSA_DBUF + 8192, ks0 + (size_t)jn * 4096, vs0 + (size_t)jn * 4096, w, lane);
                nsa_qk_swz(p0, p1, Kc, qpark, rw, hh);
                int hi = qpos - 64 * j; if (hi > 63) hi = 63; if (!((selmask[tl] >> j) & 1ull)) hi = -1;
                nsa_online(p0, p1, 0, hi, hh, m, lsum, o);
                nsa_pv_swz(o, Vc, p0, p1, lane);
                j = jn; buf ^= 1;
            }
        }
        lsum += __shfl_xor(lsum, 32);
        { const float sc = sigmoidf_(ngp[1]) / fmaxf(lsum, TINY);
#pragma unroll
          for (int e = 0; e < 2; ++e)
#pragma unroll
            for (int i = 0; i < 8; ++i) outp[e][i] = pack_bf16(bf_lo(outp[e][i]) + o[e][2 * i] * sc, bf_hi(outp[e][i]) + o[e][2 * i + 1] * sc); }
        m = -1e30f; lsum = 0.f;
        o[0] = zero16(); o[1] = zero16();
        if (SAMPLE) {
        const int ws = __builtin_amdgcn_readfirstlane(w);
        LDSP Kw = lds + (ws < 3 ? ws * NSA_WREG : 67584 + (ws - 3) * NSA_WREG); LDSP Vw = Kw + 64 * KSTR * 2;
        const int jw0 = (q0 >= WIN ? (q0 - (WIN - 1)) >> 6 : 0);
        for (int j = jw0; j <= cur; ++j) {
            if (((j - jw0) % NSA_NW) != ws) continue;
            nsa_load_wave<false>(p, l, b, g, j, Kw, Vw, lane);
            nsa_qk(p0, p1, Kw, qr, rw, hh);
            int hi = qpos - 64 * j; if (hi > 63) hi = 63;
            int lo = qpos - (WIN - 1) - 64 * j; if (lo < 0) lo = 0;
            nsa_online(p0, p1, lo, hi, hh, m, lsum, o);
            nsa_pv(o, Vw, p0, p1, lane);
        }
        nsa_combine(lds, ws, lane, m, lsum, o);
        } else {
            int j = (q0 >= WIN ? (q0 - (WIN - 1)) >> 6 : 0), buf = 0;
            const bf16_t* kw0 = p.KWB + ((size_t)g * MPAD + (size_t)b * SEQ) * 64; const bf16_t* vw0 = p.VWB + ((size_t)g * MPAD + (size_t)b * SEQ) * 64;
            __syncthreads();
            nsa_dma_tile(lds, lds + 8192, kw0 + (size_t)j * 4096, vw0 + (size_t)j * 4096, w, lane);
            for (; j <= cur; ++j) {
                LDSP Kc = lds + buf * NSA_DBUF; LDSP Vc = Kc + 8192;
                NSA_DMA_WAIT(); __syncthreads();
                if (j + 1 <= cur) nsa_dma_tile(lds + (buf ^ 1) * NSA_DBUF, lds + (buf ^ 1) * NSA_DBUF + 8192, kw0 + (size_t)(j + 1) * 4096, vw0 + (size_t)(j + 1) * 4096, w, lane);
                nsa_qk_swz(p0, p1, Kc, qpark, rw, hh);
                int hi = qpos - 64 * j; if (hi > 63) hi = 63;
                int lo = qpos - (WIN - 1) - 64 * j; if (lo < 0) lo = 0;
                nsa_online(p0, p1, lo, hi, hh, m, lsum, o);
                nsa_pv_swz(o, Vc, p0, p1, lane);
                buf ^= 1;
            }
        }
        lsum += __shfl_xor(lsum, 32);
        { const float sc = sigmoidf_(ngp[2]) / fmaxf(lsum, TINY);
#pragma unroll
          for (int e = 0; e < 2; ++e)
#pragma unroll
            for (int i = 0; i < 8; ++i) outp[e][i] = pack_bf16(bf_lo(outp[e][i]) + o[e][2 * i] * sc, bf_hi(outp[e][i]) + o[e][2 * i + 1] * sc); }
        if (!SAMPLE || (w == 0 && rw < 16)) {
            bf16_t* hb = p.HBB + (size_t)tok * 512 + head * 64;
#pragma unroll
            for (int e = 0; e < 2; ++e)
#pragma unroll
                for (int q4 = 0; q4 < 4; ++q4) {
                    uint2 v; v.x = outp[e][2 * q4]; v.y = outp[e][2 * q4 + 1];
                    *(uint2*)(hb + 32 * e + 8 * q4 + 4 * hh) = v;
                }
        }
        __syncthreads();
    }
}
__device__ __forceinline__ void ph_nsa_prompt(const P& p, int l, LDSP lds) { ph_nsa_t<false>(p, l, lds); }
__device__ __forceinline__ void ph_nsa_sample(const P& p, int l, LDSP lds) { ph_nsa_t<true>(p, l, lds); }


typedef unsigned u32x2 __attribute__((ext_vector_type(2)));
#ifdef CPU_TEST
#define MFMA_DRAIN() ((void)0)
#define VMEM_DRAIN() ((void)0)
#else
#define VMEM_DRAIN() asm volatile("s_waitcnt vmcnt(0)" ::: "memory")
#define MFMA_DRAIN() asm volatile("s_nop 15\n\ts_nop 15" ::: "memory")
#endif
constexpr int TS = 136;
constexpr int NCH = SEQ / 64, NMI = BATCH * MH * NCH;
constexpr int ML_C_OFF = 0, ML_K_OFF = 64 * TS * 2, ML_V_OFF = 2 * 64 * TS * 2, ML_Q_OFF = 3 * 64 * TS * 2, ML_CS_OFF = 4 * 64 * TS * 2,
              ML_VEC_OFF = ML_CS_OFF + 128 * TS * 2, ML_LDS_END = ML_VEC_OFF + 4096;
constexpr int M3_CS_OFF = 0, M3_V_OFF = 128 * TS * 2, M3_Q_OFF = M3_V_OFF + 64 * TS * 2, M3_K_OFF = M3_Q_OFF + 64 * TS * 2, M3_VEC_OFF = M3_K_OFF + 64 * TS * 2;
static_assert(M3_VEC_OFF + 4096 <= ML_LDS_END, "M3 LDS map");
__device__ __forceinline__ int tr_lane_off(int lane, bool natural, int stride) {
    const int G = lane >> 4, ig = lane & 15;
    return (((ig >> 2) + (natural ? 8 : 4) * (G >> 1)) * stride + 16 * (G & 1) + 4 * (ig & 3)) * 2;
}
__device__ __forceinline__ bf16x8 tr_frag(LDSP base_lane, int r0, int c0, bool natural, int stride) {
    const s16x4 lo = lds_tr16_b64(base_lane + (r0 * stride + c0) * 2);
    const s16x4 hi = lds_tr16_b64(base_lane + ((r0 + (natural ? 4 : 8)) * stride + c0) * 2);
    return (bf16x8){lo[0], lo[1], lo[2], lo[3], hi[0], hi[1], hi[2], hi[3]};
}
__device__ __forceinline__ float wave_incl_scan_add(float v, int lane) {
#pragma unroll
    for (int s = 1; s < 64; s <<= 1) { const float o = __shfl_up(v, s); if (lane >= s) v += o; }
    return v;
}
__device__ __forceinline__ float wave_incl_scan_max(float v, int lane) {
#pragma unroll
    for (int s = 1; s < 64; s <<= 1) { const float o = __shfl_up(v, s); if (lane >= s) v = fmaxf(v, o); }
    return v;
}
template <int DUP1> __device__ __forceinline__ void ph_ml1_t(const P& p, int l, LDSP lds, int first = -1, int step = 0) {
    if (first < 0) { first = blockIdx.x; step = gridDim.x; }
    const int tid = opaque_tid(), w = tid >> 6, lane = tid & 63, rw = lane & 31, hh = lane >> 5;
    LDSP Ct = lds + ML_C_OFF; LDSP Kt = lds + ML_K_OFF; LDSP Vt = lds + ML_V_OFF;
    PG8_LAS float* vec = (PG8_LAS float*)(lds + ML_VEC_OFF);
    for (int item = first; item < NMI; item += step) {
        const int c = item % NCH, h = (item / NCH) % MH, b = item / (NCH * MH);
        const int tok0 = b * SEQ + 64 * c;
        __syncthreads();
        {
            const int t = tid >> 3, c0 = (tid & 7) * 16;
#pragma unroll
            for (int cc = 0; cc < 16; cc += 4) {
                const int col = h * MHD + c0 + cc;
                f32x4 y = *(const f32x4*)(p.conv_b + l * MW + col);
#pragma unroll
                for (int j = 0; j < 4; ++j) {
                    const int tt = 64 * c + t + j - 3;
                    if (tt >= 0) { const f32x4 u = *(const f32x4*)(p.Z + (size_t)(b * SEQ + tt) * INW + ZU + col); const f32x4 wj = *(const f32x4*)(p.conv_w + ((size_t)l * 4 + j) * MW + col); y += u * wj; }
                }
                uint2 o; o.x = pack_bf16(siluf_(y[0]), siluf_(y[1])); o.y = pack_bf16(siluf_(y[2]), siluf_(y[3]));
                *(PG8_LAS u32x2*)(Ct + (t * TS + c0 + cc) * 2) = (u32x2){o.x, o.y};
                const f32x4 vv = *(const f32x4*)(p.Z + (size_t)(tok0 + t) * INW + ZV + col);
                uint2 ov; ov.x = pack_bf16(vv[0], vv[1]); ov.y = pack_bf16(vv[2], vv[3]);
                *(PG8_LAS u32x2*)(Vt + (t * TS + c0 + cc) * 2) = (u32x2){ov.x, ov.y};
            }
        }
        if (w == 0) {
            const float ig = p.IG[(size_t)(tok0 + lane) * 4 + h], lf = p.LF[(size_t)(tok0 + lane) * 4 + h];
            const float F = wave_incl_scan_add(lf, lane), a = ig - F;
            float A = a;
#pragma unroll
            for (int s = 32; s >= 1; s >>= 1) A = fmaxf(A, __shfl_xor(A, s));
            vec[lane] = F; vec[64 + lane] = a; vec[128 + lane] = expf(a - A);
            if (lane == 63) { vec[193] = F; vec[192] = A; }
        }
        __syncthreads();
        {
            const int eb = w & 3, tb = w >> 2;
            f32x16 aq, ak;
            aq = zero16(); ak = zero16();
            const bf16_t* wq = p.WMQ_T + (((size_t)l * MH + h) * MHD + 32 * eb + rw) * MHD;
            const bf16_t* wk = p.WMK_T + (((size_t)l * MH + h) * MHD + 32 * eb + rw) * MHD;
#pragma unroll
            for (int ds = 0; ds < 8; ++ds) {
                const bf16x8 bc = *(PG8_LAS const bf16x8*)(Ct + ((32 * tb + rw) * TS + 16 * ds + 8 * hh) * 2);
                const bf16x8 fq = *(const bf16x8*)(wq + 16 * ds + 8 * hh), fk = *(const bf16x8*)(wk + 16 * ds + 8 * hh);
                VMEM_DRAIN();
                aq = __builtin_amdgcn_mfma_f32_32x32x16_bf16(fq, bc, aq, 0, 0, 0);
                ak = __builtin_amdgcn_mfma_f32_32x32x16_bf16(fk, bc, ak, 0, 0, 0);
            }
            const int t = 32 * tb + rw; const float ws = vec[128 + t];
            bf16_t* qg = p.QMB + (size_t)DUP1 * MPAD * MW + (size_t)(tok0 + t) * MW + h * MHD + 32 * eb; bf16_t* kg = p.KMB + (size_t)DUP1 * MPAD * MW + (size_t)(tok0 + t) * MW + h * MHD + 32 * eb;
#pragma unroll
            for (int q4 = 0; q4 < 4; ++q4) {
                uint2 vq, vk, vkw; const float sc = 0.08838834764831845f;
                vq.x = pack_bf16(aq[4 * q4], aq[4 * q4 + 1]); vq.y = pack_bf16(aq[4 * q4 + 2], aq[4 * q4 + 3]);
                vk.x = pack_bf16(ak[4 * q4] * sc, ak[4 * q4 + 1] * sc); vk.y = pack_bf16(ak[4 * q4 + 2] * sc, ak[4 * q4 + 3] * sc);
                vkw.x = pack_bf16(ak[4 * q4] * sc * ws, ak[4 * q4 + 1] * sc * ws); vkw.y = pack_bf16(ak[4 * q4 + 2] * sc * ws, ak[4 * q4 + 3] * sc * ws);
                *(uint2*)(qg + 8 * q4 + 4 * hh) = vq; *(uint2*)(kg + 8 * q4 + 4 * hh) = vk;
                *(PG8_LAS u32x2*)(Kt + (t * TS + 32 * eb + 8 * q4 + 4 * hh) * 2) = (u32x2){vkw.x, vkw.y};
            }
        }
        __syncthreads();
        {
            LDSP kb = Kt + tr_lane_off(lane, true, TS); LDSP vb = Vt + tr_lane_off(lane, true, TS);
            float* dc = p.DC + (size_t)DUP1 * NMI * MHD * MHD + (size_t)item * MHD * MHD;
#pragma unroll
            for (int tt = 0; tt < 2; ++tt) {
                const int tile = 2 * w + tt, db = tile >> 2, eb = tile & 3;
                f32x16 acc;
                acc = zero16();
#pragma unroll
                for (int ss = 0; ss < 4; ++ss) {
                    const bf16x8 fa = tr_frag(kb, 16 * ss, 32 * db, true, TS), fb = tr_frag(vb, 16 * ss, 32 * eb, true, TS);
                    acc = __builtin_amdgcn_mfma_f32_32x32x16_bf16(fa, fb, acc, 0, 0, 0);
                }
#pragma unroll
                for (int i = 0; i < 16; ++i) dc[(size_t)(32 * db + (i & 3) + 8 * (i >> 2) + 4 * hh) * MHD + 32 * eb + rw] = acc[i];
            }
            if (tid < MHD) { float s = 0.f; for (int t = 0; t < 64; ++t) s += bf2f(*(PG8_LAS const bf16_t*)(Kt + (t * TS + tid) * 2)); p.DN[(size_t)DUP1 * NMI * MHD + (size_t)item * MHD + tid] = s; }
            if (tid == 0) { p.GSUM[(size_t)DUP1 * NMI * 2 + (size_t)item * 2] = vec[193]; p.GSUM[(size_t)DUP1 * NMI * 2 + (size_t)item * 2 + 1] = vec[193] + vec[192]; }
        }
    }
}
__device__ __forceinline__ void ph_ml2(const P& p, int l, LDSP lds_unused) {
    constexpr int PER = MHD * MHD / 4 + MHD / 4, NWT = BATCH * MH * PER / 64;
    static_assert((BATCH * MH * PER) % 64 == 0, "ml2 wave tasks");
    const int tid = opaque_tid(), lane = tid & 63, wv = tid >> 6;
    for (int wt = blockIdx.x + gridDim.x * wv; wt < NWT; wt += gridDim.x * 8) {
        const int it = wt * 64 + lane, bh = it / PER, e4 = it % PER;
        const bool isn = e4 >= MHD * MHD / 4;
        const int e = e4 % MHD, d4 = (e4 / MHD) * 4;
        const int noff = (e4 - MHD * MHD / 4) * 4;
        f32x4 C = {0.f, 0.f, 0.f, 0.f}; float m = 0.f;
        auto load_d = [&](int c) -> f32x4 {
            const size_t item = (size_t)bh * NCH + c; f32x4 d;
            if (isn) d = *(const f32x4*)(p.DN + item * MHD + noff);
            else { const float* dc = p.DC + item * MHD * MHD + (size_t)d4 * MHD + e; d[0] = dc[0]; d[1] = dc[MHD]; d[2] = dc[2 * MHD]; d[3] = dc[3 * MHD]; }
            return d; };
        f32x4 dn0 = load_d(0), dn1 = load_d(NCH > 1 ? 1 : 0);
        for (int c = 0; c < NCH; ++c) {
            const size_t item = (size_t)bh * NCH + c;
            const f32x4 d = dn0; dn0 = dn1; if (c + 2 < NCH) dn1 = load_d(c + 2);
            if (isn) *(f32x4*)(p.NS + item * MHD + noff) = C;
            else { uint2 o; o.x = pack_bf16(C[0], C[1]); o.y = pack_bf16(C[2], C[3]); *(uint2*)(p.CSB + item * MHD * MHD + (size_t)e * MHD + d4) = o; }
            if (e4 == 0) p.MS[item] = m;
            const float Fl = p.GSUM[item * 2], ml = p.GSUM[item * 2 + 1];
            const float mn = fmaxf(m + Fl, ml), dec = expf(m + Fl - mn), sc = expf(ml - mn);
            C = C * dec + d * sc; m = mn;
        }
        const int b = bh / MH, h = bh % MH;
        if (isn) *(f32x4*)(p.out + O_PN + (((size_t)l * BATCH + b) * MH + h) * MHD + noff) = C;
        else { float* oc = p.out + O_PC + (((size_t)l * BATCH + b) * MH + h) * MHD * MHD + (size_t)d4 * MHD + e; oc[0] = C[0]; oc[MHD] = C[1]; oc[2 * MHD] = C[2]; oc[3 * MHD] = C[3]; }
        if (e4 == 0) p.out[O_PM + ((size_t)l * BATCH + b) * MH + h] = m;
    }
}
template <int DUP> __device__ __forceinline__ void ph_ml3_t(const P& p, int l, LDSP lds) {
    const int tid = opaque_tid(), w = tid >> 6, lane = tid & 63, rw = lane & 31, hh = lane >> 5;
    LDSP Qt = lds + M3_Q_OFF; LDSP Kt = lds + M3_K_OFF; LDSP Vt = lds + M3_V_OFF; LDSP CSt = lds + M3_CS_OFF;
    PG8_LAS float* vec = (PG8_LAS float*)(lds + M3_VEC_OFF);
    for (int item = blockIdx.x; item < NMI; item += gridDim.x) {
        const int c = item % NCH, h = (item / NCH) % MH, b = item / (NCH * MH);
        const int tok0 = b * SEQ + 64 * c;
        __syncthreads();
        {
            const int t = tid >> 3, c0 = (tid & 7) * 16;
            const pg8::u32x4 q0 = *(const pg8::u32x4*)(p.QMB + (size_t)(tok0 + t) * MW + h * MHD + c0), q1 = *(const pg8::u32x4*)(p.QMB + (size_t)(tok0 + t) * MW + h * MHD + c0 + 8);
            const pg8::u32x4 k0 = *(const pg8::u32x4*)(p.KMB + (size_t)(tok0 + t) * MW + h * MHD + c0), k1 = *(const pg8::u32x4*)(p.KMB + (size_t)(tok0 + t) * MW + h * MHD + c0 + 8);
            *(PG8_LAS pg8::u32x4*)(Qt + (t * TS + c0) * 2) = q0; *(PG8_LAS pg8::u32x4*)(Qt + (t * TS + c0 + 8) * 2) = q1;
            *(PG8_LAS pg8::u32x4*)(Kt + (t * TS + c0) * 2) = k0; *(PG8_LAS pg8::u32x4*)(Kt + (t * TS + c0 + 8) * 2) = k1;
#pragma unroll
            for (int cc = 0; cc < 16; cc += 4) {
                const f32x4 vv = *(const f32x4*)(p.Z + (size_t)(tok0 + t) * INW + ZV + h * MHD + c0 + cc);
                uint2 ov; ov.x = pack_bf16(vv[0], vv[1]); ov.y = pack_bf16(vv[2], vv[3]);
                *(PG8_LAS u32x2*)(Vt + (t * TS + c0 + cc) * 2) = (u32x2){ov.x, ov.y};
            }
            const bf16_t* cs = p.CSB + (size_t)item * MHD * MHD;
#pragma unroll
            for (int r2 = 0; r2 < 2; ++r2) {
                const int d = (tid >> 3) + 64 * r2;
                *(PG8_LAS pg8::u32x4*)(CSt + (d * TS + c0) * 2) = *(const pg8::u32x4*)(cs + (size_t)d * MHD + c0);
                *(PG8_LAS pg8::u32x4*)(CSt + (d * TS + c0 + 8) * 2) = *(const pg8::u32x4*)(cs + (size_t)d * MHD + c0 + 8);
            }
            if (tid < MHD) vec[256 + tid] = p.NS[(size_t)item * MHD + tid];
        }
        if (w == 0) {
            const float ig = p.IG[(size_t)(tok0 + lane) * 4 + h], lf = p.LF[(size_t)(tok0 + lane) * 4 + h], ms = p.MS[item];
            const float F = wave_incl_scan_add(lf, lane), a = ig - F;
            const float mt = F + fmaxf(ms, wave_incl_scan_max(a, lane));
            vec[lane] = F - mt; vec[64 + lane] = a; vec[128 + lane] = expf(ms + F - mt); vec[192 + lane] = expf(-mt);
        }
        __syncthreads();
        if (tid < 64) { float s = 0.f; for (int d = 0; d < MHD; ++d) s += bf2f(*(PG8_LAS const bf16_t*)(Qt + (tid * TS + d) * 2)) * vec[256 + d]; vec[384 + tid] = s; }
        const int eb = w & 3, tb = w >> 2, t = 32 * tb + rw;
        f32x16 s0, s1, acc;
        s0 = zero16(); s1 = zero16(); acc = zero16();
#pragma unroll
        for (int ds = 0; ds < 8; ++ds) {
            const bf16x8 bq = *(PG8_LAS const bf16x8*)(Qt + (t * TS + 16 * ds + 8 * hh) * 2);
            const bf16x8 a0 = *(PG8_LAS const bf16x8*)(Kt + (rw * TS + 16 * ds + 8 * hh) * 2), a1 = *(PG8_LAS const bf16x8*)(Kt + ((rw + 32) * TS + 16 * ds + 8 * hh) * 2);
            s0 = __builtin_amdgcn_mfma_f32_32x32x16_bf16(a0, bq, s0, 0, 0, 0);
            s1 = __builtin_amdgcn_mfma_f32_32x32x16_bf16(a1, bq, s1, 0, 0, 0);
            const bf16x8 ac = *(PG8_LAS const bf16x8*)(CSt + ((32 * eb + rw) * TS + 16 * ds + 8 * hh) * 2);
            acc = __builtin_amdgcn_mfma_f32_32x32x16_bf16(ac, bq, acc, 0, 0, 0);
        }
        MFMA_DRAIN();
        const float lt = vec[t], inter = vec[128 + t];
        float rsum = 0.f;
#pragma unroll
        for (int i = 0; i < 16; ++i) {
            const int k0 = (i & 3) + 8 * (i >> 2) + 4 * hh, k1 = k0 + 32;
            const float e0 = fast_exp2((vec[64 + k0] + lt) * 1.4426950408889634f), e1 = fast_exp2((vec[64 + k1] + lt) * 1.4426950408889634f);
            s0[i] = k0 <= t ? s0[i] * e0 : 0.f; s1[i] = k1 <= t ? s1[i] * e1 : 0.f;
            rsum += s0[i] + s1[i];
            acc[i] *= inter;
        }
        rsum += __shfl_xor(rsum, 32);
        {
            LDSP vb = Vt + tr_lane_off(lane, false, TS);
#pragma unroll
            for (int kh = 0; kh < 2; ++kh)
#pragma unroll
                for (int ks = 0; ks < 2; ++ks) {
                    const f32x16& pp = kh ? s1 : s0;
                    pg8::u32x4 pb; pb[0] = pack_bf16(pp[8 * ks + 0], pp[8 * ks + 1]); pb[1] = pack_bf16(pp[8 * ks + 2], pp[8 * ks + 3]); pb[2] = pack_bf16(pp[8 * ks + 4], pp[8 * ks + 5]); pb[3] = pack_bf16(pp[8 * ks + 6], pp[8 * ks + 7]);
                    const bf16x8 av = tr_frag(vb, 32 * kh + 16 * ks, 32 * eb, false, TS);
                    acc = __builtin_amdgcn_mfma_f32_32x32x16_bf16(av, __builtin_bit_cast(bf16x8, pb), acc, 0, 0, 0);
                }
        }
        MFMA_DRAIN();
        __syncthreads();
        const float den = rsum + inter * vec[384 + t];
        const float inv = 1.f / fmaxf(fabsf(den), vec[192 + t]);
        float ss = 0.f;
#pragma unroll
        for (int i = 0; i < 16; ++i) { acc[i] *= inv; ss += acc[i] * acc[i]; }
        ss += __shfl_xor(ss, 32);
        if (hh == 0) vec[448 + eb * 64 + t] = ss;
        __syncthreads();
        const float rn = 1.f / sqrtf((vec[448 + t] + vec[448 + 64 + t] + vec[448 + 128 + t] + vec[448 + 192 + t]) * (1.f / MHD) + EPS);
        const size_t tok = (size_t)tok0 + t;
#pragma unroll
        for (int q4 = 0; q4 < 4; ++q4) {
            const int e = h * MHD + 32 * eb + 8 * q4 + 4 * hh;
            const f32x4 og = *(const f32x4*)(p.Z + tok * INW + ZO + e), gg = *(const f32x4*)(p.mnorm_g + l * MW + e);
            uint2 v; v.x = pack_bf16(acc[4 * q4] * rn * gg[0] * sigmoidf_(og[0]), acc[4 * q4 + 1] * rn * gg[1] * sigmoidf_(og[1]));
            v.y = pack_bf16(acc[4 * q4 + 2] * rn * gg[2] * sigmoidf_(og[2]), acc[4 * q4 + 3] * rn * gg[3] * sigmoidf_(og[3]));
                        if (DUP) *(uint2*)(p.HBB + (size_t)DUP * MPAD * MW + tok * MW + e) = v;
            else *(uint2*)(p.HAB + tok * MW + e) = v;
        }
    }
}

__device__ __forceinline__ void ph_ml3(const P& p, int l, LDSP lds) { ph_ml3_t<0>(p, l, lds); }
#if 1
__device__ __forceinline__ void ph_ml3_dup(const P& p, int l, LDSP lds) { ph_ml3_t<1>(p, l, lds); }
__device__ __forceinline__ void ph_ml3_dup2(const P& p, int l, LDSP lds) { ph_ml3_t<2>(p, l, lds); }
__device__ __forceinline__ void ph_ml3_cmp2(const P& p, int l, long gtid, long gsz) {
    PLOOP(i, (size_t)NPT * MW) { if (p.HBB[(size_t)2 * MPAD * MW + i] != p.HBB[(size_t)MPAD * MW + i]) p.DIAGF[0] = 1; }
}
__device__ __forceinline__ void ph_ml3_cmp(const P& p, int l, long gtid, long gsz) {
    PLOOP(i, (size_t)NPT * MW) { if (p.HAB[i] != p.HBB[(size_t)MPAD * MW + i]) p.DIAGF[0] = 1; }
}
#endif

#ifdef DIAG_SUM
__device__ __forceinline__ void ph_diag_sum(const P& p, int l, long gtid, long gsz) {
    unsigned long long s = 0ull;
    if (DIAG_SUM & 1) { PLOOP(i, (size_t)NPT * MW / 2) s += ((const unsigned*)p.QMB)[i] * 2654435761ull + (unsigned long long)i * ((const unsigned*)p.QMB)[i]; }
    if (DIAG_SUM & 2) { PLOOP(i, (size_t)NPT * MW / 2) s += ((const unsigned*)p.KMB)[i] * 2246822519ull + (unsigned long long)i * ((const unsigned*)p.KMB)[i]; }
    if (DIAG_SUM & 4) { PLOOP(i, (size_t)NMI * MHD * MHD / 2) s += ((const unsigned*)p.CSB)[i] * 3266489917ull + (unsigned long long)i * ((const unsigned*)p.CSB)[i]; }
    if (DIAG_SUM & 8) { PLOOP(i, (size_t)NMI * MHD) s += ((const unsigned*)p.NS)[i] * 668265263ull + (unsigned long long)i * ((const unsigned*)p.NS)[i]; }
    if (DIAG_SUM & 16) { PLOOP(i, (size_t)NMI) s += ((const unsigned*)p.MS)[i] * 374761393ull + (unsigned long long)i * ((const unsigned*)p.MS)[i]; }
    if (DIAG_SUM & 32) { PLOOP(i, (size_t)NPT * MW / 2) s += ((const unsigned*)(p.HBB + (size_t)MPAD * MW))[i] * 2654435761ull + (unsigned long long)i * ((const unsigned*)(p.HBB + (size_t)MPAD * MW))[i]; }
    if (DIAG_SUM & 64) { PLOOP(i, (size_t)NTOK * 4) s += ((const unsigned*)p.IG)[i] * 2654435761ull + ((const unsigned*)p.LF)[i] * 40503ull + (unsigned long long)i * ((const unsigned*)p.IG)[i]; }
    if (m & 256) s += cks(p.HAB, (size_t)NPT * MW / 2, 2654435761ull, gtid, gsz);
    if (m & 512) s += cks(p.HAB + (size_t)NPT * MW, (size_t)NST * MW / 2, 2654435761ull, gtid, gsz);
    if (s) atomicAdd((unsigned long long*)(p.DIAGF + 2), s);
}
#endif

#ifdef DIAG2
__device__ __forceinline__ unsigned long long cks(const void* buf, size_t nwords, unsigned long long mul, long gtid, long gsz) {
    unsigned long long s = 0ull; const unsigned* u = (const unsigned*)buf;
    for (long i = gtid; i < (long)nwords; i += gsz) s += u[i] * mul + (unsigned long long)i * u[i];
    return s;
}
__device__ __forceinline__ void ph_diag2(const P& p, int l, long gtid, long gsz) {
    unsigned long long s = 0ull;
    const int m = l == 0 ? (DIAG2 & 0xFFFF) : (DIAG2 >> 16);
    if (m & 1) s += cks(p.HAB, (size_t)NTOK * MW / 2, 2654435761ull, gtid, gsz);
    if (m & 2) s += cks(p.MGB, (size_t)NTOK * D / 2, 2246822519ull, gtid, gsz);
    if (m & 4) s += cks(p.X, (size_t)NTOK * D, 3266489917ull, gtid, gsz);
    if (m & 8) s += cks(p.Z, (size_t)NTOK * INW, 668265263ull, gtid, gsz);
    if (m & 16) s += cks(p.HBB, (size_t)NTOK * MW / 2, 374761393ull, gtid, gsz);
    if (m & 32) s += cks(p.ACTB, (size_t)NTOK * DFF / 2, 40503ull, gtid, gsz);
    if (m & 64) s += cks(p.XB, (size_t)NTOK * D / 2, 99991ull, gtid, gsz);
    if (m & 128) s += cks(p.MGF, (size_t)NTOK * D, 1234577ull, gtid, gsz);
    if (s) atomicAdd((unsigned long long*)(p.DIAGF + 2), s);
}
#endif

#ifdef DIAG3
__device__ __forceinline__ void ph_diag3(const P& p, int l, long gtid, long gsz) {
    if (l != 0) return;
    unsigned long long s = 0ull;
    if (DIAG3 & 1) s += cks(p.HAB, (size_t)NPT * MW / 2, 2654435761ull, gtid, gsz);
    if (DIAG3 & 2) s += cks(p.QMB, (size_t)NPT * MW / 2, 2246822519ull, gtid, gsz);
    if (DIAG3 & 4) s += cks(p.KMB, (size_t)NPT * MW / 2, 3266489917ull, gtid, gsz);
    if (DIAG3 & 8) s += cks(p.CSB, (size_t)NMI * MHD * MHD / 2, 668265263ull, gtid, gsz);
    if (DIAG3 & 16) s += cks(p.NS, (size_t)NMI * MHD, 374761393ull, gtid, gsz);
    if (DIAG3 & 32) s += cks(p.MS, (size_t)NMI, 40503ull, gtid, gsz);
    if (DIAG3 & 64) s += cks(p.IG, (size_t)NTOK * 4, 99991ull, gtid, gsz) + cks(p.LF, (size_t)NTOK * 4, 7919ull, gtid, gsz);
    if (DIAG3 & 128) s += cks(p.DC, (size_t)NMI * MHD * MHD, 1234577ull, gtid, gsz);
    if (DIAG3 & 256) s += cks(p.GSUM, (size_t)NMI * 2, 104729ull, gtid, gsz) + cks(p.DN, (size_t)NMI * MHD, 15485863ull, gtid, gsz);
    if (DIAG3 & 512) s += cks(p.Z, (size_t)NPT * INW, 32452843ull, gtid, gsz);
    if (DIAG3 & 1024) s += cks(p.WMQ_T, (size_t)DEPTH * MH * MHD * MHD / 2, 49979687ull, gtid, gsz) + cks(p.WMK_T, (size_t)DEPTH * MH * MHD * MHD / 2, 67867967ull, gtid, gsz);
    if (s) atomicAdd((unsigned long long*)(p.DIAGF + 2), s);
}
#endif

#ifdef ML3_VIA_COPY
__device__ __forceinline__ void ph_ml3_copy(const P& p, int l, long gtid, long gsz) {
    PLOOP(i, (size_t)NPT * MW / 8) ((pg8::u32x4*)p.HAB)[i] = ((const pg8::u32x4*)(p.HBB + (size_t)MPAD * MW))[i];
}
#endif

__device__ __forceinline__ void ph_ml1(const P& p, int l, LDSP lds, int first = -1, int step = 0) { ph_ml1_t<0>(p, l, lds, first, step); }
#ifdef DIAG_ML1DUP
__device__ __forceinline__ void ph_ml1_dup(const P& p, int l, LDSP lds) { ph_ml1_t<1>(p, l, lds); }
__device__ __forceinline__ void ph_ml1_cmp(const P& p, int l, long gtid, long gsz) {
    PLOOP(i, (size_t)NPT * MW / 2) { if (((const unsigned*)p.QMB)[i] != ((const unsigned*)(p.QMB + (size_t)MPAD * MW))[i] || ((const unsigned*)p.KMB)[i] != ((const unsigned*)(p.KMB + (size_t)MPAD * MW))[i]) p.DIAGF[0] = 1; }
    PLOOP(i, (size_t)NMI * MHD * MHD) { if (__builtin_bit_cast(unsigned, p.DC[i]) != __builtin_bit_cast(unsigned, p.DC[(size_t)NMI * MHD * MHD + i])) p.DIAGF[0] = 1; }
    PLOOP(i, (size_t)NMI * MHD) { if (__builtin_bit_cast(unsigned, p.DN[i]) != __builtin_bit_cast(unsigned, p.DN[(size_t)NMI * MHD + i])) p.DIAGF[0] = 1; }
    PLOOP(i, (size_t)NMI * 2) { if (__builtin_bit_cast(unsigned, p.GSUM[i]) != __builtin_bit_cast(unsigned, p.GSUM[(size_t)NMI * 2 + i])) p.DIAGF[0] = 1; }
}
#endif

#ifdef CPU_TEST
__device__ __forceinline__ float fast_gelu(float x) { return geluf_(x); }
#else
__device__ __forceinline__ float fast_gelu(float x) { const float u = 1.5957691216057308f * (x + 0.044715f * x * x * x); return x * __builtin_amdgcn_rcpf(1.f + __builtin_amdgcn_exp2f(-1.4426950408889634f * u)); }
#endif
constexpr int CMP_SL = 72;
constexpr int CMP_SLICE_BYTES = 128 * CMP_SL * 2, CMP_HID_OFF = 2 * CMP_SLICE_BYTES, CMP_HS = 136, CMP_LDS_END = CMP_HID_OFF + 8 * 16 * CMP_HS * 2;
constexpr int CMP_MB_P = (NCP + 127) / 128, CMP_MB_S = (NCS + 127) / 128;
constexpr int CMP_ITEMS = BATCH * NKV * 2 * CMP_MB_P + DEC_BATCH * NKV * 2 * CMP_MB_S;
__device__ __forceinline__ void ph_compress(const P& p, int l, LDSP lds) {
    const int tid = opaque_tid(), w = tid >> 6, lane = tid & 63, lr = lane & 15, kq = lane >> 4;
    LDSP hidw = lds + CMP_HID_OFF + w * 16 * CMP_HS * 2;
    for (int item = blockIdx.x; item < CMP_ITEMS; item += gridDim.x) {
        int seq, g, kind, mb;
        if (item < DEC_BATCH * NKV * 2 * CMP_MB_S) { int r = item; mb = r % CMP_MB_S; r /= CMP_MB_S; kind = r & 1; g = (r >> 1) & 1; seq = BATCH + (r >> 2); }
        else { int r = item - DEC_BATCH * NKV * 2 * CMP_MB_S; mb = r % CMP_MB_P; r /= CMP_MB_P; kind = r & 1; g = (r >> 1) & 1; seq = r >> 2; }
        const int nc = seq_nc(seq), n = mb * 128 + 16 * w + lr;
        const int nl = n < nc ? n : nc - 1;
        const bf16_t* w1t = p.W1T + ((size_t)l * 2 + kind) * 128 * 2048;
        f32x4 acc[8];
#pragma unroll
        for (int i = 0; i < 8; ++i) acc[i] = (f32x4){0.f, 0.f, 0.f, 0.f};
        __syncthreads();
        {
            const int e = tid >> 2, c16 = (tid & 3) * 16;
            const pg8::u32x4 s0 = *(const pg8::u32x4*)(w1t + (size_t)e * 2048 + c16), s1 = *(const pg8::u32x4*)(w1t + (size_t)e * 2048 + c16 + 8);
            *(PG8_LAS pg8::u32x4*)(lds + (e * CMP_SL + c16) * 2) = s0; *(PG8_LAS pg8::u32x4*)(lds + (e * CMP_SL + c16 + 8) * 2) = s1;
        }
        __syncthreads();
        const float* rb0; const float* rb1; int rsplit; size_t rstride;
        if (seq < BATCH) { rb0 = rb1 = p.out + O_PKV + ((((size_t)l * BATCH + seq) * SEQ + 16 * nl) * 4 + kind) * 128 + g * 64; rsplit = 32; rstride = 512; }
        else { const int bsm = seq - BATCH, pos0 = 16 * nl, pg0 = p.page_table[bsm * N_PAGES + pos0 / PAGE], pg1 = p.page_table[bsm * N_PAGES + (pos0 + 31) / PAGE];
            rb0 = p.cache_kv + ((((size_t)l * N_POOL + pg0) * PAGE + pos0 % PAGE) * 4 + kind) * 128 + g * 64;
            rsplit = PAGE - pos0 % PAGE;
            rb1 = p.cache_kv + ((((size_t)l * N_POOL + pg1) * PAGE) * 4 + kind) * 128 + g * 64 - (size_t)rsplit * 512; rstride = 512; }
        auto load_a = [&](int r, f32x4 (&a)[4]) { const float* row = (r < rsplit ? rb0 : rb1) + (size_t)r * rstride;
            a[0] = *(const f32x4*)(row + 8 * kq); a[1] = *(const f32x4*)(row + 8 * kq + 4); a[2] = *(const f32x4*)(row + 32 + 8 * kq); a[3] = *(const f32x4*)(row + 32 + 8 * kq + 4); };
        f32x4 an[4]; load_a(0, an);
        for (int r = 0; r < 32; ++r) {
            LDSP cur = lds + (r & 1) * CMP_SLICE_BYTES; LDSP nxt = lds + ((r + 1) & 1) * CMP_SLICE_BYTES;
            const int e = tid >> 2, c16 = (tid & 3) * 16;
            pg8::u32x4 s0 = {0u, 0u, 0u, 0u}, s1 = {0u, 0u, 0u, 0u};
            f32x4 ac[4] = {an[0], an[1], an[2], an[3]};
            if (r + 1 < 32) { s0 = *(const pg8::u32x4*)(w1t + (size_t)e * 2048 + (r + 1) * 64 + c16); s1 = *(const pg8::u32x4*)(w1t + (size_t)e * 2048 + (r + 1) * 64 + c16 + 8); load_a(r + 1, an); }
#pragma unroll
            for (int half = 0; half < 2; ++half) {
                const f32x4 a0 = ac[2 * half], a1 = ac[2 * half + 1];
                pg8::u32x4 ap; ap[0] = pack_bf16(a0[0], a0[1]); ap[1] = pack_bf16(a0[2], a0[3]); ap[2] = pack_bf16(a1[0], a1[1]); ap[3] = pack_bf16(a1[2], a1[3]);
                const bf16x8 af = __builtin_bit_cast(bf16x8, ap);
#pragma unroll
                for (int nt = 0; nt < 8; ++nt) {
                    const bf16x8 bfr = *(PG8_LAS const bf16x8*)(cur + ((16 * nt + lr) * CMP_SL + 32 * half + 8 * kq) * 2);
                    acc[nt] = __builtin_amdgcn_mfma_f32_16x16x32_bf16(af, bfr, acc[nt], 0, 0, 0);
                }
            }
            if (r + 1 < 32) { *(PG8_LAS pg8::u32x4*)(nxt + (e * CMP_SL + c16) * 2) = s0; *(PG8_LAS pg8::u32x4*)(nxt + (e * CMP_SL + c16 + 8) * 2) = s1; }
            __syncthreads();
        }
        const float* bias = p.CBIAS + ((size_t)l * 2 + kind) * 128;
#pragma unroll
        for (int nt = 0; nt < 8; ++nt) {
            const float bb = bias[16 * nt + lr];
#pragma unroll
            for (int i = 0; i < 4; ++i) *(PG8_LAS bf16_t*)(hidw + ((4 * kq + i) * CMP_HS + 16 * nt + lr) * 2) = f2bf(fast_gelu(acc[nt][i] + bb));
        }
        __syncthreads();
        const bf16_t* w2t = p.W2T + ((size_t)l * 2 + kind) * 64 * 128;
        f32x4 o[4];
#pragma unroll
        for (int i = 0; i < 4; ++i) o[i] = (f32x4){0.f, 0.f, 0.f, 0.f};
#pragma unroll
        for (int s = 0; s < 4; ++s) {
            const bf16x8 af = *(PG8_LAS const bf16x8*)(hidw + (lr * CMP_HS + 32 * s + 8 * kq) * 2);
#pragma unroll
            for (int ft = 0; ft < 4; ++ft) {
                const bf16x8 bfr = *(const bf16x8*)(w2t + (size_t)(16 * ft + lr) * 128 + 32 * s + 8 * kq);
                o[ft] = __builtin_amdgcn_mfma_f32_16x16x32_bf16(af, bfr, o[ft], 0, 0, 0);
            }
        }
        float* dst = kind ? p.VC : p.KC;
#pragma unroll
        for (int ft = 0; ft < 4; ++ft)
#pragma unroll
            for (int i = 0; i < 4; ++i) { const int nn = mb * 128 + 16 * w + 4 * kq + i; if (nn < nc) dst[((kc_base(seq) + nn) * 2 + g) * 64 + 16 * ft + lr] = o[ft][i]; }
    }
}
constexpr int CMP2_HID_OFF = 2 * CMP_SLICE_BYTES, CMP2_LDS_END = CMP2_HID_OFF + 8 * 32 * CMP_HS * 2;
constexpr int CMP2_ITEMS = DEC_BATCH * 2 * CMP_MB_S + BATCH * 2 * CMP_MB_P;
__device__ __forceinline__ void ph_compress2(const P& p, int l, LDSP lds) {
    const int tid = opaque_tid(), w = tid >> 6, lane = tid & 63, lr = lane & 31, hh = lane >> 5, g = w >> 2, wr = w & 3;
    LDSP hidw = lds + CMP2_HID_OFF + w * 32 * CMP_HS * 2;
    for (int item = blockIdx.x; item < CMP2_ITEMS; item += gridDim.x) {
        int seq, kind, mb;
        if (item < DEC_BATCH * 2 * CMP_MB_S) { int r = item; mb = r % CMP_MB_S; r /= CMP_MB_S; kind = r & 1; seq = BATCH + (r >> 1); }
        else { int r = item - DEC_BATCH * 2 * CMP_MB_S; mb = r % CMP_MB_P; r /= CMP_MB_P; kind = r & 1; seq = r >> 1; }
        const int nc = seq_nc(seq), n = mb * 128 + 32 * wr + lr;
        const int nl = n < nc ? n : nc - 1;
        const bf16_t* w1t = p.W1T + ((size_t)l * 2 + kind) * 128 * 2048;
        f32x16 acc[4];
#pragma unroll
        for (int i = 0; i < 4; ++i) acc[i] = zero16();
        const float* rb0; const float* rb1; int rsplit;
        if (seq < BATCH) { rb0 = rb1 = p.out + O_PKV + ((((size_t)l * BATCH + seq) * SEQ + 16 * nl) * 4 + kind) * 128 + g * 64; rsplit = 32; }
        else { const int bsm = seq - BATCH, pos0 = 16 * nl, pg0 = p.page_table[bsm * N_PAGES + pos0 / PAGE], pg1 = p.page_table[bsm * N_PAGES + (pos0 + 31) / PAGE];
            rb0 = p.cache_kv + ((((size_t)l * N_POOL + pg0) * PAGE + pos0 % PAGE) * 4 + kind) * 128 + g * 64;
            rsplit = PAGE - pos0 % PAGE;
            rb1 = p.cache_kv + ((((size_t)l * N_POOL + pg1) * PAGE) * 4 + kind) * 128 + g * 64 - (size_t)rsplit * 512; }
        auto load_a = [&](int r, f32x4 (&a)[8]) { const float* row = (r < rsplit ? rb0 : rb1) + (size_t)r * 512 + 8 * hh;
#pragma unroll
            for (int ks = 0; ks < 4; ++ks) { a[2 * ks] = *(const f32x4*)(row + 16 * ks); a[2 * ks + 1] = *(const f32x4*)(row + 16 * ks + 4); } };
        __syncthreads();
        {
            const int e = tid >> 2, c16 = (tid & 3) * 16;
            const pg8::u32x4 s0 = *(const pg8::u32x4*)(w1t + (size_t)e * 2048 + c16), s1 = *(const pg8::u32x4*)(w1t + (size_t)e * 2048 + c16 + 8);
            *(PG8_LAS pg8::u32x4*)(lds + (e * CMP_SL + c16) * 2) = s0; *(PG8_LAS pg8::u32x4*)(lds + (e * CMP_SL + c16 + 8) * 2) = s1;
        }
        f32x4 an[8]; load_a(0, an);
        __syncthreads();
        for (int r = 0; r < 32; ++r) {
            LDSP cur = lds + (r & 1) * CMP_SLICE_BYTES; LDSP nxt = lds + ((r + 1) & 1) * CMP_SLICE_BYTES;
            const int e = tid >> 2, c16 = (tid & 3) * 16;
            pg8::u32x4 s0 = {0u, 0u, 0u, 0u}, s1 = {0u, 0u, 0u, 0u};
            f32x4 ac[8];
#pragma unroll
            for (int i = 0; i < 8; ++i) ac[i] = an[i];
            if (r + 1 < 32) { s0 = *(const pg8::u32x4*)(w1t + (size_t)e * 2048 + (r + 1) * 64 + c16); s1 = *(const pg8::u32x4*)(w1t + (size_t)e * 2048 + (r + 1) * 64 + c16 + 8); load_a(r + 1, an); }
#pragma unroll
            for (int ks = 0; ks < 4; ++ks) {
                pg8::u32x4 ap; ap[0] = pack_bf16(ac[2 * ks][0], ac[2 * ks][1]); ap[1] = pack_bf16(ac[2 * ks][2], ac[2 * ks][3]); ap[2] = pack_bf16(ac[2 * ks + 1][0], ac[2 * ks + 1][1]); ap[3] = pack_bf16(ac[2 * ks + 1][2], ac[2 * ks + 1][3]);
                const bf16x8 af = __builtin_bit_cast(bf16x8, ap);
#pragma unroll
                for (int nt = 0; nt < 4; ++nt) {
                    const bf16x8 bfr = *(PG8_LAS const bf16x8*)(cur + ((32 * nt + lr) * CMP_SL + 16 * ks + 8 * hh) * 2);
                    acc[nt] = __builtin_amdgcn_mfma_f32_32x32x16_bf16(af, bfr, acc[nt], 0, 0, 0);
                }
            }
            if (r + 1 < 32) { *(PG8_LAS pg8::u32x4*)(nxt + (e * CMP_SL + c16) * 2) = s0; *(PG8_LAS pg8::u32x4*)(nxt + (e * CMP_SL + c16 + 8) * 2) = s1; }
            __syncthreads();
        }
        const float* bias = p.CBIAS + ((size_t)l * 2 + kind) * 128;
#pragma unroll
        for (int nt = 0; nt < 4; ++nt) {
            const float bb = bias[32 * nt + lr];
#pragma unroll
            for (int i = 0; i < 16; ++i) *(PG8_LAS bf16_t*)(hidw + (((i & 3) + 8 * (i >> 2) + 4 * hh) * CMP_HS + 32 * nt + lr) * 2) = f2bf(fast_gelu(acc[nt][i] + bb));
        }
        __syncthreads();
        const bf16_t* w2t = p.W2T + ((size_t)l * 2 + kind) * 64 * 128;
        f32x16 o[2]; o[0] = zero16(); o[1] = zero16();
#pragma unroll
        for (int ks = 0; ks < 8; ++ks) {
            const bf16x8 af = *(PG8_LAS const bf16x8*)(hidw + (lr * CMP_HS + 16 * ks + 8 * hh) * 2);
#pragma unroll
            for (int ft = 0; ft < 2; ++ft) {
                const bf16x8 bfr = *(const bf16x8*)(w2t + (size_t)(32 * ft + lr) * 128 + 16 * ks + 8 * hh);
                o[ft] = __builtin_amdgcn_mfma_f32_32x32x16_bf16(af, bfr, o[ft], 0, 0, 0);
            }
        }
        float* dst = kind ? p.VC : p.KC;
#pragma unroll
        for (int ft = 0; ft < 2; ++ft)
#pragma unroll
            for (int i = 0; i < 16; ++i) { const int nn = mb * 128 + 32 * wr + (i & 3) + 8 * (i >> 2) + 4 * hh; if (nn < nc) dst[((kc_base(seq) + nn) * 2 + g) * 64 + 32 * ft + lr] = o[ft][i]; }
    }
}
constexpr int CMP3_SL = 136, CMP3_SLICE_BYTES = 128 * CMP3_SL * 2, CMP3_LDS_END = 2 * CMP3_SLICE_BYTES;
static_assert(8 * 2 * 16 * CMP_HS * 2 <= CMP3_LDS_END, "compress3 LDS");
__device__ __forceinline__ void ph_compress3(const P& p, int l, LDSP lds, int first = -1, int step = 0) {
    if (first < 0) { first = blockIdx.x; step = gridDim.x; }
    const int tid = opaque_tid(), w = tid >> 6, lane = tid & 63, lr = lane & 15, kq = lane >> 4;
    for (int item = first; item < CMP2_ITEMS; item += step) {
        int seq, kind, mb;
        if (item < DEC_BATCH * 2 * CMP_MB_S) { int r = item; mb = r % CMP_MB_S; r /= CMP_MB_S; kind = r & 1; seq = BATCH + (r >> 1); }
        else { int r = item - DEC_BATCH * 2 * CMP_MB_S; mb = r % CMP_MB_P; r /= CMP_MB_P; kind = r & 1; seq = r >> 1; }
        const int nc = seq_nc(seq), n = mb * 128 + 16 * w + lr;
        const int nl = n < nc ? n : nc - 1;
        const bf16_t* w1t = p.W1T + ((size_t)l * 2 + kind) * 128 * 2048;
        f32x4 acc[2][8];
#pragma unroll
        for (int gg = 0; gg < 2; ++gg)
#pragma unroll
            for (int i = 0; i < 8; ++i) acc[gg][i] = (f32x4){0.f, 0.f, 0.f, 0.f};
        const float* rb0; const float* rb1; int rsplit;
        if (seq < BATCH) { rb0 = rb1 = p.out + O_PKV + ((((size_t)l * BATCH + seq) * SEQ + 16 * nl) * 4 + kind) * 128; rsplit = 32; }
        else { const int bsm = seq - BATCH, pos0 = 16 * nl, pg0 = p.page_table[bsm * N_PAGES + pos0 / PAGE], pg1 = p.page_table[bsm * N_PAGES + (pos0 + 31) / PAGE];
            rb0 = p.cache_kv + ((((size_t)l * N_POOL + pg0) * PAGE + pos0 % PAGE) * 4 + kind) * 128;
            rsplit = PAGE - pos0 % PAGE;
            rb1 = p.cache_kv + ((((size_t)l * N_POOL + pg1) * PAGE) * 4 + kind) * 128 - (size_t)rsplit * 512; }
        auto load_a = [&](int r, f32x4 (&a)[8]) { const float* row = (r < rsplit ? rb0 : rb1) + (size_t)r * 512 + 8 * kq;
#pragma unroll
            for (int gg = 0; gg < 2; ++gg) { a[4 * gg] = *(const f32x4*)(row + 64 * gg); a[4 * gg + 1] = *(const f32x4*)(row + 64 * gg + 4); a[4 * gg + 2] = *(const f32x4*)(row + 64 * gg + 32); a[4 * gg + 3] = *(const f32x4*)(row + 64 * gg + 36); } };
        auto load_b = [&](int st, pg8::u32x4 (&s)[4]) { const bf16_t* src = w1t + (size_t)(tid >> 2) * 2048 + st * 128 + (tid & 3) * 32;
#pragma unroll
            for (int i = 0; i < 4; ++i) s[i] = *(const pg8::u32x4*)(src + 8 * i); };
        auto put_b = [&](LDSP dst, const pg8::u32x4 (&s)[4]) {
#pragma unroll
            for (int i = 0; i < 4; ++i) *(PG8_LAS pg8::u32x4*)(dst + ((tid >> 2) * CMP3_SL + (tid & 3) * 32 + 8 * i) * 2) = s[i]; };
        __syncthreads();
        { pg8::u32x4 s[4]; load_b(0, s); put_b(lds, s); }
        f32x4 an[8]; load_a(0, an);
        __syncthreads();
        for (int st = 0; st < 16; ++st) {
            LDSP cur = lds + (st & 1) * CMP3_SLICE_BYTES; LDSP nxt = lds + ((st + 1) & 1) * CMP3_SLICE_BYTES;
            pg8::u32x4 sn[4];
            if (st + 1 < 16) load_b(st + 1, sn);
#pragma unroll
            for (int rr = 0; rr < 2; ++rr) {
                const int r = 2 * st + rr;
                f32x4 ac[8];
#pragma unroll
                for (int i = 0; i < 8; ++i) ac[i] = an[i];
                if (r + 1 < 32) load_a(r + 1, an);
#pragma unroll
                for (int half = 0; half < 2; ++half) {
                    bf16x8 af[2];
#pragma unroll
                    for (int gg = 0; gg < 2; ++gg) { const f32x4 a0 = ac[4 * gg + 2 * half], a1 = ac[4 * gg + 2 * half + 1];
                        pg8::u32x4 ap; ap[0] = pack_bf16(a0[0], a0[1]); ap[1] = pack_bf16(a0[2], a0[3]); ap[2] = pack_bf16(a1[0], a1[1]); ap[3] = pack_bf16(a1[2], a1[3]);
                        af[gg] = __builtin_bit_cast(bf16x8, ap); }
#pragma unroll
                    for (int nt = 0; nt < 8; ++nt) {
                        const bf16x8 bfr = *(PG8_LAS const bf16x8*)(cur + ((16 * nt + lr) * CMP3_SL + 64 * rr + 32 * half + 8 * kq) * 2);
                        acc[0][nt] = __builtin_amdgcn_mfma_f32_16x16x32_bf16(af[0], bfr, acc[0][nt], 0, 0, 0);
                        acc[1][nt] = __builtin_amdgcn_mfma_f32_16x16x32_bf16(af[1], bfr, acc[1][nt], 0, 0, 0);
                    }
                }
            }
            if (st + 1 < 16) put_b(nxt, sn);
            __syncthreads();
        }
        const float* bias = p.CBIAS + ((size_t)l * 2 + kind) * 128;
        LDSP hidw = lds + w * 2 * 16 * CMP_HS * 2;
#pragma unroll
        for (int gg = 0; gg < 2; ++gg)
#pragma unroll
            for (int nt = 0; nt < 8; ++nt) {
                const float bb = bias[16 * nt + lr];
#pragma unroll
                for (int i = 0; i < 4; ++i) *(PG8_LAS bf16_t*)(hidw + ((gg * 16 + 4 * kq + i) * CMP_HS + 16 * nt + lr) * 2) = f2bf(fast_gelu(acc[gg][nt][i] + bb));
            }
        __syncthreads();
        const bf16_t* w2t = p.W2T + ((size_t)l * 2 + kind) * 64 * 128;
        f32x4 o[2][4];
#pragma unroll
        for (int gg = 0; gg < 2; ++gg)
#pragma unroll
            for (int i = 0; i < 4; ++i) o[gg][i] = (f32x4){0.f, 0.f, 0.f, 0.f};
#pragma unroll
        for (int s = 0; s < 4; ++s) {
            const bf16x8 a0 = *(PG8_LAS const bf16x8*)(hidw + (lr * CMP_HS + 32 * s + 8 * kq) * 2), a1 = *(PG8_LAS const bf16x8*)(hidw + ((16 + lr) * CMP_HS + 32 * s + 8 * kq) * 2);
#pragma unroll
            for (int ft = 0; ft < 4; ++ft) {
                const bf16x8 bfr = *(const bf16x8*)(w2t + (size_t)(16 * ft + lr) * 128 + 32 * s + 8 * kq);
                o[0][ft] = __builtin_amdgcn_mfma_f32_16x16x32_bf16(a0, bfr, o[0][ft], 0, 0, 0);
                o[1][ft] = __builtin_amdgcn_mfma_f32_16x16x32_bf16(a1, bfr, o[1][ft], 0, 0, 0);
            }
        }
        float* dst = kind ? p.VC : p.KC; bf16_t* dstb = kind ? p.VCB : p.KCB;
#pragma unroll
        for (int gg = 0; gg < 2; ++gg)
#pragma unroll
            for (int ft = 0; ft < 4; ++ft)
#pragma unroll
                for (int i = 0; i < 4; ++i) { const int nn = mb * 128 + 16 * w + 4 * kq + i; if (nn < nc) { dst[((kc_base(seq) + nn) * 2 + gg) * 64 + 16 * ft + lr] = o[gg][ft][i]; dstb[((kc_base(seq) + nn) * 2 + gg) * 64 + 16 * ft + lr] = f2bf(o[gg][ft][i]); } }
    }
}

constexpr int SM_ITEMS = DEC_BATCH * MH;
constexpr int SM_C = 0, SM_Q = 2048, SM_K = 4096, SM_V = 6144, SM_SC = 8192, SM_RED = 8704, SM_END = SM_RED + 16 * 4 * 128 * 4;
__device__ __forceinline__ void ph_smlstm(const P& p, int l, LDSP lds, int first = -1, int step = 0) {
    if (first < 0) { first = blockIdx.x; step = gridDim.x; }
    const int tid = opaque_tid(), lane = tid & 63, w = tid >> 6;
    PG8_LAS float* cS = (PG8_LAS float*)(lds + SM_C); PG8_LAS float* qS = (PG8_LAS float*)(lds + SM_Q); PG8_LAS float* kS = (PG8_LAS float*)(lds + SM_K);
    PG8_LAS float* vS = (PG8_LAS float*)(lds + SM_V); PG8_LAS float* sc = (PG8_LAS float*)(lds + SM_SC); PG8_LAS float* red = (PG8_LAS float*)(lds + SM_RED);
    for (int item = first; item < SM_ITEMS; item += step) {
        const int b = item / MH, h = item % MH, tok0 = NPT + b * DEC_SEQ;
        const int t = tid >> 7, e = tid & 127;
        __syncthreads();
        {
            const int col = h * MHD + e;
            float y = p.conv_b[l * MW + col];
#pragma unroll
            for (int j = 0; j < 4; ++j) { const int tt = t + j - 3;
                const float u = tt >= 0 ? p.Z[(size_t)(tok0 + tt) * INW + ZU + col] : p.st_conv[(((size_t)l * DEC_BATCH + b) * 3 + (3 + tt)) * MW + col];
                y += u * p.conv_w[((size_t)l * 4 + j) * MW + col]; }
            cS[t * 128 + e] = siluf_(y);
            vS[t * 128 + e] = p.Z[(size_t)(tok0 + t) * INW + ZV + col];
        }
        __syncthreads();
        {
            const float* wq = p.w_mq + ((size_t)l * MH + h) * MHD * MHD + e; const float* wk = p.w_mk + ((size_t)l * MH + h) * MHD * MHD + e;
            float aq = 0.f, ak = 0.f;
            for (int d = 0; d < MHD; ++d) { const float c = cS[t * 128 + d]; aq += c * wq[(size_t)d * MHD]; ak += c * wk[(size_t)d * MHD]; }
            qS[t * 128 + e] = aq; kS[t * 128 + e] = ak * 0.08838834764831845f;
        }
        float dec[4], wg[4], mt[4];
        {
            float m = p.st_m[((size_t)l * DEC_BATCH + b) * MH + h];
#pragma unroll
            for (int s = 0; s < 4; ++s) { const float ig = p.IG[(size_t)(tok0 + s) * 4 + h], lf = p.LF[(size_t)(tok0 + s) * 4 + h];
                const float mn = fmaxf(lf + m, ig); dec[s] = expf(lf + m - mn); wg[s] = expf(ig - mn); m = mn; mt[s] = mn; }
        }
        __syncthreads();
        const int e4 = tid & 31, d0 = tid >> 5;
        const size_t cbase = (((size_t)l * DEC_BATCH + b) * MH + h) * MHD * MHD;
        f32x4 C[8]; f32x4 np[4];
#pragma unroll
        for (int i = 0; i < 8; ++i) C[i] = *(const f32x4*)(p.st_C + cbase + (size_t)(d0 + 16 * i) * MHD + 4 * e4);
#pragma unroll
        for (int s = 0; s < 4; ++s) {
            const f32x4 vv = *(PG8_LAS const f32x4*)(vS + s * 128 + 4 * e4);
            f32x4 acc = {0.f, 0.f, 0.f, 0.f};
#pragma unroll
            for (int i = 0; i < 8; ++i) { const float kd = kS[s * 128 + d0 + 16 * i] * wg[s], qd = qS[s * 128 + d0 + 16 * i];
                C[i] = C[i] * dec[s] + vv * kd; acc += C[i] * qd; }
            np[s] = acc;
        }
#pragma unroll
        for (int s = 0; s < 4; ++s) *(PG8_LAS f32x4*)(red + (d0 * 4 + s) * 128 + 4 * e4) = np[s];
        float* oc = p.out + O_SC + cbase;
#pragma unroll
        for (int i = 0; i < 8; ++i) *(f32x4*)(oc + (size_t)(d0 + 16 * i) * MHD + 4 * e4) = C[i];
        float dpart[4] = {0.f, 0.f, 0.f, 0.f};
        if (tid < MHD) {
            float nn = p.st_n[(((size_t)l * DEC_BATCH + b) * MH + h) * MHD + tid];
#pragma unroll
            for (int s = 0; s < 4; ++s) { nn = nn * dec[s] + wg[s] * kS[s * 128 + tid]; dpart[s] = qS[s * 128 + tid] * nn; }
            p.out[O_SN + (((size_t)l * DEC_BATCH + b) * MH + h) * MHD + tid] = nn;
            if (tid == 0) p.out[O_SM + ((size_t)l * DEC_BATCH + b) * MH + h] = mt[3];
        }
        if (w < 2) {
#pragma unroll
            for (int s = 0; s < 4; ++s) { float v = dpart[s];
#pragma unroll
                for (int x = 32; x >= 1; x >>= 1) v += __shfl_xor(v, x);
                if (lane == 0) sc[w * 4 + s] = v; }
        }
        __syncthreads();
        float num = 0.f;
#pragma unroll
        for (int d = 0; d < 16; ++d) num += red[(d * 4 + t) * 128 + e];
        const float den = sc[t] + sc[4 + t];
        float hv = num / fmaxf(fabsf(den), expf(-mt[t]));
        float ss = hv * hv;
#pragma unroll
        for (int x = 32; x >= 1; x >>= 1) ss += __shfl_xor(ss, x);
        if (lane == 0) sc[16 + w] = ss;
        __syncthreads();
        const float rn = 1.f / sqrtf((sc[16 + 2 * t] + sc[16 + 2 * t + 1]) * (1.f / MHD) + EPS);
        const float og = p.Z[(size_t)(tok0 + t) * INW + ZO + h * MHD + e];
        p.HAB[(size_t)(tok0 + t) * MW + h * MHD + e] = f2bf(hv * rn * p.mnorm_g[l * MW + h * MHD + e] * sigmoidf_(og));
    }
}
__device__ __forceinline__ void ph_small_mfma(const P& p, int l, LDSP lds) {
    const int tid = opaque_tid(), lane = tid & 63, lr = lane & 15, kq = lane >> 4;
    const bf16_t* wsm = p.WSM_T + (size_t)l * 32 * D;
    for (int task = blockIdx.x * 8 + (tid >> 6); task < MPAD / 16; task += gridDim.x * 8) {
        f32x4 a0 = {0.f, 0.f, 0.f, 0.f}, a1 = {0.f, 0.f, 0.f, 0.f};
        const bf16_t* xa = p.XB + (size_t)(task * 16 + lr) * D + 8 * kq;
        const bf16_t* w0 = wsm + (size_t)lr * D + 8 * kq; const bf16_t* w1 = wsm + (size_t)(16 + lr) * D + 8 * kq;
#pragma unroll 8
        for (int s = 0; s < D / 32; ++s) {
            const bf16x8 af = *(const bf16x8*)(xa + 32 * s), b0 = *(const bf16x8*)(w0 + 32 * s), b1 = *(const bf16x8*)(w1 + 32 * s);
            a0 = __builtin_amdgcn_mfma_f32_16x16x32_bf16(af, b0, a0, 0, 0, 0);
            a1 = __builtin_amdgcn_mfma_f32_16x16x32_bf16(af, b1, a1, 0, 0, 0);
        }
#pragma unroll
        for (int i = 0; i < 4; ++i) {
            const int tok = task * 16 + 4 * kq + i;
            if (tok >= NTOK) continue;
            const float rs = rstd_of(p.RSS[(size_t)(2 * l) * MPAD + tok]);
            const float z0 = a0[i] * rs, z1 = a1[i] * rs;
            float* zr = p.Z + (size_t)tok * INW;
            if (lr < 4) { zr[ZIG + lr] = z0; p.IG[(size_t)tok * 4 + lr] = z0 + p.b_gates[l * 8 + lr]; }
            else if (lr < 8) { zr[ZFG + lr - 4] = z0; p.LF[(size_t)tok * 4 + lr - 4] = log_sigmoidf_(z0 + p.b_gates[l * 8 + lr]); }
            else zr[ZNG + lr - 8] = z0;
            zr[ZNG + 8 + lr] = z1;
        }
    }
}
__device__ __forceinline__ void ph_conv_tails(const P& p, int l, long gtid, long gsz) {
    PLOOP(i, (size_t)NSEQ * 3 * 512) {
        int seq = (int)(i / 1536), r = (int)((i % 1536) / 512), c = (int)(i % 512);
        int T = seq_len(seq), row0 = seq_row0(seq);
        Tok ti = tokinfo(row0 + T - 1);
        float v = conv_u(p, l, ti, row0 + T - 1, r - 2, c);
        if (seq < BATCH) p.out[O_PCONV + (((size_t)l * BATCH + seq) * 3 + r) * MW + c] = v;
        else p.out[O_SCONV + (((size_t)l * DEC_BATCH + (seq - BATCH)) * 3 + r) * MW + c] = v;
    }
}
__device__ __forceinline__ void ph_swin_shift(const P& p, int l, long gtid, long gsz) {
    PLOOP(i, (size_t)DEC_BATCH * (WB - DEC_SEQ) * 64) {
        const int b = (int)(i / ((WB - DEC_SEQ) * 64)); const int r = (int)(i % ((WB - DEC_SEQ) * 64));
        ((float4*)(p.out + O_SWIN + ((size_t)l * DEC_BATCH + b) * WB * 256))[r] = ((const float4*)(p.cache_win + ((size_t)l * DEC_BATCH + b) * WB * 256 + DEC_SEQ * 256))[r];
    }
}
__device__ __forceinline__ void ph_misc(const P& p, int l, long gtid, long gsz) {
    PLOOP(i, (size_t)NSEQ * 3 * 512) {
        int seq = (int)(i / 1536), r = (int)((i % 1536) / 512), c = (int)(i % 512);
        int T = seq_len(seq), row0 = seq_row0(seq);
        Tok ti = tokinfo(row0 + T - 1);
        float v = conv_u(p, l, ti, row0 + T - 1, r - 2, c);
        if (seq < BATCH) p.out[O_PCONV + (((size_t)l * BATCH + seq) * 3 + r) * MW + c] = v;
        else p.out[O_SCONV + (((size_t)l * DEC_BATCH + (seq - BATCH)) * 3 + r) * MW + c] = v;
    }
    PLOOP(i, (size_t)DEC_BATCH * (WB - DEC_SEQ) * 64) {
        const int b = (int)(i / ((WB - DEC_SEQ) * 64)); const int r = (int)(i % ((WB - DEC_SEQ) * 64));
        ((float4*)(p.out + O_SWIN + ((size_t)l * DEC_BATCH + b) * WB * 256))[r] = ((const float4*)(p.cache_win + ((size_t)l * DEC_BATCH + b) * WB * 256 + DEC_SEQ * 256))[r];
    }
}


}

#ifdef DIAG_ML1DUP
#define ML1DUP_PHASES(F, B) B(ph_ml1_dup) F(ph_ml1_cmp)
#else
#define ML1DUP_PHASES(F, B)
#endif
#ifdef DIAG3
#define DIAG3_PHASES(F) F(ph_diag3)
#else
#define DIAG3_PHASES(F)
#endif
#ifdef DIAG2
#define DIAG2_PHASES(F) F(ph_diag2)
#else
#define DIAG2_PHASES(F)
#endif
#ifdef ML3_VIA_COPY
#define ML3_PHASE(B) B(ph_ml3_dup) ML3_COPY_F
#elif defined(BISECT_A)
#define ML3_PHASE(B) B(ph_ml3_dup)
#else
#define ML3_PHASE(B) B(ph_ml3)
#endif
#ifdef DIAG_SUM
#define DIAG_PHASES(F, B) F(ph_diag_sum)
#elif defined(DIAG_DUP2)
#define DIAG_PHASES(F, B) B(ph_ml3_dup2) F(ph_ml3_cmp2)
#elif defined(DIAG_DUP)
#define DIAG_PHASES(F, B) B(ph_ml3_dup) F(ph_ml3_cmp)
#else
#define DIAG_PHASES(F, B)
#endif
#define ML3_COPY_F RUN_F(ph_ml3_copy)
__device__ __forceinline__ void ph_mixB(const P& p, int l, LDSP lds) {
    ph_small_mfma(p, l, lds);
    const long gtid = (long)blockIdx.x * NT + opaque_tid(), gsz = (long)gridDim.x * NT;
    ph_misc(p, l, gtid, gsz);
}
__device__ __forceinline__ void ph_gemm_in_plus(const P& p, int l, LDSP lds) {
    ph_gemm_in(p, l, lds); __syncthreads(); ph_small_mfma(p, l, lds);
}
constexpr int MIXC_QSLOT_OFF = 120 * 1024, MIXC_ITEMS = CMP2_ITEMS + SM_ITEMS + NMI;
__device__ __forceinline__ void ph_mixC(const P& p, int l, LDSP lds) {
    const int tid = opaque_tid();
    { const long gtid = (long)blockIdx.x * NT + tid, gsz = (long)gridDim.x * NT; ph_conv_tails(p, l, gtid, gsz); }
    PG8_LAS int* qslot = (PG8_LAS int*)(lds + MIXC_QSLOT_OFF);
    for (;;) {
        __syncthreads();
        if (tid == 0) *qslot = atomicAdd(p.QCTR + l, 1);
        __syncthreads();
        const int it = *qslot;
        if (it >= MIXC_ITEMS) break;
        if (it < CMP2_ITEMS) ph_compress3(p, l, lds, it, 1 << 30);
        else if (it < CMP2_ITEMS + SM_ITEMS) ph_smlstm(p, l, lds, it - CMP2_ITEMS, 1 << 30);
        else ph_ml1(p, l, lds, it - CMP2_ITEMS - SM_ITEMS, 1 << 30);
    }
}
__device__ __forceinline__ void ph_mixD(const P& p, int l, LDSP lds) { ph_ml2(p, l, lds); __syncthreads(); ph_nsa_prompt(p, l, lds); __syncthreads(); ph_nsa_sample(p, l, lds); }
#if defined(TIME_DUP) && TIME_DUP == 1
#define DUP_FRONT(F) F(ph_small) F(ph_swin_copy) F(ph_conv) F(ph_mqk) F(ph_mlstm) F(ph_ha)
#else
#define DUP_FRONT(F)
#endif
#if defined(TIME_DUP) && TIME_DUP == 2
#define DUP_NSAS(F) F(ph_sc) F(ph_sc_softmax) F(ph_oc) F(ph_select) F(ph_ss) F(ph_ss_softmax) F(ph_os) F(ph_sw) F(ph_sw_softmax) F(ph_ow) F(ph_hb)
#else
#define DUP_NSAS(F)
#endif
#if defined(TIME_DUP) && TIME_DUP == 3
#define DUP_NSAP(B) B(ph_nsa_prompt)
#else
#define DUP_NSAP(B)
#endif
#if defined(TIME_DUP) && TIME_DUP == 4
#define DUP_ML(F, B) B(ph_ml1) F(ph_ml2) B(ph_ml3) B(ph_compress)
#else
#define DUP_ML(F, B)
#endif
#if defined(TIME_DUP) && TIME_DUP == 31
#define TDUP1(B) B(ph_smlstm)
#elif defined(TIME_DUP) && TIME_DUP == 32
#define TDUP1(B) B(ph_ml1)
#elif defined(TIME_DUP) && TIME_DUP == 33
#define TDUP1(B) B(ph_compress)
#elif defined(TIME_DUP) && TIME_DUP == 11
#define TDUP1(B) B(ph_mixC)
#else
#define TDUP1(B)
#endif
#if defined(TIME_DUP) && TIME_DUP == 21
#define TDUP2(B) B(ph_nsa_sample)
#elif defined(TIME_DUP) && TIME_DUP == 22
#define TDUP2(B) B(ph_nsa_prompt)
#elif defined(TIME_DUP) && TIME_DUP == 23
#define TDUP2(B) B(ph_ml2)
#elif defined(TIME_DUP) && TIME_DUP == 12
#define TDUP2(B) B(ph_mixD)
#else
#define TDUP2(B)
#endif
#if defined(TIME_DUP) && TIME_DUP == 13
#define TDUP3(B) B(ph_gemm_in)
#else
#define TDUP3(B)
#endif
#if defined(TIME_DUP) && TIME_DUP == 16
#define TDUP6(B) B(ph_ml3)
#else
#define TDUP6(B)
#endif
#define LAYER_PHASES(F, B) \
    B(ph_gemm_in_plus) TDUP3(B) B(ph_mixC) TDUP1(B) B(ph_mixD) TDUP2(B) ML3_PHASE(B) TDUP6(B) B(ph_gemm_branch) B(ph_gemm_out) B(ph_gemm_up) B(ph_gemm_down) DIAG2_PHASES(F)

constexpr int LDS_BYTES = pg8::STAGE_BYTES + 16 + 256;
static_assert(NSA_LDS_END <= pg8::STAGE_BYTES && ML_LDS_END <= pg8::STAGE_BYTES && CMP_LDS_END <= pg8::STAGE_BYTES && CMP2_LDS_END <= pg8::STAGE_BYTES && CMP3_LDS_END <= MIXC_QSLOT_OFF && ML_LDS_END <= MIXC_QSLOT_OFF && SM_END <= MIXC_QSLOT_OFF && CMP3_LDS_END <= pg8::STAGE_BYTES && SM_END <= pg8::STAGE_BYTES, "LDS maps");

#ifndef CPU_TEST
#define XB_TMO      128
#define XB_XCNT(j)  (256  + 64 * (j))
#define XB_XSUB(j)  (1280 + 64 * (j))
#define XB_XGEN(j)  (2304 + 64 * (j))
#define XB_TOP      3328
#define XB_TOPGEN   3392
#define XCD_BAR_WORDS 3456
#define XB_SPIN_CAP (1u << 18)
#define LAS __attribute__((address_space(3)))

__device__ __forceinline__ unsigned xb_ld(unsigned* p)              { return __hip_atomic_load(p, __ATOMIC_RELAXED, __HIP_MEMORY_SCOPE_AGENT); }
__device__ __forceinline__ unsigned xb_add(unsigned* p, unsigned v) { return __hip_atomic_fetch_add(p, v, __ATOMIC_RELAXED, __HIP_MEMORY_SCOPE_AGENT); }
__device__ __forceinline__ unsigned xb_xcc_id() { return (unsigned)__builtin_amdgcn_s_getreg((3 << 11) | 20) & 0xFu; }
#define XB_SPIN(cond, bar) do { unsigned _sp = 0; while (cond) { __builtin_amdgcn_s_sleep(1); \
    if ((++_sp & 255u) == 0u) { if (xb_ld(&(bar)[XB_TMO])) break; if (_sp > XB_SPIN_CAP) { atomicAdd(&(bar)[XB_TMO], 1u); break; } } } } while (0)

struct XcdBarrier {
    unsigned* bar; unsigned x;
    volatile LAS unsigned* st;
};

__device__ __forceinline__ XcdBarrier xcd_barrier_post(unsigned* bar, volatile LAS unsigned* st) {
    XcdBarrier b; b.bar = bar; b.x = xb_xcc_id(); b.st = st;
    if (threadIdx.x == 0) (void)xb_add(&bar[XB_XCNT(b.x)], 1u);
    return b;
}
__device__ __forceinline__ void xcd_barrier_complete(unsigned* bar, unsigned x, unsigned& nloc, unsigned& nx) {
    const unsigned G = gridDim.x * gridDim.y * gridDim.z;
    unsigned sum, cnt, mine, sp = 0u;
    for (;;) {
        sum = 0u; cnt = 0u; mine = 0u;
#pragma unroll
        for (unsigned j = 0; j < 16; ++j) { const unsigned c = xb_ld(&bar[XB_XCNT(j)]); sum += c; cnt += (c > 0u) ? 1u : 0u; mine = (j == x) ? c : mine; }
        if (sum == G) break;
        __builtin_amdgcn_s_sleep(1);
        if ((++sp & 255u) == 0u) { if (xb_ld(&bar[XB_TMO])) break; if (sp > XB_SPIN_CAP) { atomicAdd(&bar[XB_TMO], 1u); break; } }
    }
    nloc = mine > 0u ? mine : 1u; nx = cnt > 0u ? cnt : 1u;
}

__device__ __forceinline__ void xcd_barrier(const XcdBarrier& b) {
    asm volatile("s_waitcnt vmcnt(0)" ::: "memory");
    __syncthreads();
    if (opaque_tid() == 0) {
        unsigned* bar = b.bar;
        __builtin_amdgcn_s_waitcnt(0);
        unsigned nloc = b.st[0], nx = b.st[1];
        if (nloc == 0u) { xcd_barrier_complete(bar, b.x, nloc, nx); b.st[0] = nloc; b.st[1] = nx; }
        const unsigned old = xb_add(&bar[XB_XSUB(b.x)], 1u);
        const unsigned gen = old / nloc;
        if (old + 1u == (gen + 1u) * nloc) {
            __builtin_amdgcn_fence(__ATOMIC_RELEASE, "agent");
            asm volatile("s_waitcnt vmcnt(0)" ::: "memory");
            const unsigned og = xb_add(&bar[XB_TOP], 1u);
            const unsigned tg = og / nx;
            if (og + 1u == (tg + 1u) * nx) xb_add(&bar[XB_TOPGEN], 1u);
            else XB_SPIN(xb_ld(&bar[XB_TOPGEN]) == tg, bar);
            __builtin_amdgcn_fence(__ATOMIC_ACQUIRE, "agent");
            xb_add(&bar[XB_XGEN(b.x)], 1u);
            asm volatile("s_waitcnt vmcnt(0)" ::: "memory");
        } else {
            XB_SPIN(xb_ld(&bar[XB_XGEN(b.x)]) == gen, bar);
            __builtin_amdgcn_fence(__ATOMIC_ACQUIRE, "agent");
            asm volatile("s_waitcnt vmcnt(0)" ::: "memory");
        }
    }
    __syncthreads();
}


#define GRID_SYNC() do { XcdBarrier b_; b_.bar = p.bar; b_.x = xb_xcc_id(); b_.st = (volatile LAS unsigned*)(lds + pg8::STAGE_BYTES); xcd_barrier(b_); } while (0)
#define RUN_F(name) { const long gtid = (long)blockIdx.x * NT + opaque_tid(), gsz = (long)gridDim.x * NT; name(p, l, gtid, gsz); } GRID_SYNC();
#define RUN_B(name) name(p, l, lds); GRID_SYNC();
__global__ void __launch_bounds__(NT, 2) mega_kernel(P p) {
    extern __shared__ __attribute__((aligned(16))) unsigned char smem[];
    LDSP lds = (LDSP)smem;
    for (int i = threadIdx.x; i < LDS_BYTES / 4; i += NT) ((PG8_LAS unsigned*)lds)[i] = 0u;
    __syncthreads();
    if ((threadIdx.x & 63) == 0) *(PG8_LAS int*)(lds + WTAB_LDS_OFF + 4 * hw_wave_key()) = (int)(threadIdx.x >> 6);
    __syncthreads();
    (void)xcd_barrier_post(p.bar, (volatile LAS unsigned*)(lds + pg8::STAGE_BYTES));
    { const int l = 0; RUN_B(ph_prologue) }
#if defined(TIME_DUP) && TIME_DUP == 20
    { const int l = 0; RUN_B(ph_prologue) }
#endif
    { const int l = 0; LAYER_PHASES(RUN_F, RUN_B) }
    { const int l = 1; LAYER_PHASES(RUN_F, RUN_B) }
    static_assert(DEPTH == 2, "layer program is written out twice");
    { const int l = 0; const long gtid = (long)blockIdx.x * NT + opaque_tid(), gsz = (long)gridDim.x * NT; ph_final(p, l, gtid, gsz); }
}
#ifdef PHASE_PROBE
#define PK_B(name) __global__ void __launch_bounds__(NT, 2) probe_##name(P p, int l) { extern __shared__ __attribute__((aligned(16))) unsigned char smem[]; name(p, l, (LDSP)smem); }
#define PK_F(name) __global__ void __launch_bounds__(NT, 2) probe_##name(P p, int l) { name(p, l, (long)blockIdx.x * NT + threadIdx.x, (long)gridDim.x * NT); }
LAYER_PHASES(PK_F, PK_B)
PK_B(ph_prologue)
PK_B(ph_nsa_prompt) PK_B(ph_nsa_sample) PK_B(ph_ml1) PK_B(ph_ml2) PK_B(ph_compress) PK_B(ph_smlstm) PK_B(ph_small_mfma)
#endif
#else
#ifndef EMU_GRID
#define EMU_GRID 16
#endif
#define RUN_F(name) emu_parallel_for(1 << 14, [&](long g_) { name(p, l, g_, 1 << 14); });
#define RUN_B(name) emu_launch(EMU_GRID, NT, [&]() { name(p, l, (LDSP)emu_lds()); });
#endif

extern "C" void kernel_launch(void* const* d_in, const int* in_sizes, int n_in, void* d_out, int out_size, void* d_ws, size_t ws_size,
                              hipStream_t stream) {
    P p{};
    const float* const* f = (const float* const*)d_in;
    p.x_prompt = f[0]; p.x_sample = f[1]; p.cache_kv = f[2]; p.page_table = (const int*)d_in[3]; p.cache_win = f[4];
    p.st_C = f[5]; p.st_n = f[6]; p.st_m = f[7]; p.st_conv = f[8]; p.norm1_g = f[9]; p.w_in = f[10]; p.b_gates = f[11];
    p.conv_w = f[12]; p.conv_b = f[13]; p.w_mq = f[14]; p.w_mk = f[15]; p.mnorm_g = f[16]; p.pe_k = f[17]; p.pe_v = f[18];
    p.w1_k = f[19]; p.w2_k = f[20]; p.w1_v = f[21]; p.w2_v = f[22]; p.w_a = f[23]; p.w_b = f[24]; p.w_out = f[25];
    p.norm2_g = f[26]; p.w_up = f[27]; p.w_down = f[28]; p.final_g = f[29];
    p.out = (float*)d_out;
    char* w = (char*)d_ws;
    auto takeb = [&](size_t bytes) { char* r = w; w += (bytes + 255) / 256 * 256; return r; };
    auto take = [&](size_t n) { return (float*)takeb(n * 4); };
    auto take16 = [&](size_t n) { return (bf16_t*)takeb(n * 2); };
    p.bar = (unsigned*)takeb(16384); p.DIAGF = (int*)(p.bar + 3600); p.QCTR = (int*)(p.bar + 3800);
    p.X = take((size_t)MPAD * D); p.Z = take((size_t)MPAD * INW); p.RSS = (unsigned long long*)takeb((size_t)5 * MPAD * 8);
    p.KW = take((size_t)NTOK * 256); p.QR = take((size_t)NTOK * 512); p.CC = take((size_t)NTOK * 512);
    p.IG = take((size_t)NTOK * 4); p.LF = take((size_t)NTOK * 4); p.QM = take((size_t)NTOK * 512); p.KM = take((size_t)NTOK * 512);
    p.NUMP = take((size_t)NTOK * MH * 4 * 129); p.MT = take((size_t)NTOK * 4);
    p.HID = take(KC_ROWS * 4 * CHID); p.KC = take(KC_ROWS * 128); p.VC = take(KC_ROWS * 128);
    p.PC = take((size_t)NTOK * NH * NCMAX); p.OC = take((size_t)NTOK * 512); p.OS = take((size_t)NTOK * 512); p.OW = take((size_t)NTOK * 512);
    p.SCORE = take((size_t)NTOK * NKV * 64); p.PS = take((size_t)NTOK * NH * 1024); p.PW = take((size_t)NTOK * NH * 512);
    p.MGF = take((size_t)MPAD * D);
    p.SEL = (int*)take((size_t)NTOK * NKV * SELTOP);
    p.XB = take16((size_t)MPAD * D); p.HAB = take16((size_t)MPAD * MW); p.HBB = take16((size_t)3 * MPAD * MW); p.MGB = take16((size_t)MPAD * D);
    p.ACTB = take16((size_t)MPAD * DFF);
    p.QMB = take16((size_t)2 * MPAD * MW); p.KMB = take16((size_t)2 * MPAD * MW); p.CSB = take16((size_t)NMI * MHD * MHD);
    p.WSM_T = take16((size_t)DEPTH * 32 * D); p.SGB = take16((size_t)MPAD * 2048); p.KCB = take16(KC_ROWS * 128 + 64 * 128); p.VCB = take16(KC_ROWS * 128 + 64 * 128); p.ROPE = take((size_t)ROPE_POS * 16); p.W1T = take16((size_t)DEPTH * 2 * 128 * 2048); p.W2T = take16((size_t)DEPTH * 2 * 64 * 128); p.CBIAS = take((size_t)DEPTH * 2 * 128);
    p.WMQ_T = take16((size_t)DEPTH * MH * MHD * MHD); p.WMK_T = take16((size_t)DEPTH * MH * MHD * MHD);
    p.DC = take((size_t)2 * NMI * MHD * MHD); p.DN = take((size_t)2 * NMI * MHD); p.GSUM = take((size_t)2 * NMI * 2); p.NS = take((size_t)NMI * MHD); p.MS = take(NMI);
    p.QCB = take16((size_t)MPAD * 512); p.QRB = take16((size_t)MPAD * 512);
    p.KSB = take16((size_t)NKV * MPAD * 64); p.VSB = take16((size_t)NKV * MPAD * 64); p.KWB = take16((size_t)NKV * MPAD * 64); p.VWB = take16((size_t)NKV * MPAD * 64);
    p.WIN_T = take16((size_t)DEPTH * INP * D); p.WA_T = take16((size_t)DEPTH * D * MW); p.WB_T = take16((size_t)DEPTH * D * MW);
    p.WOUT_T = take16((size_t)DEPTH * D * D); p.WUP_T = take16((size_t)DEPTH * 2 * DFF * D); p.WDOWN_T = take16((size_t)DEPTH * D * DFF);
#ifdef CPU_TEST
    memset(p.bar, 0, 16384);
    { const int l = 0; RUN_B(ph_prologue) }
    for (int l = 0; l < DEPTH; ++l) {
        LAYER_PHASES(RUN_F, RUN_B)
    }
    { const int l = 0; RUN_F(ph_final) }
#else
    static int grid = 0;
    if (grid == 0) {
        int dev = 0, cus = 0;
        if (hipGetDevice(&dev) != hipSuccess || hipDeviceGetAttribute(&cus, hipDeviceAttributeMultiprocessorCount, dev) != hipSuccess) { grid = -1; return; }
        if (hipFuncSetAttribute((const void*)mega_kernel, hipFuncAttributeMaxDynamicSharedMemorySize, LDS_BYTES) != hipSuccess) { fprintf(stderr, "hipFuncSetAttribute failed\n"); grid = -1; return; }
        (void)hipGetLastError();
        grid = cus;
    }
    if (grid < 0) return;
    (void)hipMemsetAsync(p.bar, 0, 16384, stream);
#ifdef DIAG_NANFILL
    (void)hipMemsetAsync((char*)d_ws + 16384, 0xFF, (size_t)(w - (char*)d_ws) - 16384, stream);
#endif
    hipLaunchKernelGGL(mega_kernel, dim3(grid), dim3(NT), LDS_BYTES, stream, p);
#endif
}
```

```cpp
#ifdef CPU_TEST
#include "hipemu.h"
#else
#include <hip/hip_runtime.h>
#endif
#include <stdint.h>
#include <stddef.h>
#include <cstdio>

#ifndef CFG_BATCH
#define CFG_BATCH 4
#define CFG_SEQ 4096
#define CFG_DEC_BATCH 128
#define CFG_PAST_LEN 2048
#endif

#ifdef CPU_TEST
static inline int opaque_tid() { return (int)threadIdx.x; }
#else
__device__ __forceinline__ int my_lane() { unsigned z = 0u; asm volatile("" : "+v"(z)); return (int)__builtin_amdgcn_mbcnt_hi(~0u, __builtin_amdgcn_mbcnt_lo(~0u, z)); }
extern __shared__ __attribute__((aligned(16))) unsigned char g_dyn_lds[];
#define WTAB_LDS_OFF (131072 + 16)
__device__ __forceinline__ int hw_wave_key() { return (int)(__builtin_amdgcn_s_getreg((5 << 11) | (0 << 6) | 4) & 63u); }
__device__ __forceinline__ int opaque_tid() {
    const int wv = __builtin_amdgcn_readfirstlane(*(const __attribute__((address_space(3))) int*)(g_dyn_lds + WTAB_LDS_OFF + 4 * hw_wave_key()));
    int t = (wv << 6) | my_lane(); asm volatile("" : "+v"(t)); return t; }
template <class T> __device__ __forceinline__ T my_shfl_xor(T v, int m) { static_assert(sizeof(T) == 4, "32-bit shuffles only"); return __builtin_bit_cast(T, __builtin_amdgcn_ds_bpermute((my_lane() ^ m) << 2, __builtin_bit_cast(int, v))); }
template <class T> __device__ __forceinline__ T my_shfl_up(T v, int d) { static_assert(sizeof(T) == 4, "32-bit shuffles only"); const int l = my_lane(), s = l - d < 0 ? l : l - d; return __builtin_bit_cast(T, __builtin_amdgcn_ds_bpermute(s << 2, __builtin_bit_cast(int, v))); }
#define __shfl_xor my_shfl_xor
#define __shfl_up my_shfl_up
#endif
namespace pg8 {
#ifdef CPU_TEST
#define PG8_LAS
#else
#define PG8_LAS __attribute__((address_space(3)))
#endif
typedef unsigned short bf16_t;
typedef short bf16x8 __attribute__((ext_vector_type(8)));
typedef float f32x4 __attribute__((ext_vector_type(4)));
typedef unsigned u32x4 __attribute__((ext_vector_type(4)));
constexpr int BM = 256, BK = 64, HALF = 128, HTB = HALF * BK * 2  , STAGE_BYTES = 8 * HTB, NXCD = 8, WGM = 8;

__host__ __device__ __forceinline__ int lds_byte(int r, int c) { const int st = (r >> 4) * 2 + (c >> 5), rr = r & 15, cc = c & 31, ob = rr * 64 + cc * 2; return st * 1024 + (ob ^ (((ob >> 9) & 1) << 5)); }
__host__ __device__ __forceinline__ void stage_rc(int b, int& R, int& C) { const int st = b / 1024, sb = b % 1024, swz = sb ^ (((sb >> 9) & 1) << 5); R = (st >> 1) * 16 + swz / 64; C = (st & 1) * 32 + (swz % 64) / 2; }
__host__ __device__ __forceinline__ int perm32(int rho) { const int n = rho >> 4, i = rho & 15; return 8 * (i >> 2) + 4 * n + (i & 3); }

struct Unit { int pm, pn; };
struct Gemm { const bf16_t* A; const bf16_t* Bt; int M, N, K; };

struct StaticOrder {
    int nM, nN, nwg, G, c;
    __host__ __device__ void init(int M, int N, int G_, int c_) { nM = M / BM; nN = N / BM; nwg = nM * nN; G = G_; c = c_; }
    __host__ __device__ bool next(int i, Unit& u) const {
        const long L = (long)i * G + c; if (L >= nwg) return false;
        int wgid = (int)L; { const int q = nwg / NXCD, r = nwg % NXCD, xcd = wgid % NXCD, off = wgid / NXCD; wgid = (xcd < r ? xcd * (q + 1) : r * (q + 1) + (xcd - r) * q) + off; }
        const int nig = WGM * nN, gid = wgid / nig, fm = gid * WGM, gsz = (nM - fm) < WGM ? (nM - fm) : WGM;
        u.pm = fm + ((wgid % nig) % gsz); u.pn = (wgid % nig) / gsz; return true;
    }
    __device__ __forceinline__ void a_ready(const Unit&) const {}
    __device__ __forceinline__ void done(const Unit&) const {}
};
#ifdef CPU_TEST
__device__ __forceinline__ unsigned cvt_pk_bf16(float lo, float hi) { return (unsigned)emu_f2bf(lo) | ((unsigned)emu_f2bf(hi) << 16); }
#else
typedef float pk_f32x2 __attribute__((ext_vector_type(2))); typedef __bf16 pk_bf16x2 __attribute__((ext_vector_type(2)));
__device__ __forceinline__ unsigned cvt_pk_bf16(float lo, float hi) { pk_f32x2 v = {lo, hi}; pk_bf16x2 b = __builtin_convertvector(v, pk_bf16x2); return __builtin_bit_cast(unsigned, b); }
#endif
template <class Epi, class Sched, bool STAMP = false>
__device__ __forceinline__ void gemm_phase(PG8_LAS unsigned char* lds, const Gemm g, const Sched& S, const Epi& E, unsigned long long* stamps) {
    const int tid = opaque_tid(), wid = __builtin_amdgcn_readfirstlane(tid >> 6), lane = tid & 63, wr = wid >> 2, wc = wid & 3, fr = lane & 15, fq = lane >> 4;
    const int K = g.K, nt = K / BK;
#define PG8_STAMP() do {} while (0)
    PG8_STAMP();
    unsigned voffA[2], voffB[2];
#pragma unroll
    for (int i = 0; i < 2; ++i) { int R, C; stage_rc(tid * 16 + i * 8192, R, C); const int Rb = Epi::PERM ? ((R & ~31) + perm32(R & 31)) : R;
        voffA[i] = (unsigned)(R * K + C) * 2u; voffB[i] = (unsigned)(Rb * K + C) * 2u; }
    const size_t kstep = (size_t)(BK * 2);
    const size_t hstep = (size_t)HALF * K * 2;
    const size_t tstep = 2 * hstep;
    const unsigned ldsw = (unsigned)wid * 1024u;
    const int aoff = lds_byte(wr * 64 + fr, fq * 8), boff = lds_byte(wc * 32 + fr, fq * 8);
#define PG8_SA(b, h) (((b) * 2 + (h)) * HTB)
#define PG8_SB(b, h) ((4 + (b) * 2 + (h)) * HTB)
#define PG8_STAGE(bufoff, gbase, voff) do { _Pragma("unroll") for (int _i = 0; _i < 2; ++_i) \
        __builtin_amdgcn_global_load_lds((const unsigned*)((const char*)(gbase) + (voff)[_i]), (PG8_LAS unsigned*)(lds + (bufoff) + ldsw + _i * 8192), 16, 0, 0); } while (0)
#define PG8_LDA(dst, b, h) do { _Pragma("unroll") for (int m = 0; m < 4; ++m) _Pragma("unroll") for (int k = 0; k < 2; ++k) dst[m][k] = *(const PG8_LAS bf16x8*)(lds + PG8_SA(b, h) + aoff + m * 2048 + k * 1024); } while (0)
#define PG8_LDB(dst, b, h) do { _Pragma("unroll") for (int n = 0; n < 2; ++n) _Pragma("unroll") for (int k = 0; k < 2; ++k) dst[n][k] = *(const PG8_LAS bf16x8*)(lds + PG8_SB(b, h) + boff + n * 2048 + k * 1024); } while (0)
#define PG8_MMA(ai, bj, At, Bt) do { __builtin_amdgcn_s_setprio(1); _Pragma("unroll") for (int m = 0; m < 4; ++m) _Pragma("unroll") for (int n = 0; n < 2; ++n) _Pragma("unroll") for (int k = 0; k < 2; ++k) \
        acc[ai][bj][m][n] = __builtin_amdgcn_mfma_f32_16x16x32_bf16(Bt[n][k], At[m][k], acc[ai][bj][m][n], 0, 0, 0); __builtin_amdgcn_s_setprio(0); } while (0)
#ifdef CPU_TEST
#define PG8_WAIT_V(n) ((void)0)
#define PG8_WAIT_L(n) ((void)0)
#else
#define PG8_WAIT_V(n) asm volatile("s_waitcnt vmcnt(" #n ")" ::: "memory")
#define PG8_WAIT_L(n) asm volatile("s_waitcnt lgkmcnt(" #n ")" ::: "memory")
#endif
#define PG8_BAR __builtin_amdgcn_s_barrier()
#define PG8_SCHED __builtin_amdgcn_sched_barrier(0)
    Unit cur, nxt; int ui = 0;
    if (!S.next(0, cur)) return;
    f32x4 acc[2][2][4][2];
#pragma unroll
    for (int a = 0; a < 2; ++a)
#pragma unroll
        for (int b = 0; b < 2; ++b)
#pragma unroll
            for (int m = 0; m < 4; ++m)
#pragma unroll
                for (int n = 0; n < 2; ++n) acc[a][b][m][n] = (f32x4){0.f, 0.f, 0.f, 0.f};
    bf16x8 At[4][2], B0[2][2], B1[2][2];
    const char* cA = (const char*)g.A + (size_t)cur.pm * tstep; const char* cB = (const char*)g.Bt + (size_t)cur.pn * tstep;
    S.a_ready(cur);
    PG8_STAGE(PG8_SB(0, 0), cB, voffB); PG8_STAGE(PG8_SA(0, 0), cA, voffA); PG8_STAGE(PG8_SB(0, 1), cB + hstep, voffB); PG8_STAGE(PG8_SA(0, 1), cA + hstep, voffA);
    if (wr == 1) PG8_BAR;
    PG8_WAIT_V(4); PG8_BAR;
    PG8_STAGE(PG8_SB(1, 0), cB + kstep, voffB); PG8_STAGE(PG8_SA(1, 0), cA + kstep, voffA); PG8_STAGE(PG8_SB(1, 1), cB + hstep + kstep, voffB);
    PG8_WAIT_V(6); PG8_BAR;
    PG8_STAMP();
    for (;;) {
        const bool has_next = S.next(ui + 1, nxt);
        const char* nA = has_next ? (const char*)g.A + (size_t)nxt.pm * tstep : cA; const char* nB = has_next ? (const char*)g.Bt + (size_t)nxt.pn * tstep : cB;
        for (int t = 0; t < nt; t += 2) {
            const bool last = (t == nt - 2);
            const char* a1 = cA + (size_t)(t + 1) * kstep;
            const char* a2 = last ? nA : cA + (size_t)(t + 2) * kstep; const char* b2 = last ? nB : cB + (size_t)(t + 2) * kstep;
            const char* a3 = a2 + kstep; const char* b3 = b2 + kstep;
            if (last && has_next) S.a_ready(nxt);
            PG8_LDB(B0, 0, 0); PG8_SCHED; PG8_LDA(At, 0, 0); PG8_STAGE(PG8_SA(1, 1), a1 + hstep, voffA);
            PG8_WAIT_L(8); PG8_BAR; PG8_WAIT_L(0); PG8_MMA(0, 0, At, B0); PG8_BAR; PG8_SCHED;
            PG8_LDB(B1, 0, 1); PG8_STAGE(PG8_SB(0, 0), b2, voffB);
            PG8_BAR; PG8_WAIT_L(0); PG8_MMA(0, 1, At, B1); PG8_BAR;
            PG8_LDA(At, 0, 1); PG8_STAGE(PG8_SA(0, 0), a2, voffA);
            PG8_BAR; PG8_WAIT_L(0); PG8_MMA(1, 0, At, B0); PG8_BAR; PG8_SCHED;
            PG8_STAGE(PG8_SB(0, 1), b2 + hstep, voffB);
            PG8_WAIT_V(6); PG8_BAR; PG8_MMA(1, 1, At, B1); PG8_BAR;
            PG8_LDB(B0, 1, 0); PG8_SCHED; PG8_LDA(At, 1, 0); PG8_STAGE(PG8_SA(0, 1), a2 + hstep, voffA);
            PG8_WAIT_L(8); PG8_BAR; PG8_WAIT_L(0); PG8_MMA(0, 0, At, B0); PG8_BAR; PG8_SCHED;
            PG8_LDB(B1, 1, 1); PG8_STAGE(PG8_SB(1, 0), b3, voffB);
            PG8_BAR; PG8_WAIT_L(0); PG8_MMA(0, 1, At, B1); PG8_BAR;
            PG8_LDA(At, 1, 1); PG8_STAGE(PG8_SA(1, 0), a3, voffA);
            PG8_BAR; PG8_WAIT_L(0); PG8_MMA(1, 0, At, B0); PG8_BAR; PG8_SCHED;
            PG8_STAGE(PG8_SB(1, 1), b3 + hstep, voffB);
            PG8_WAIT_V(6); PG8_BAR; PG8_MMA(1, 1, At, B1); PG8_BAR;
        }
        PG8_STAMP();
        if constexpr (!Epi::AFTER_DRAIN) { E(acc, cur, wr, wc, fr, fq); S.done(cur); }
        PG8_STAMP();
        if (!has_next) break;
#pragma unroll
        for (int a = 0; a < 2; ++a)
#pragma unroll
            for (int b = 0; b < 2; ++b)
#pragma unroll
                for (int m = 0; m < 4; ++m)
#pragma unroll
                    for (int n = 0; n < 2; ++n) acc[a][b][m][n] = (f32x4){0.f, 0.f, 0.f, 0.f};
        cur = nxt; cA = nA; cB = nB; ++ui;
    }
    PG8_WAIT_V(0);
    if (wr == 0) PG8_BAR;
    PG8_BAR;
    if constexpr (Epi::AFTER_DRAIN) { E.fused(acc, cur, wr, wc, fr, fq, lds, wid, lane); S.done(cur); }
    PG8_STAMP();
#undef PG8_STAMP
#undef PG8_SA
#undef PG8_SB
#undef PG8_STAGE
#undef PG8_LDA
#undef PG8_LDB
#undef PG8_MMA
#undef PG8_WAIT_V
#undef PG8_WAIT_L
#undef PG8_BAR
#undef PG8_SCHED
}
template <class Epi, class Sched, bool ALIGN_EPI = false, bool SP2 = false>
__device__ __forceinline__ void gemm_phase2(PG8_LAS unsigned char* lds, const Gemm g, const Sched& S, const Epi& E) {
    const int tid = opaque_tid(), wid = __builtin_amdgcn_readfirstlane(tid >> 6), lane = tid & 63, wr = wid >> 2, wc = wid & 3, fr = lane & 15, fq = lane >> 4;
    const int K = g.K, nt = K / BK;
    unsigned voffA[2], voffB[2];
#pragma unroll
    for (int i = 0; i < 2; ++i) { int R, C; stage_rc(tid * 16 + i * 8192, R, C); const int Rb = Epi::PERM ? ((R & ~31) + perm32(R & 31)) : R;
        voffA[i] = (unsigned)(R * K + C) * 2u; voffB[i] = (unsigned)(Rb * K + C) * 2u; }
    const size_t kstep = (size_t)(BK * 2);
    const size_t hstep = (size_t)HALF * K * 2;
    const size_t tstep = 2 * hstep;
    const unsigned ldsw = (unsigned)wid * 1024u;
    const int aoff = lds_byte(wr * 64 + fr, fq * 8), boff = lds_byte(wc * 32 + fr, fq * 8);
#define PG8_SA(b, h) (((b) * 2 + (h)) * HTB)
#define PG8_SB(b, h) ((4 + (b) * 2 + (h)) * HTB)
#define PG8_STAGE(bufoff, gbase, voff) do { _Pragma("unroll") for (int _i = 0; _i < 2; ++_i) \
        __builtin_amdgcn_global_load_lds((const unsigned*)((const char*)(gbase) + (voff)[_i]), (PG8_LAS unsigned*)(lds + (bufoff) + ldsw + _i * 8192), 16, 0, 0); } while (0)
#define PG8_LDA(dst, b, h) do { _Pragma("unroll") for (int m = 0; m < 4; ++m) _Pragma("unroll") for (int k = 0; k < 2; ++k) dst[m][k] = *(const PG8_LAS bf16x8*)(lds + PG8_SA(b, h) + aoff + m * 2048 + k * 1024); } while (0)
#define PG8_LDB(dst, b, h) do { _Pragma("unroll") for (int n = 0; n < 2; ++n) _Pragma("unroll") for (int k = 0; k < 2; ++k) dst[n][k] = *(const PG8_LAS bf16x8*)(lds + PG8_SB(b, h) + boff + n * 2048 + k * 1024); } while (0)
#define PG8_MMA(ai, bj, At, Bt) do { __builtin_amdgcn_s_setprio(1); _Pragma("unroll") for (int m = 0; m < 4; ++m) _Pragma("unroll") for (int n = 0; n < 2; ++n) _Pragma("unroll") for (int k = 0; k < 2; ++k) \
        acc[ai][bj][m][n] = __builtin_amdgcn_mfma_f32_16x16x32_bf16(Bt[n][k], At[m][k], acc[ai][bj][m][n], 0, 0, 0); __builtin_amdgcn_s_setprio(0); } while (0)
#ifdef CPU_TEST
#define PG8_WAIT_V(n) ((void)0)
#define PG8_WAIT_L(n) ((void)0)
#else
#define PG8_WAIT_V(n) asm volatile("s_waitcnt vmcnt(" #n ")" ::: "memory")
#define PG8_WAIT_L(n) asm volatile("s_waitcnt lgkmcnt(" #n ")" ::: "memory")
#endif
#define PG8_BAR __builtin_amdgcn_s_barrier()
#define PG8_SCHED __builtin_amdgcn_sched_barrier(0)
    Unit cur, nxt; int ui = 0;
    if (!S.next(0, cur)) return;
    f32x4 acc[2][2][4][2];
#pragma unroll
    for (int a = 0; a < 2; ++a)
#pragma unroll
        for (int b = 0; b < 2; ++b)
#pragma unroll
            for (int m = 0; m < 4; ++m)
#pragma unroll
                for (int n = 0; n < 2; ++n) acc[a][b][m][n] = (f32x4){0.f, 0.f, 0.f, 0.f};
    bf16x8 At[4][2], B0[2][2], B1[2][2];
    const char* cA = (const char*)g.A + (size_t)cur.pm * tstep; const char* cB = (const char*)g.Bt + (size_t)cur.pn * tstep;
    S.a_ready(cur);
    if constexpr (SP2) {
        PG8_STAGE(PG8_SB(0, 0), cB, voffB); PG8_STAGE(PG8_SB(0, 1), cB + hstep, voffB); PG8_STAGE(PG8_SA(0, 0), cA, voffA); PG8_STAGE(PG8_SA(0, 1), cA + hstep, voffA);
        if (wr == 1) PG8_BAR;
        PG8_WAIT_V(2); PG8_BAR;
        PG8_STAGE(PG8_SB(1, 0), cB + kstep, voffB); PG8_STAGE(PG8_SA(1, 0), cA + kstep, voffA); PG8_STAGE(PG8_SB(1, 1), cB + hstep + kstep, voffB);
        PG8_WAIT_V(6); PG8_BAR;
    } else {
        PG8_STAGE(PG8_SB(0, 0), cB, voffB); PG8_STAGE(PG8_SA(0, 0), cA, voffA); PG8_STAGE(PG8_SB(0, 1), cB + hstep, voffB); PG8_STAGE(PG8_SA(0, 1), cA + hstep, voffA);
        if (wr == 1) PG8_BAR;
        PG8_WAIT_V(4); PG8_BAR;
        PG8_STAGE(PG8_SB(1, 0), cB + kstep, voffB); PG8_STAGE(PG8_SA(1, 0), cA + kstep, voffA); PG8_STAGE(PG8_SB(1, 1), cB + hstep + kstep, voffB);
        PG8_WAIT_V(6); PG8_BAR;
    }
    for (;;) {
        const bool has_next = S.next(ui + 1, nxt);
        const char* nA = has_next ? (const char*)g.A + (size_t)nxt.pm * tstep : cA; const char* nB = has_next ? (const char*)g.Bt + (size_t)nxt.pn * tstep : cB;
        for (int t = 0; t < nt; t += 2) {
            const bool last = (t == nt - 2);
            const char* a1 = cA + (size_t)(t + 1) * kstep;
            const char* a2 = last ? nA : cA + (size_t)(t + 2) * kstep; const char* b2 = last ? nB : cB + (size_t)(t + 2) * kstep;
            const char* a3 = a2 + kstep; const char* b3 = b2 + kstep;
            if (last && has_next) S.a_ready(nxt);
            if constexpr (SP2) {
            PG8_LDB(B0, 0, 0); PG8_LDB(B1, 0, 1); PG8_SCHED; PG8_LDA(At, 0, 0); PG8_STAGE(PG8_SA(1, 1), a1 + hstep, voffA);
            PG8_WAIT_V(8); PG8_WAIT_L(0); PG8_BAR; PG8_MMA(0, 0, At, B0); PG8_MMA(0, 1, At, B1); PG8_BAR; PG8_SCHED;
            PG8_LDA(At, 0, 1); PG8_STAGE(PG8_SB(0, 0), b2, voffB); PG8_STAGE(PG8_SB(0, 1), b2 + hstep, voffB); PG8_STAGE(PG8_SA(0, 0), a2, voffA);
            PG8_WAIT_V(8); PG8_WAIT_L(0); PG8_BAR; PG8_MMA(1, 0, At, B0); PG8_MMA(1, 1, At, B1); PG8_BAR; PG8_SCHED;
            PG8_LDB(B0, 1, 0); PG8_LDB(B1, 1, 1); PG8_SCHED; PG8_LDA(At, 1, 0); PG8_STAGE(PG8_SA(0, 1), a2 + hstep, voffA);
            PG8_WAIT_V(8); PG8_WAIT_L(0); PG8_BAR; PG8_MMA(0, 0, At, B0); PG8_MMA(0, 1, At, B1); PG8_BAR; PG8_SCHED;
            PG8_LDA(At, 1, 1); PG8_STAGE(PG8_SB(1, 0), b3, voffB); PG8_STAGE(PG8_SB(1, 1), b3 + hstep, voffB); PG8_STAGE(PG8_SA(1, 0), a3, voffA);
            PG8_WAIT_V(8); PG8_WAIT_L(0); PG8_BAR; PG8_MMA(1, 0, At, B0); PG8_MMA(1, 1, At, B1); PG8_BAR; PG8_SCHED;
            } else {
            PG8_LDB(B0, 0, 0); PG8_SCHED; PG8_LDA(At, 0, 0); PG8_STAGE(PG8_SA(1, 1), a1 + hstep, voffA);
            PG8_WAIT_L(8); PG8_BAR; PG8_WAIT_L(0); PG8_MMA(0, 0, At, B0); PG8_BAR; PG8_SCHED;
            PG8_LDB(B1, 0, 1); PG8_STAGE(PG8_SB(0, 0), b2, voffB);
            PG8_BAR; PG8_WAIT_L(0); PG8_MMA(0, 1, At, B1); PG8_BAR;
            PG8_LDA(At, 0, 1); PG8_STAGE(PG8_SA(0, 0), a2, voffA);
            PG8_BAR; PG8_WAIT_L(0); PG8_MMA(1, 0, At, B0); PG8_BAR; PG8_SCHED;
            PG8_STAGE(PG8_SB(0, 1), b2 + hstep, voffB);
            PG8_WAIT_V(6); PG8_BAR; PG8_MMA(1, 1, At, B1); PG8_BAR;
            PG8_LDB(B0, 1, 0); PG8_SCHED; PG8_LDA(At, 1, 0); PG8_STAGE(PG8_SA(0, 1), a2 + hstep, voffA);
            PG8_WAIT_L(8); PG8_BAR; PG8_WAIT_L(0); PG8_MMA(0, 0, At, B0); PG8_BAR; PG8_SCHED;
            PG8_LDB(B1, 1, 1); PG8_STAGE(PG8_SB(1, 0), b3, voffB);
            PG8_BAR; PG8_WAIT_L(0); PG8_MMA(0, 1, At, B1); PG8_BAR;
            PG8_LDA(At, 1, 1); PG8_STAGE(PG8_SA(1, 0), a3, voffA);
            PG8_BAR; PG8_WAIT_L(0); PG8_MMA(1, 0, At, B0); PG8_BAR; PG8_SCHED;
            PG8_STAGE(PG8_SB(1, 1), b3 + hstep, voffB);
            PG8_WAIT_V(6); PG8_BAR; PG8_MMA(1, 1, At, B1); PG8_BAR;
            }
        }
        if constexpr (ALIGN_EPI) { if (wr == 0) PG8_BAR; }
        if constexpr (!Epi::AFTER_DRAIN) { E(acc, cur, wr, wc, fr, fq); S.done(cur); }
        if (!has_next) break;
#pragma unroll
        for (int a = 0; a < 2; ++a)
#pragma unroll
            for (int b = 0; b < 2; ++b)
#pragma unroll
                for (int m = 0; m < 4; ++m)
#pragma unroll
                    for (int n = 0; n < 2; ++n) acc[a][b][m][n] = (f32x4){0.f, 0.f, 0.f, 0.f};
        cur = nxt; cA = nA; cB = nB; ++ui;
        if constexpr (ALIGN_EPI) { if (wr == 1) PG8_BAR; }
    }
    PG8_WAIT_V(0);
    if constexpr (!ALIGN_EPI) { if (wr == 0) PG8_BAR; }
    PG8_BAR;
    if constexpr (Epi::AFTER_DRAIN) { E.fused(acc, cur, wr, wc, fr, fq, lds, wid, lane); S.done(cur); }
#undef PG8_SA
#undef PG8_SB
#undef PG8_STAGE
#undef PG8_LDA
#undef PG8_LDB
#undef PG8_MMA
#undef PG8_WAIT_V
#undef PG8_WAIT_L
#undef PG8_BAR
#undef PG8_SCHED
}

}


namespace {
using pg8::bf16_t; using pg8::bf16x8; using pg8::f32x4;
#define LDSP PG8_LAS unsigned char*
constexpr int BATCH = CFG_BATCH, SEQ = CFG_SEQ, DEC_BATCH = CFG_DEC_BATCH, PAST_LEN = CFG_PAST_LEN;
constexpr int D = 1024, DEPTH = 2, DEC_SEQ = 4, PAGE = 128;
constexpr int MH = 4, MW = 512, MHD = 128;
constexpr int HD = 64, NH = 8, NKV = 2;
constexpr int CHID = 128, SELB = 64, SELTOP = 16, WIN = 512;
constexpr int DFF = 2816, INW = 4896, INP = 4864;
constexpr float EPS = 1e-6f, NEG = -1e30f, TINY = 1e-30f;
constexpr int NPT = BATCH * SEQ, NST = DEC_BATCH * DEC_SEQ, NTOK = NPT + NST, NSEQ = BATCH + DEC_BATCH;
constexpr int MPAD = (NTOK + 255) / 256 * 256;
constexpr int N_PAGES = PAST_LEN / PAGE, N_USED = DEC_BATCH * N_PAGES, N_POOL = N_USED + N_USED / 4;
constexpr int WB = (WIN < PAST_LEN ? WIN : PAST_LEN), WP = (WIN < SEQ ? WIN : SEQ);
constexpr int NCP = SEQ / 16 - 1, NCS = (PAST_LEN + DEC_SEQ) / 16 - 1, NCMAX = (NCP > NCS ? NCP : NCS);
constexpr int NBP = (SEQ + 63) / 64, NBS = (PAST_LEN + DEC_SEQ + 63) / 64;
constexpr int ZU = 0, ZV = 512, ZO = 1024, ZIG = 1536, ZFG = 1540, ZQ = 1544, ZKV = 2056, ZNG = 2824, ZGA = 2848, ZGB = 3872;
constexpr size_t O_YP = 0;
constexpr size_t O_YS = O_YP + (size_t)NPT * D;
constexpr size_t O_PKV = O_YS + (size_t)NST * D;
constexpr size_t O_PWIN = O_PKV + (size_t)DEPTH * BATCH * SEQ * 512;
constexpr size_t O_PC = O_PWIN + (size_t)DEPTH * BATCH * WP * 256;
constexpr size_t O_PN = O_PC + (size_t)DEPTH * BATCH * MH * MHD * MHD;
constexpr size_t O_PM = O_PN + (size_t)DEPTH * BATCH * MH * MHD;
constexpr size_t O_PCONV = O_PM + (size_t)DEPTH * BATCH * MH;
constexpr size_t O_SKV = O_PCONV + (size_t)DEPTH * BATCH * 3 * MW;
constexpr size_t O_SWIN = O_SKV + (size_t)DEPTH * DEC_BATCH * DEC_SEQ * 512;
constexpr size_t O_SC = O_SWIN + (size_t)DEPTH * DEC_BATCH * WB * 256;
constexpr size_t O_SN = O_SC + (size_t)DEPTH * DEC_BATCH * MH * MHD * MHD;
constexpr size_t O_SM = O_SN + (size_t)DEPTH * DEC_BATCH * MH * MHD;
constexpr size_t O_SCONV = O_SM + (size_t)DEPTH * DEC_BATCH * MH;
constexpr size_t O_END = O_SCONV + (size_t)DEPTH * DEC_BATCH * 3 * MW;
constexpr int NT = 512;

struct P {
    const float *x_prompt, *x_sample, *cache_kv;
    const int* page_table;
    const float *cache_win, *st_C, *st_n, *st_m, *st_conv, *norm1_g, *w_in, *b_gates, *conv_w, *conv_b, *w_mq, *w_mk, *mnorm_g,
        *pe_k, *pe_v, *w1_k, *w2_k, *w1_v, *w2_v, *w_a, *w_b, *w_out, *norm2_g, *w_up, *w_down, *final_g;
    float* out;
    float *ROPE, *CBIAS, *DC, *DN, *GSUM, *NS, *MS, *X, *Z, *KW, *QR, *CC, *IG, *LF, *QM, *KM, *NUMP, *MT, *HID, *KC, *VC, *PC, *OC, *OS, *OW, *SCORE, *PS, *PW, *MGF;
    bf16_t *XB, *HAB, *HBB, *MGB, *ACTB, *QCB, *QRB, *KSB, *VSB, *KWB, *VWB, *QMB, *KMB, *CSB, *WMQ_T, *WMK_T, *W1T, *W2T, *WSM_T, *SGB, *KCB, *VCB, *WIN_T, *WA_T, *WB_T, *WOUT_T, *WUP_T, *WDOWN_T;
    int* SEL; int* DIAGF; int* QCTR;
    unsigned long long* RSS;
    unsigned* bar;
};

__device__ __forceinline__ float bf2f(bf16_t b) { unsigned u = ((unsigned)b) << 16; float f; __builtin_memcpy(&f, &u, 4); return f; }
__device__ __forceinline__ bf16_t f2bf(float f) { unsigned u; __builtin_memcpy(&u, &f, 4); u += 0x7fffu + ((u >> 16) & 1u); return (bf16_t)(u >> 16); }

struct Tok { int seq, t, pos, b; bool sample; };
__device__ __forceinline__ Tok tokinfo(int tok) {
    Tok r;
    if (tok < NPT) { r.b = tok / SEQ; r.t = tok % SEQ; r.seq = r.b; r.pos = r.t; r.sample = false; }
    else { int q = tok - NPT; r.b = q / DEC_SEQ; r.t = q % DEC_SEQ; r.seq = BATCH + r.b; r.pos = PAST_LEN + r.t; r.sample = true; }
    return r;
}
__device__ __forceinline__ int seq_row0(int seq) { return seq < BATCH ? seq * SEQ : NPT + (seq - BATCH) * DEC_SEQ; }
__device__ __forceinline__ int seq_len(int seq) { return seq < BATCH ? SEQ : DEC_SEQ; }
__device__ __forceinline__ int seq_nc(int seq) { return seq < BATCH ? NCP : NCS; }
__device__ __forceinline__ size_t kc_base(int seq) { return seq < BATCH ? (size_t)seq * NCP : (size_t)BATCH * NCP + (size_t)(seq - BATCH) * NCS; }
constexpr size_t KC_ROWS = (size_t)BATCH * NCP + (size_t)DEC_BATCH * NCS;

__device__ __forceinline__ const float* kvrow(const P& p, int l, int seq, int pos, int j, int g) {
    if (seq < BATCH) return p.out + O_PKV + ((((size_t)l * BATCH + seq) * SEQ + pos) * 4 + j) * 128 + g * 64;
    int b = seq - BATCH;
    if (pos < PAST_LEN) {
        int pg = p.page_table[b * N_PAGES + pos / PAGE];
        return p.cache_kv + ((((size_t)l * N_POOL + pg) * PAGE + pos % PAGE) * 4 + j) * 128 + g * 64;
    }
    return p.out + O_SKV + ((((size_t)l * DEC_BATCH + b) * DEC_SEQ + (pos - PAST_LEN)) * 4 + j) * 128 + g * 64;
}
__device__ __forceinline__ const float* winrow(const P& p, int l, int seq, int pos, int kv, int g) {
    if (seq < BATCH) return p.KW + ((size_t)(seq * SEQ + pos) * 2 + kv) * 128 + g * 64;
    int b = seq - BATCH;
    if (pos < PAST_LEN) return p.cache_win + ((((size_t)l * DEC_BATCH + b) * WB + (pos - (PAST_LEN - WB))) * 2 + kv) * 128 + g * 64;
    return p.KW + ((size_t)(NPT + b * DEC_SEQ + (pos - PAST_LEN)) * 2 + kv) * 128 + g * 64;
}

__device__ __forceinline__ float sigmoidf_(float x) { return 1.f / (1.f + expf(-x)); }
__device__ __forceinline__ float siluf_(float x) { return x / (1.f + expf(-x)); }
__device__ __forceinline__ float log_sigmoidf_(float x) { return fminf(x, 0.f) - log1pf(expf(-fabsf(x))); }
__device__ __forceinline__ float geluf_(float x) { return 0.5f * x * (1.f + tanhf(0.7978845608028654f * (x + 0.044715f * x * x * x))); }
__device__ __forceinline__ float rope_inv(int i) { return powf(500000.0f, -(float)i / 8.0f); }
__device__ __forceinline__ float rope_elem(const float* x, int d, int pos) {
    if (d >= 16) return x[d];
    int i = d & 7;
    float ang = (float)pos * rope_inv(i);
    float c = cosf(ang), s = sinf(ang);
    return d < 8 ? x[d] * c - x[d + 8] * s : x[d] * c + x[d - 8] * s;
}

#define PLOOP(i, n) for (long i = gtid; i < (long)(n); i += gsz)


__device__ __forceinline__ void gemm_items(const float* A, int lda, const float* B, int ldb, float* C, int ldc, int M, int N, int K,
                                           int accumulate, long gtid, long gsz) {
    const int ng = N / 4;
    const long items = (long)(M / 4) * ng;
    for (long it = gtid; it < items; it += gsz) {
        const int mg = (int)(it / ng), n4 = (int)(it % ng) * 4;
        float acc[4][4];
#pragma unroll
        for (int i = 0; i < 4; ++i)
#pragma unroll
            for (int j = 0; j < 4; ++j) acc[i][j] = 0.f;
        const float* a0 = A + (size_t)(mg * 4) * lda;
        const float* b0 = B + n4;
        for (int k = 0; k < K; ++k) {
            const float4 b = *(const float4*)(b0 + (size_t)k * ldb);
#pragma unroll
            for (int i = 0; i < 4; ++i) {
                const float a = a0[(size_t)i * lda + k];
                acc[i][0] += a * b.x; acc[i][1] += a * b.y; acc[i][2] += a * b.z; acc[i][3] += a * b.w;
            }
        }
#pragma unroll
        for (int i = 0; i < 4; ++i) {
            float* c = C + (size_t)(mg * 4 + i) * ldc + n4;
#pragma unroll
            for (int j = 0; j < 4; ++j) c[j] = accumulate ? c[j] + acc[i][j] : acc[i][j];
        }
    }
}


constexpr float QSCALE = 0.125f * 1.4426950408889634f;
#ifdef BISECT_A
constexpr int ML_SEQ0 = 0, ML_TOK0 = 0;
#else
constexpr int ML_SEQ0 = BATCH, ML_TOK0 = NPT;
#endif
constexpr int NSA_TOK0 = NPT;
#define PLOOP_FROM(i, s, n) for (long i = (long)(s) + gtid; i < (long)(n); i += gsz)

constexpr int ROPE_POS = (SEQ > PAST_LEN + DEC_SEQ ? SEQ : PAST_LEN + DEC_SEQ);
constexpr float RSS_SCALE = 16777216.f;
__device__ __forceinline__ float rstd_of(unsigned long long q) { return 1.f / sqrtf((float)q * (1.f / (RSS_SCALE * D)) + EPS); }
__host__ __device__ __forceinline__ int unperm16(int pos) { return pos < 16 ? (pos & 3) + ((pos >> 2) & 1) * 8 + ((pos >> 3) & 1) * 4 : pos; }
__host__ __device__ __forceinline__ int in_col_map(int n) {
    const int tile = n >> 8, cl = n & 255;
    if (tile < 6) return n;
    if (tile < 8) return ZQ + ((tile - 6) * 4 + (cl >> 6)) * 64 + unperm16(cl & 63);
    if (tile == 8) return ZKV + cl;
    if (tile < 11) { const int base = ZKV + (tile - 8) * 256; return cl < 128 ? base + (cl >> 6) * 64 + unperm16(cl & 63) : base + cl; }
    if (tile < 15) return ZGA + (tile - 11) * 256 + cl;
    return ZGB + (tile - 15) * 256 + cl;
}
__host__ __device__ __forceinline__ int up_col_map(int n) { const int c = (n >> 3) * 4 + (n & 3); return ((n >> 2) & 1) * DFF + c; }

#ifdef CPU_TEST
__device__ __forceinline__ float fast_sigmoid(float x) { return 1.f / (1.f + expf(-x)); }
#else
__device__ __forceinline__ float fast_sigmoid(float x) { return __builtin_amdgcn_rcpf(1.f + __builtin_amdgcn_exp2f(-1.4426950408889634f * x)); }
#endif
struct EpiIn {
    static constexpr bool PERM = true, AFTER_DRAIN = false;
    float* Z; const unsigned long long* rss; const float* rope; float* out; bf16_t *QCB, *QRB, *KSB, *VSB, *KWB, *VWB, *SGB; int l;
    __device__ __forceinline__ void operator()(const f32x4 (&acc)[2][2][4][2], const pg8::Unit& u, int wr, int wc, int fr, int fq) const {
#pragma unroll
        for (int ai = 0; ai < 2; ++ai)
#pragma unroll
            for (int m = 0; m < 4; ++m) {
                const int row = u.pm * 256 + ai * 128 + wr * 64 + m * 16 + fr;
                const float rs = rstd_of(rss[row]);
                if (u.pn >= 11) {
#pragma unroll
                    for (int bj = 0; bj < 2; ++bj) {
                        const int c = (u.pn - 11) * 256 + bj * 128 + wc * 32 + fq * 8;
                        const f32x4 v0 = acc[ai][bj][m][0] * rs, v1 = acc[ai][bj][m][1] * rs;
                        pg8::u32x4 o; o[0] = pg8::cvt_pk_bf16(fast_sigmoid(v0[0]), fast_sigmoid(v0[1])); o[1] = pg8::cvt_pk_bf16(fast_sigmoid(v0[2]), fast_sigmoid(v0[3]));
                        o[2] = pg8::cvt_pk_bf16(fast_sigmoid(v1[0]), fast_sigmoid(v1[1])); o[3] = pg8::cvt_pk_bf16(fast_sigmoid(v1[2]), fast_sigmoid(v1[3]));
                        *(pg8::u32x4*)(SGB + (size_t)row * 2048 + c) = o;
                    }
                    continue;
                }
                if (u.pn < 6) {
                    float* zr = Z + (size_t)row * INW;
#pragma unroll
                    for (int bj = 0; bj < 2; ++bj) {
                        const int n0 = u.pn * 256 + bj * 128 + wc * 32 + fq * 8;
                        const int o0 = in_col_map(n0);
                        *(f32x4*)(zr + o0) = acc[ai][bj][m][0] * rs;
                        *(f32x4*)(zr + o0 + 4) = acc[ai][bj][m][1] * rs;
                    }
                    continue;
                }
                if (row >= NTOK) continue;
                const bool sample = row >= NPT;
                const int bb = sample ? (row - NPT) / DEC_SEQ : row / SEQ, tt = sample ? (row - NPT) % DEC_SEQ : row % SEQ, pos = sample ? PAST_LEN + tt : tt;
#pragma unroll
                for (int bj = 0; bj < 2; ++bj) {
                    const int cl = bj * 128 + wc * 32 + fq * 8, hp = cl & 63;
                    f32x4 v0 = acc[ai][bj][m][0] * rs, v1 = acc[ai][bj][m][1] * rs;
                    const bool roped = (u.pn <= 7) || (u.pn >= 9 && cl < 128);
                    f32x4 r0 = v0, r1 = v1;
                    const bool split = roped && hp < 16;
                    const int dl = hp >> 1;
                    if (split) {
                        const f32x4 cs0 = *(const f32x4*)(rope + (size_t)pos * 16 + 2 * dl), cs1 = *(const f32x4*)(rope + (size_t)pos * 16 + 2 * dl + 4);
                        const float c[4] = {cs0[0], cs0[2], cs1[0], cs1[2]}, s[4] = {cs0[1], cs0[3], cs1[1], cs1[3]};
#pragma unroll
                        for (int i = 0; i < 4; ++i) { r0[i] = v0[i] * c[i] - v1[i] * s[i]; r1[i] = v1[i] * c[i] + v0[i] * s[i]; }
                    }
                    const int dA = split ? dl : hp, dB = split ? dl + 8 : hp + 4;
                    if (u.pn <= 7) {
                        const int head = (u.pn - 6) * 4 + (cl >> 6);
                        bf16_t* qc = QCB + (size_t)row * 512 + head * 64; bf16_t* qr = QRB + (size_t)row * 512 + head * 64;
                        uint2 a, b2, c2, d2;
                        a.x = pg8::cvt_pk_bf16(v0[0] * QSCALE, v0[1] * QSCALE); a.y = pg8::cvt_pk_bf16(v0[2] * QSCALE, v0[3] * QSCALE);
                        b2.x = pg8::cvt_pk_bf16(v1[0] * QSCALE, v1[1] * QSCALE); b2.y = pg8::cvt_pk_bf16(v1[2] * QSCALE, v1[3] * QSCALE);
                        c2.x = pg8::cvt_pk_bf16(r0[0] * QSCALE, r0[1] * QSCALE); c2.y = pg8::cvt_pk_bf16(r0[2] * QSCALE, r0[3] * QSCALE);
                        d2.x = pg8::cvt_pk_bf16(r1[0] * QSCALE, r1[1] * QSCALE); d2.y = pg8::cvt_pk_bf16(r1[2] * QSCALE, r1[3] * QSCALE);
                        *(uint2*)(qc + dA) = a; *(uint2*)(qc + dB) = b2; *(uint2*)(qr + dA) = c2; *(uint2*)(qr + dB) = d2;
                    } else {
                        const int j = (u.pn - 8) * 2 + (cl >> 7), g = (cl >> 6) & 1;
                        if (j < 4) {
                            float* o = out + (sample ? O_SKV + ((((size_t)l * DEC_BATCH + bb) * DEC_SEQ + tt) * 4 + j) * 128 : O_PKV + ((((size_t)l * BATCH + bb) * SEQ + tt) * 4 + j) * 128) + g * 64;
                            *(f32x4*)(o + dA) = r0; *(f32x4*)(o + dB) = r1;
                        } else {
                            const int kv = j - 4;
                            if (sample) { float* o = out + O_SWIN + ((((size_t)l * DEC_BATCH + bb) * WB + (WB - DEC_SEQ + tt)) * 2 + kv) * 128 + g * 64; *(f32x4*)(o + dA) = r0; *(f32x4*)(o + dB) = r1; }
                            else if (tt >= SEQ - WP) { float* o = out + O_PWIN + ((((size_t)l * BATCH + bb) * WP + (tt - (SEQ - WP))) * 2 + kv) * 128 + g * 64; *(f32x4*)(o + dA) = r0; *(f32x4*)(o + dB) = r1; }
                        }
                        if (j >= 2) {
                            bf16_t* dstb = (j == 2 ? KSB : (j == 3 ? VSB : (j == 4 ? KWB : VWB))) + ((size_t)g * MPAD + row) * 64;
                            uint2 a, b2; a.x = pg8::cvt_pk_bf16(r0[0], r0[1]); a.y = pg8::cvt_pk_bf16(r0[2], r0[3]); b2.x = pg8::cvt_pk_bf16(r1[0], r1[1]); b2.y = pg8::cvt_pk_bf16(r1[2], r1[3]);
                            *(uint2*)(dstb + dA) = a; *(uint2*)(dstb + dB) = b2;
                        }
                    }
                }
            }
    }
};
template <int SECOND> struct EpiBranch {
    static constexpr bool PERM = true, AFTER_DRAIN = false;
    const bf16_t* SGB; float* MGF; bf16_t* MGB;
    __device__ __forceinline__ void operator()(const f32x4 (&acc)[2][2][4][2], const pg8::Unit& u, int wr, int wc, int fr, int fq) const {
#pragma unroll
        for (int ai = 0; ai < 2; ++ai)
#pragma unroll
            for (int m = 0; m < 4; ++m) {
                const int row = u.pm * 256 + ai * 128 + wr * 64 + m * 16 + fr;
#pragma unroll
                for (int bj = 0; bj < 2; ++bj) {
                    const int c = u.pn * 256 + bj * 128 + wc * 32 + fq * 8;
                    const pg8::u32x4 gs = *(const pg8::u32x4*)(SGB + (size_t)row * 2048 + (SECOND ? 1024 : 0) + c);
                    f32x4 v0, v1;
#pragma unroll
                    for (int i = 0; i < 2; ++i) { v0[2 * i] = acc[ai][bj][m][0][2 * i] * __builtin_bit_cast(float, gs[i] << 16); v0[2 * i + 1] = acc[ai][bj][m][0][2 * i + 1] * __builtin_bit_cast(float, gs[i] & 0xffff0000u);
                        v1[2 * i] = acc[ai][bj][m][1][2 * i] * __builtin_bit_cast(float, gs[2 + i] << 16); v1[2 * i + 1] = acc[ai][bj][m][1][2 * i + 1] * __builtin_bit_cast(float, gs[2 + i] & 0xffff0000u); }
                    bf16_t* mgh = (bf16_t*)MGF + (size_t)row * D + c;
                    if (!SECOND) { pg8::u32x4 o; o[0] = pg8::cvt_pk_bf16(v0[0], v0[1]); o[1] = pg8::cvt_pk_bf16(v0[2], v0[3]); o[2] = pg8::cvt_pk_bf16(v1[0], v1[1]); o[3] = pg8::cvt_pk_bf16(v1[2], v1[3]); *(pg8::u32x4*)mgh = o; }
                    else {
                        const pg8::u32x4 pv = *(const pg8::u32x4*)mgh;
#pragma unroll
                        for (int i = 0; i < 2; ++i) { v0[2 * i] += __builtin_bit_cast(float, pv[i] << 16); v0[2 * i + 1] += __builtin_bit_cast(float, pv[i] & 0xffff0000u); v1[2 * i] += __builtin_bit_cast(float, pv[2 + i] << 16); v1[2 * i + 1] += __builtin_bit_cast(float, pv[2 + i] & 0xffff0000u); }
                        pg8::u32x4 o; o[0] = pg8::cvt_pk_bf16(v0[0], v0[1]); o[1] = pg8::cvt_pk_bf16(v0[2], v0[3]); o[2] = pg8::cvt_pk_bf16(v1[0], v1[1]); o[3] = pg8::cvt_pk_bf16(v1[2], v1[3]);
                        *(pg8::u32x4*)(MGB + (size_t)row * D + c) = o;
                    }
                }
            }
    }
};
struct EpiResid {
    static constexpr bool PERM = true, AFTER_DRAIN = false;
    const float* Xs; float* X; bf16_t* XB; unsigned long long* rss;
    __device__ __forceinline__ void operator()(const f32x4 (&acc)[2][2][4][2], const pg8::Unit& u, int wr, int wc, int fr, int fq) const {
#pragma unroll
        for (int ai = 0; ai < 2; ++ai)
#pragma unroll
            for (int m = 0; m < 4; ++m) {
                const int row = u.pm * 256 + ai * 128 + wr * 64 + m * 16 + fr;
                float ss = 0.f;
#pragma unroll
                for (int bj = 0; bj < 2; ++bj) {
                    const int c = u.pn * 256 + bj * 128 + wc * 32 + fq * 8;
                    float* xp = X + (size_t)row * D + c; const float* xs = Xs + (size_t)row * D + c;
                    f32x4 v0 = *(const f32x4*)xs + acc[ai][bj][m][0], v1 = *(const f32x4*)(xs + 4) + acc[ai][bj][m][1];
                    *(f32x4*)xp = v0; *(f32x4*)(xp + 4) = v1;
                    pg8::u32x4 o; o[0] = pg8::cvt_pk_bf16(v0[0], v0[1]); o[1] = pg8::cvt_pk_bf16(v0[2], v0[3]); o[2] = pg8::cvt_pk_bf16(v1[0], v1[1]); o[3] = pg8::cvt_pk_bf16(v1[2], v1[3]);
                    *(pg8::u32x4*)(XB + (size_t)row * D + c) = o;
#pragma unroll
                    for (int i = 0; i < 4; ++i) ss += v0[i] * v0[i] + v1[i] * v1[i];
                }
                ss += __shfl_xor(ss, 16); ss += __shfl_xor(ss, 32);
                if (fq == 0) atomicAdd(rss + row, (unsigned long long)(ss * RSS_SCALE + 0.5f));
            }
    }
};
struct EpiUp {
    static constexpr bool PERM = true, AFTER_DRAIN = false;
    bf16_t* ACT; const unsigned long long* rss;
    __device__ __forceinline__ void operator()(const f32x4 (&acc)[2][2][4][2], const pg8::Unit& u, int wr, int wc, int fr, int fq) const {
#pragma unroll
        for (int ai = 0; ai < 2; ++ai)
#pragma unroll
            for (int m = 0; m < 4; ++m) {
                const int row = u.pm * 256 + ai * 128 + wr * 64 + m * 16 + fr;
                const float rs = rstd_of(rss[row]);
#pragma unroll
                for (int bj = 0; bj < 2; ++bj) {
                    const int n0 = u.pn * 256 + bj * 128 + wc * 32 + fq * 8;
                    const int c = n0 >> 1;
                    float a[4];
#pragma unroll
                    for (int i = 0; i < 4; ++i) { const float g = acc[ai][bj][m][0][i] * rs, uu = acc[ai][bj][m][1][i] * rs; a[i] = g * fast_sigmoid(g) * uu; }
                    uint2 o; o.x = pg8::cvt_pk_bf16(a[0], a[1]); o.y = pg8::cvt_pk_bf16(a[2], a[3]);
                    *(uint2*)(ACT + (size_t)row * DFF + c) = o;
                }
            }
    }
};

template <int MAP> __device__ __forceinline__ void wconv_tile(const float* src, int ldsrc, const float* gain, bf16_t* dst, int K, int k0, int n0, LDSP lds) {
    PG8_LAS float* tile = (PG8_LAS float*)lds;
    const int tid = opaque_tid();
    {
        const int n4 = (tid & 15) * 4, kk = tid >> 4;
        const int oc = MAP == 1 ? in_col_map(n0 + n4) : (MAP == 2 ? up_col_map(n0 + n4) : n0 + n4);
#pragma unroll
        for (int r = 0; r < 2; ++r) { const int k = kk + 32 * r; f32x4 v = *(const f32x4*)(src + (size_t)(k0 + k) * ldsrc + oc); if (gain) v *= gain[k0 + k]; *(PG8_LAS f32x4*)(tile + k * 68 + n4) = v; }
    }
    __syncthreads();
    {
        const int nn = tid >> 3, k8 = (tid & 7) * 8;
        pg8::u32x4 o;
#pragma unroll
        for (int i = 0; i < 4; ++i) o[i] = pg8::cvt_pk_bf16(tile[(k8 + 2 * i) * 68 + nn], tile[(k8 + 2 * i + 1) * 68 + nn]);
        *(pg8::u32x4*)(dst + (size_t)(n0 + nn) * K + k0 + k8) = o;
    }
    __syncthreads();
}
template <int MAP> __device__ __forceinline__ void wconv_strip(const float* src, int ldsrc, const float* gain, bf16_t* dst, int K, int k0, int n0, LDSP lds) {
    PG8_LAS float* tile = (PG8_LAS float*)lds;
    const int tid = opaque_tid();
    {
        const int n4 = (tid & 15) * 4, kk = tid >> 4;
        f32x4 v[4][2];
#pragma unroll
        for (int t = 0; t < 4; ++t) { const int nb = n0 + 64 * t + n4; const int oc = MAP == 1 ? in_col_map(nb) : (MAP == 2 ? up_col_map(nb) : nb);
#pragma unroll
            for (int r = 0; r < 2; ++r) v[t][r] = *(const f32x4*)(src + (size_t)(k0 + kk + 32 * r) * ldsrc + oc); }
#pragma unroll
        for (int t = 0; t < 4; ++t)
#pragma unroll
            for (int r = 0; r < 2; ++r) { f32x4 x = v[t][r]; if (gain) x *= gain[k0 + kk + 32 * r]; *(PG8_LAS f32x4*)(tile + t * 64 * 68 + (kk + 32 * r) * 68 + n4) = x; }
    }
    __syncthreads();
    {
        const int nn = tid >> 3, k8 = (tid & 7) * 8;
#pragma unroll
        for (int t = 0; t < 4; ++t) { pg8::u32x4 o;
#pragma unroll
            for (int i = 0; i < 4; ++i) o[i] = pg8::cvt_pk_bf16(tile[t * 64 * 68 + (k8 + 2 * i) * 68 + nn], tile[t * 64 * 68 + (k8 + 2 * i + 1) * 68 + nn]);
            *(pg8::u32x4*)(dst + (size_t)(n0 + 64 * t + nn) * K + k0 + k8) = o; }
    }
    __syncthreads();
}
__device__ __forceinline__ void ph_prologue(const P& p, int l_unused, LDSP lds) {
    const int tid_ = opaque_tid(); const long gtid = (long)blockIdx.x * NT + tid_, gsz = (long)gridDim.x * NT;
    for (long i = MPAD + gtid; i < 5L * MPAD; i += gsz) p.RSS[i] = 0ull;
    for (long i = gtid; i < (long)ROPE_POS * 8; i += gsz) { const int pos = (int)(i >> 3), f = (int)(i & 7); const float ang = (float)pos * rope_inv(f); p.ROPE[i * 2] = cosf(ang); p.ROPE[i * 2 + 1] = sinf(ang); }
    for (long i = gtid; i < (long)DEPTH * 32 * D; i += gsz) { const int k = (int)(i % D), j = (int)((i / D) % 32), l2 = (int)(i / (32 * D));
        const int col = j < 4 ? ZIG + j : (j < 8 ? ZFG + j - 4 : ZNG + j - 8);
        p.WSM_T[i] = f2bf(p.norm1_g[l2 * D + k] * p.w_in[((size_t)l2 * D + k) * INW + col]); }
    for (int it = (int)gridDim.x - 1 - (int)blockIdx.x; it < DEPTH * 2; it += gridDim.x) { const int kind = it & 1, l2 = it >> 1;
        const float* pe = (kind ? p.pe_v : p.pe_k) + (size_t)l2 * 2048; const float* w1 = (kind ? p.w1_v : p.w1_k) + (size_t)l2 * 2048 * 128;
        const int e4 = (tid_ & 31) * 4, kr = tid_ >> 5;
        f32x4 s = {0.f, 0.f, 0.f, 0.f};
#pragma unroll 8
        for (int k = kr; k < 2048; k += 16) { const f32x4 w = *(const f32x4*)(w1 + (size_t)k * 128 + e4); s += pe[k] * w; }
#pragma unroll
        for (int c = 0; c < 4; ++c) s[c] += __shfl_xor(s[c], 32);
        PG8_LAS float* red = (PG8_LAS float*)lds;
        if ((tid_ & 63) < 32) *(PG8_LAS f32x4*)(red + (tid_ >> 6) * 128 + e4) = s;
        __syncthreads();
        if (tid_ < 128) { float a = 0.f;
#pragma unroll
            for (int w = 0; w < 8; ++w) a += red[w * 128 + tid_];
            p.CBIAS[(size_t)it * 128 + tid_] = a; }
        __syncthreads(); }
    constexpr int T_IN = (D / 64) * (INP / 256), T_A = (MW / 64) * (D / 256), T_OUT = (D / 64) * (D / 256), T_UP = (D / 64) * (2 * DFF / 256), T_DOWN = (DFF / 64) * (D / 256);
    static_assert(INP % 256 == 0 && D % 256 == 0 && (2 * DFF) % 256 == 0, "strip widths");
    constexpr int T_W1 = 2 * (2048 / 64) * (128 / 64), T_W2 = 2 * (128 / 64) * (64 / 64);
    constexpr int T_MQK = 2 * MH * 4;
    constexpr int T_LAYER = T_IN + 2 * T_A + T_OUT + T_UP + T_DOWN + T_MQK + T_W1 + T_W2;
    for (int t = blockIdx.x; t < DEPTH * T_LAYER; t += gridDim.x) {
        const int l = t / T_LAYER; int r = t % T_LAYER;
        if (r < T_IN) { const int kt = r % (D / 64), nt = r / (D / 64); wconv_strip<1>(p.w_in + (size_t)l * D * INW, INW, p.norm1_g + l * D, p.WIN_T + (size_t)l * INP * D, D, kt * 64, nt * 256, lds); continue; }
        r -= T_IN;
        if (r < T_A) { const int kt = r % (MW / 64), nt = r / (MW / 64); wconv_strip<0>(p.w_a + (size_t)l * MW * D, D, nullptr, p.WA_T + (size_t)l * D * MW, MW, kt * 64, nt * 256, lds); continue; }
        r -= T_A;
        if (r < T_A) { const int kt = r % (MW / 64), nt = r / (MW / 64); wconv_strip<0>(p.w_b + (size_t)l * MW * D, D, nullptr, p.WB_T + (size_t)l * D * MW, MW, kt * 64, nt * 256, lds); continue; }
        r -= T_A;
        if (r < T_OUT) { const int kt = r % (D / 64), nt = r / (D / 64); wconv_strip<0>(p.w_out + (size_t)l * D * D, D, nullptr, p.WOUT_T + (size_t)l * D * D, D, kt * 64, nt * 256, lds); continue; }
        r -= T_OUT;
        if (r < T_UP) { const int kt = r % (D / 64), nt = r / (D / 64); wconv_strip<2>(p.w_up + (size_t)l * D * 2 * DFF, 2 * DFF, p.norm2_g + l * D, p.WUP_T + (size_t)l * 2 * DFF * D, D, kt * 64, nt * 256, lds); continue; }
        r -= T_UP;
        if (r >= T_DOWN + T_MQK) { r -= T_DOWN + T_MQK;
            if (r < T_W1) { const int kind = r / (T_W1 / 2), q = r % (T_W1 / 2), kt = q % 32, nt = q / 32;
                wconv_tile<0>((kind ? p.w1_v : p.w1_k) + (size_t)l * 2048 * 128, 128, nullptr, p.W1T + ((size_t)l * 2 + kind) * 128 * 2048, 2048, kt * 64, nt * 64, lds); }
            else { r -= T_W1; const int kind = r / 2, kt = r & 1;
                wconv_tile<0>((kind ? p.w2_v : p.w2_k) + (size_t)l * 128 * 64, 64, nullptr, p.W2T + ((size_t)l * 2 + kind) * 64 * 128, 128, kt * 64, 0, lds); }
            continue; }
        if (r >= T_DOWN) { r -= T_DOWN; const int which = r / (MH * 4), hd = (r / 4) % MH, kt = r & 1, nt = (r >> 1) & 1;
            wconv_tile<0>((which ? p.w_mk : p.w_mq) + ((size_t)l * MH + hd) * MHD * MHD, MHD, nullptr, (which ? p.WMK_T : p.WMQ_T) + ((size_t)l * MH + hd) * MHD * MHD, MHD, kt * 64, nt * 64, lds); continue; }
        { const int kt = r % (DFF / 64), nt = r / (DFF / 64); wconv_strip<0>(p.w_down + (size_t)l * DFF * D, D, nullptr, p.WDOWN_T + (size_t)l * D * DFF, DFF, kt * 64, nt * 256, lds); }
    }
    const int wave = tid_ >> 6, lane = tid_ & 63;
    for (int row = blockIdx.x * 8 + wave; row < MPAD; row += gridDim.x * 8) {
        float ss = 0.f;
        for (int c = lane * 4; c < D; c += 256) {
            float4 v = make_float4(0.f, 0.f, 0.f, 0.f);
            if (row < NTOK) v = *(const float4*)((row < NPT ? p.x_prompt + (size_t)row * D : p.x_sample + (size_t)(row - NPT) * D) + c);
            uint2 o; o.x = pg8::cvt_pk_bf16(v.x, v.y); o.y = pg8::cvt_pk_bf16(v.z, v.w);
            *(uint2*)(p.XB + (size_t)row * D + c) = o;
            ss += v.x * v.x + v.y * v.y + v.z * v.z + v.w * v.w;
        }
#pragma unroll
        for (int s = 32; s >= 1; s >>= 1) ss += __shfl_xor(ss, s);
        if (lane == 0) p.RSS[row] = (unsigned long long)(ss * RSS_SCALE + 0.5f);
    }
}

#ifndef GP_ALIGN
#define GP_ALIGN true
#endif
#ifndef GP_SP2
#define GP_SP2 true
#endif
__device__ __forceinline__ void ph_gemm_in(const P& p, int l, LDSP lds) {
    pg8::Gemm g{p.XB, p.WIN_T + (size_t)l * INP * D, MPAD, INP, D};
    pg8::StaticOrder S; S.init(MPAD, INP, gridDim.x, blockIdx.x);
    EpiIn E{p.Z, p.RSS + (size_t)(2 * l) * MPAD, p.ROPE, p.out, p.QCB, p.QRB, p.KSB, p.VSB, p.KWB, p.VWB, p.SGB, l};
    pg8::gemm_phase2<EpiIn, pg8::StaticOrder, GP_ALIGN, GP_SP2>(lds, g, S, E);
}
__device__ __forceinline__ void ph_small(const P& p, int l, long gtid, long gsz) {
    PLOOP(i, (size_t)NTOK * 32) {
        const int tok = (int)(i >> 5), j = (int)(i & 31);
        const int col = j < 4 ? ZIG + j : (j < 8 ? ZFG + j - 4 : ZNG + j - 8);
        const float* x = p.X + (size_t)tok * D; const float* w = p.w_in + (size_t)l * D * INW + col; const float* g = p.norm1_g + l * D;
        float acc = 0.f;
        for (int k = 0; k < D; ++k) acc += x[k] * g[k] * w[(size_t)k * INW];
        p.Z[(size_t)tok * INW + col] = acc * rstd_of(p.RSS[(size_t)(2 * l) * MPAD + tok]);
    }
}
constexpr int TAIL_ROWS = MPAD - NPT;
static_assert(NPT % 256 == 0 && TAIL_ROWS % 64 == 0 && D % 32 == 0, "tail tiling");
template <int KDIM> __device__ __forceinline__ void tail_partial(f32x4 (&acc)[8], const bf16_t* A, const bf16_t* W, int row0, int col0, int wv, int lr, int kq) {
    constexpr int KW = KDIM / 8; static_assert(KW % 32 == 0, "K slice per wave");
    const bf16_t* ap = A + (size_t)(row0 + lr) * KDIM + wv * KW + 8 * kq; const bf16_t* wp = W + (size_t)(col0 + lr) * KDIM + wv * KW + 8 * kq;
#pragma unroll
    for (int t = 0; t < 8; ++t) acc[t] = f32x4{0.f, 0.f, 0.f, 0.f};
#pragma unroll 2
    for (int s = 0; s < KW / 32; ++s) {
        bf16x8 af[4], wf[2];
#pragma unroll
        for (int a = 0; a < 4; ++a) af[a] = *(const bf16x8*)(ap + (size_t)a * 16 * KDIM + 32 * s);
#pragma unroll
        for (int b = 0; b < 2; ++b) wf[b] = *(const bf16x8*)(wp + (size_t)b * 16 * KDIM + 32 * s);
#pragma unroll
        for (int b = 0; b < 2; ++b)
#pragma unroll
            for (int a = 0; a < 4; ++a) acc[b * 4 + a] = __builtin_amdgcn_mfma_f32_16x16x32_bf16(af[a], wf[b], acc[b * 4 + a], 0, 0, 0);
    }
}
__device__ __forceinline__ f32x4 tail_reduce(LDSP lds, const f32x4 (&acc)[8], int wv, int lane) {
    PG8_LAS float* rb = (PG8_LAS float*)lds;
    __syncthreads();
#pragma unroll
    for (int t = 0; t < 8; ++t)
#pragma unroll
        for (int i = 0; i < 4; ++i) rb[(wv * 32 + t * 4 + i) * 64 + lane] = acc[t][i];
    __syncthreads();
    f32x4 r = {0.f, 0.f, 0.f, 0.f};
#pragma unroll
    for (int v = 0; v < 8; ++v)
#pragma unroll
        for (int i = 0; i < 4; ++i) r[i] += rb[(v * 32 + wv * 4 + i) * 64 + lane];
    return r;
}
#define TAIL_LOOP const int tid = opaque_tid(), wv = tid >> 6, lane = tid & 63, lr = tid & 15, kq = (tid >> 4) & 3; \
    for (int t = blockIdx.x; t < (TAIL_ROWS / 64) * (D / 32); t += gridDim.x) { const int rowb = NPT + (t / (D / 32)) * 64, colb = (t % (D / 32)) * 32, row0 = rowb + (wv & 3) * 16, col0 = colb + (wv >> 2) * 16;
template <int KDIM, bool FIRST> __device__ __forceinline__ void tail_resid(LDSP lds, const bf16_t* A, const bf16_t* W, const float* Xs, float* X, bf16_t* XB, unsigned long long* rss) {
    TAIL_LOOP
        f32x4 acc[8]; tail_partial<KDIM>(acc, A, W, rowb, colb, wv, lr, kq);
        const f32x4 a = tail_reduce(lds, acc, wv, lane);
#pragma unroll
        for (int i = 0; i < 4; ++i) { const int row = row0 + 4 * kq + i; const size_t o = (size_t)row * D + col0 + lr;
            const float x = ((FIRST && row >= NTOK) ? 0.f : Xs[o]) + a[i]; X[o] = x; XB[o] = f2bf(x);
            float ss = x * x; ss += __shfl_xor(ss, 1); ss += __shfl_xor(ss, 2); ss += __shfl_xor(ss, 4); ss += __shfl_xor(ss, 8);
            if (lr == 0) atomicAdd(rss + row, (unsigned long long)(ss * RSS_SCALE + 0.5f)); }
    }
}
__device__ __forceinline__ void tail_branch(const P& p, int l, LDSP lds) {
    TAIL_LOOP
        f32x4 acc[8]; tail_partial<MW>(acc, p.HAB, p.WA_T + (size_t)l * D * MW, rowb, colb, wv, lr, kq);
        const f32x4 a = tail_reduce(lds, acc, wv, lane);
        tail_partial<MW>(acc, p.HBB, p.WB_T + (size_t)l * D * MW, rowb, colb, wv, lr, kq);
        const f32x4 b = tail_reduce(lds, acc, wv, lane);
#pragma unroll
        for (int i = 0; i < 4; ++i) { const int row = row0 + 4 * kq + i, c = col0 + lr;
            const float v = a[i] * bf2f(p.SGB[(size_t)row * 2048 + c]) + b[i] * bf2f(p.SGB[(size_t)row * 2048 + 1024 + c]);
            p.MGB[(size_t)row * D + c] = f2bf(v); }
    }
}
__device__ __forceinline__ void ph_gemm_branch(const P& p, int l, LDSP lds) {
    pg8::StaticOrder S; S.init(NPT, D, gridDim.x, blockIdx.x);
    { pg8::Gemm g{p.HAB, p.WA_T + (size_t)l * D * MW, NPT, D, MW}; EpiBranch<0> E{p.SGB, p.MGF, p.MGB}; pg8::gemm_phase2<EpiBranch<0>, pg8::StaticOrder, GP_ALIGN, GP_SP2>(lds, g, S, E); }
    __syncthreads();
    { pg8::Gemm g{p.HBB, p.WB_T + (size_t)l * D * MW, NPT, D, MW}; EpiBranch<1> E{p.SGB, p.MGF, p.MGB}; pg8::gemm_phase2<EpiBranch<1>, pg8::StaticOrder, GP_ALIGN, GP_SP2>(lds, g, S, E); }
    tail_branch(p, l, lds);
}
__device__ __forceinline__ void ph_gemm_out(const P& p, int l, LDSP lds) {
    pg8::Gemm g{p.MGB, p.WOUT_T + (size_t)l * D * D, NPT, D, D};
    pg8::StaticOrder S; S.init(NPT, D, gridDim.x, blockIdx.x);
    EpiResid E{l == 0 ? p.x_prompt : p.X, p.X, p.XB, p.RSS + (size_t)(2 * l + 1) * MPAD};
    pg8::gemm_phase2<EpiResid, pg8::StaticOrder, GP_ALIGN, GP_SP2>(lds, g, S, E);
    if (l == 0) tail_resid<D, true>(lds, p.MGB, p.WOUT_T + (size_t)l * D * D, p.x_sample - (size_t)NPT * D, p.X, p.XB, p.RSS + (size_t)(2 * l + 1) * MPAD);
    else tail_resid<D, false>(lds, p.MGB, p.WOUT_T + (size_t)l * D * D, p.X, p.X, p.XB, p.RSS + (size_t)(2 * l + 1) * MPAD);
}
__device__ __forceinline__ void swin_shift_light(const P& p, int l, int nunits) {
    const int G = (int)gridDim.x, nfull = nunits % G;
    const int nl = nfull ? G - nfull : G, li = nfull ? (int)blockIdx.x - nfull : (int)blockIdx.x;
    if (li < 0) return;
    constexpr unsigned PER_B = (unsigned)(WB - DEC_SEQ) * 64u, NV = (unsigned)DEC_BATCH * PER_B;
    const unsigned stride = (unsigned)nl * NT;
    const float4* src0 = (const float4*)(p.cache_win + (size_t)l * DEC_BATCH * WB * 256 + DEC_SEQ * 256); float4* dst0 = (float4*)(p.out + O_SWIN + (size_t)l * DEC_BATCH * WB * 256);
    for (unsigned i0 = (unsigned)li * NT + (unsigned)opaque_tid(); i0 < NV; i0 += 8u * stride) {
        float4 v0, v1, v2, v3, v4, v5, v6, v7;
#define SWL(u, v) { const unsigned i = i0 + u * stride; if (i < NV) v = src0[(size_t)(i / PER_B) * (WB * 64) + i % PER_B]; }
        SWL(0u, v0) SWL(1u, v1) SWL(2u, v2) SWL(3u, v3) SWL(4u, v4) SWL(5u, v5) SWL(6u, v6) SWL(7u, v7)
#undef SWL
#define SWS(u, v) { const unsigned i = i0 + u * stride; if (i < NV) dst0[(size_t)(i / PER_B) * (WB * 64) + i % PER_B] = v; }
        SWS(0u, v0) SWS(1u, v1) SWS(2u, v2) SWS(3u, v3) SWS(4u, v4) SWS(5u, v5) SWS(6u, v6) SWS(7u, v7)
#undef SWS
    }
}
__device__ __forceinline__ void ph_gemm_up(const P& p, int l, LDSP lds) {
    pg8::Gemm g{p.XB, p.WUP_T + (size_t)l * 2 * DFF * D, MPAD, 2 * DFF, D};
    pg8::StaticOrder S; S.init(MPAD, 2 * DFF, gridDim.x, blockIdx.x);
    EpiUp E{p.ACTB, p.RSS + (size_t)(2 * l + 1) * MPAD};
    pg8::gemm_phase2<EpiUp, pg8::StaticOrder, GP_ALIGN, GP_SP2>(lds, g, S, E);
    swin_shift_light(p, l, (MPAD / 256) * (2 * DFF / 256));
}
__device__ __forceinline__ void ph_gemm_down(const P& p, int l, LDSP lds) {
    pg8::Gemm g{p.ACTB, p.WDOWN_T + (size_t)l * D * DFF, NPT, D, DFF};
    pg8::StaticOrder S; S.init(NPT, D, gridDim.x, blockIdx.x);
    EpiResid E{p.X, p.X, p.XB, p.RSS + (size_t)(2 * l + 2) * MPAD};
    pg8::gemm_phase2<EpiResid, pg8::StaticOrder, GP_ALIGN, GP_SP2>(lds, g, S, E);
    tail_resid<DFF, false>(lds, p.ACTB, p.WDOWN_T + (size_t)l * D * DFF, p.X, p.X, p.XB, p.RSS + (size_t)(2 * l + 2) * MPAD);
}
__device__ __forceinline__ void ph_final(const P& p, int l, long gtid, long gsz) {
#ifdef DIAG2
    for (long i = (long)O_PKV + gtid; i < (long)O_END; i += gsz) p.out[i] = 0.f;
#endif
    PLOOP(i, (size_t)NTOK * D / 4) {
        const int tok = (int)(i / (D / 4)), c = (int)(i % (D / 4)) * 4;
        const float rs = rstd_of(p.RSS[(size_t)(2 * DEPTH) * MPAD + tok]);
        const float4 x = *(const float4*)(p.X + (size_t)tok * D + c), g = *(const float4*)(p.final_g + c);
        float4 y = make_float4(x.x * rs * g.x, x.y * rs * g.y, x.z * rs * g.z, x.w * rs * g.w);
#if defined(DIAG_DUP) || defined(DIAG_DUP2)
        if (p.DIAGF[0]) y = make_float4(0.f, 0.f, 0.f, 0.f);
#endif
#ifdef DIAG2
        y = make_float4(0.f, 0.f, 0.f, 0.f);
        if (i == 0) y.x = (float)(*(const unsigned long long*)(p.DIAGF + 2) & 0xFFFFFFull) * (4.f / 16777216.f);
#ifdef DIAG_ML1DUP
        if (i == 0) y.x = p.DIAGF[0] ? 3.f : 0.f;
#endif
#endif
#ifdef DIAG_SUM
        if (i == 0) y.x = (float)(*(const unsigned long long*)(p.DIAGF + 2) & 0xFFFFFFull) * (4.f / 16777216.f);
#endif
        *(float4*)(p.out + (size_t)tok * D + c) = y;
    }
}

__device__ __forceinline__ void ph_kv(const P& p, int l, long gtid, long gsz) {
    PLOOP(i, (size_t)NTOK * 768) {
        int tok = (int)(i / 768), c = (int)(i % 768);
        int j = c / 128, g = (c % 128) / 64, d = c % 64;
        Tok ti = tokinfo(tok);
        const float* x = p.Z + (size_t)tok * INW + ZKV + j * 128 + g * 64;
        float v = (j == 2 || j == 4) ? rope_elem(x, d, ti.pos) : x[d];
        if (j >= 2) { bf16_t* dstb = (j == 2 ? p.KSB : (j == 3 ? p.VSB : (j == 4 ? p.KWB : p.VWB))); dstb[((size_t)g * MPAD + tok) * 64 + d] = f2bf(v); }
        if (j < 4) {
            size_t o = ti.sample ? O_SKV + ((((size_t)l * DEC_BATCH + ti.b) * DEC_SEQ + ti.t) * 4 + j) * 128 + g * 64 + d
                                 : O_PKV + ((((size_t)l * BATCH + ti.b) * SEQ + ti.t) * 4 + j) * 128 + g * 64 + d;
            p.out[o] = v;
        } else {
            int kv = j - 4;
            p.KW[((size_t)tok * 2 + kv) * 128 + g * 64 + d] = v;
            if (ti.sample) {
                p.out[O_SWIN + ((((size_t)l * DEC_BATCH + ti.b) * WB + (WB - DEC_SEQ + ti.t)) * 2 + kv) * 128 + g * 64 + d] = v;
            } else if (ti.t >= SEQ - WP) {
                p.out[O_PWIN + ((((size_t)l * BATCH + ti.b) * WP + (ti.t - (SEQ - WP))) * 2 + kv) * 128 + g * 64 + d] = v;
            }
        }
    }
}
__device__ __forceinline__ void ph_swin_copy(const P& p, int l, long gtid, long gsz) {
    PLOOP(i, (size_t)DEC_BATCH * (WB - DEC_SEQ) * 256) {
        int b = (int)(i / ((WB - DEC_SEQ) * 256)); int r = (int)(i % ((WB - DEC_SEQ) * 256));
        p.out[O_SWIN + ((size_t)l * DEC_BATCH + b) * WB * 256 + r] = p.cache_win[((size_t)l * DEC_BATCH + b) * WB * 256 + DEC_SEQ * 256 + r];
    }
}
__device__ __forceinline__ void ph_qrot(const P& p, int l, long gtid, long gsz) {
    PLOOP(i, (size_t)NTOK * 512) {
        int tok = (int)(i / 512), c = (int)(i % 512); int h = c / 64, d = c % 64;
        Tok ti = tokinfo(tok);
        p.QR[i] = rope_elem(p.Z + (size_t)tok * INW + ZQ + h * 64, d, ti.pos);
        p.QRB[i] = f2bf(p.QR[i] * QSCALE); p.QCB[i] = f2bf(p.Z[(size_t)tok * INW + ZQ + h * 64 + d] * QSCALE);
    }
}
__device__ __forceinline__ float conv_u(const P& p, int l, const Tok& ti, int tok, int dt, int c) {
    int t = ti.t + dt;
    if (t >= 0) return p.Z[(size_t)(tok + dt) * INW + ZU + c];
    if (!ti.sample) return 0.f;
    return p.st_conv[(((size_t)l * DEC_BATCH + ti.b) * 3 + (3 + t)) * MW + c];
}
__device__ __forceinline__ void ph_conv(const P& p, int l, long gtid, long gsz) {
    PLOOP_FROM(i, (size_t)ML_TOK0 * 512, (size_t)NTOK * 512) {
        int tok = (int)(i / 512), c = (int)(i % 512);
        Tok ti = tokinfo(tok);
        float y = p.conv_b[l * MW + c];
#pragma unroll
        for (int j = 0; j < 4; ++j) y += conv_u(p, l, ti, tok, j - 3, c) * p.conv_w[((size_t)l * 4 + j) * MW + c];
        p.CC[i] = siluf_(y);
    }
    PLOOP(i, (size_t)NSEQ * 3 * 512) {
        int seq = (int)(i / 1536), r = (int)((i % 1536) / 512), c = (int)(i % 512);
        int T = seq_len(seq), row0 = seq_row0(seq);
        Tok ti = tokinfo(row0 + T - 1);
        float v = conv_u(p, l, ti, row0 + T - 1, r - 2, c);
        if (seq < BATCH) p.out[O_PCONV + (((size_t)l * BATCH + seq) * 3 + r) * MW + c] = v;
        else p.out[O_SCONV + (((size_t)l * DEC_BATCH + (seq - BATCH)) * 3 + r) * MW + c] = v;
    }
    PLOOP(i, (size_t)NTOK * 4) {
        int tok = (int)(i / 4), h = (int)(i % 4);
        p.IG[i] = p.Z[(size_t)tok * INW + ZIG + h] + p.b_gates[l * 8 + h];
        p.LF[i] = log_sigmoidf_(p.Z[(size_t)tok * INW + ZFG + h] + p.b_gates[l * 8 + 4 + h]);
    }
}
__device__ __forceinline__ void ph_mqk(const P& p, int l, long gtid, long gsz) {
    for (int h = 0; h < MH; ++h) {
        gemm_items(p.CC + (size_t)ML_TOK0 * MW + h * MHD, MW, p.w_mq + ((size_t)l * MH + h) * MHD * MHD, MHD, p.QM + (size_t)ML_TOK0 * MW + h * MHD, MW, NTOK - ML_TOK0, MHD, MHD, 0, gtid, gsz);
        gemm_items(p.CC + (size_t)ML_TOK0 * MW + h * MHD, MW, p.w_mk + ((size_t)l * MH + h) * MHD * MHD, MHD, p.KM + (size_t)ML_TOK0 * MW + h * MHD, MW, NTOK - ML_TOK0, MHD, MHD, 0, gtid, gsz);
    }
}
__device__ __forceinline__ void ph_mlstm(const P& p, int l, long gtid, long gsz) {
    PLOOP_FROM(it, (size_t)ML_SEQ0 * MH * 4 * 129, (size_t)NSEQ * MH * 4 * 129) {
        int e = (int)(it % 129); int part = (int)((it / 129) % 4); int h = (int)((it / (129 * 4)) % MH); int seq = (int)(it / (129 * 4 * MH));
        int T = seq_len(seq), row0 = seq_row0(seq);
        bool sample = seq >= BATCH; int b = sample ? seq - BATCH : seq;
        float C[32]; float m = 0.f;
#pragma unroll
        for (int i = 0; i < 32; ++i) C[i] = 0.f;
        if (sample) {
            m = p.st_m[((size_t)l * DEC_BATCH + b) * MH + h];
#pragma unroll
            for (int i = 0; i < 32; ++i) {
                int d = part * 32 + i;
                C[i] = e < 128 ? p.st_C[((((size_t)l * DEC_BATCH + b) * MH + h) * MHD + d) * MHD + e] : p.st_n[(((size_t)l * DEC_BATCH + b) * MH + h) * MHD + d];
            }
        }
        for (int t = 0; t < T; ++t) {
            int tok = row0 + t;
            float ig = p.IG[tok * 4 + h], lf = p.LF[tok * 4 + h];
            float mn = fmaxf(lf + m, ig);
            float dec = expf(lf + m - mn), w = expf(ig - mn);
            m = mn;
            float ve = e < 128 ? p.Z[(size_t)tok * INW + ZV + h * MHD + e] : 1.f;
            float wv = w * ve, acc = 0.f;
            const float* kk = p.KM + (size_t)tok * MW + h * MHD + part * 32;
            const float* qq = p.QM + (size_t)tok * MW + h * MHD + part * 32;
#pragma unroll
            for (int i = 0; i < 32; ++i) {
                C[i] = dec * C[i] + wv * (kk[i] * 0.08838834764831845f);
                acc += qq[i] * C[i];
            }
            p.NUMP[(((size_t)tok * MH + h) * 4 + part) * 129 + e] = acc;
            if (e == 0 && part == 0) p.MT[tok * 4 + h] = m;
        }
        size_t oC = sample ? O_SC + (((size_t)l * DEC_BATCH + b) * MH + h) * MHD * MHD : O_PC + (((size_t)l * BATCH + b) * MH + h) * MHD * MHD;
        size_t oN = sample ? O_SN + (((size_t)l * DEC_BATCH + b) * MH + h) * MHD : O_PN + (((size_t)l * BATCH + b) * MH + h) * MHD;
        size_t oM = sample ? O_SM + ((size_t)l * DEC_BATCH + b) * MH + h : O_PM + ((size_t)l * BATCH + b) * MH + h;
#pragma unroll
        for (int i = 0; i < 32; ++i) {
            int d = part * 32 + i;
            if (e < 128) p.out[oC + (size_t)d * MHD + e] = C[i]; else p.out[oN + d] = C[i];
        }
        if (e == 0 && part == 0) p.out[oM] = m;
    }
}
__device__ __forceinline__ void ph_ha(const P& p, int l, long gtid, long gsz) {
    PLOOP_FROM(it, (size_t)ML_TOK0 * MH, (size_t)NTOK * MH) {
        int tok = (int)(it / MH), h = (int)(it % MH);
        const float* np_ = p.NUMP + (size_t)it * 4 * 129;
        float den = np_[128] + np_[129 + 128] + np_[2 * 129 + 128] + np_[3 * 129 + 128];
        float dn = fmaxf(fabsf(den), expf(-p.MT[it]));
        float ss = 0.f;
        for (int e = 0; e < MHD; ++e) { float hv = (np_[e] + np_[129 + e] + np_[2 * 129 + e] + np_[3 * 129 + e]) / dn; ss += hv * hv; }
        float r = 1.f / sqrtf(ss / MHD + EPS);
        for (int e = 0; e < MHD; ++e) {
            float hv = (np_[e] + np_[129 + e] + np_[2 * 129 + e] + np_[3 * 129 + e]) / dn;
            float o = p.Z[(size_t)tok * INW + ZO + h * MHD + e];
            p.HAB[(size_t)tok * MW + h * MHD + e] = f2bf(hv * r * p.mnorm_g[l * MW + h * MHD + e] * sigmoidf_(o));
        }
    }
}
__device__ __forceinline__ void cmp_item(long item, int& seq, int& n, int& g, int& kind) {
    kind = (int)(item & 1); g = (int)((item >> 1) & 1); long r = item >> 2;
    if (r < (long)BATCH * NCP) { seq = (int)(r / NCP); n = (int)(r % NCP); }
    else { r -= (long)BATCH * NCP; seq = BATCH + (int)(r / NCS); n = (int)(r % NCS); }
}
__device__ __forceinline__ void ph_cmp_hid(const P& p, int l, long gtid, long gsz) {
    PLOOP(i, KC_ROWS * 4 * CHID) {
        long item = i / CHID; int e = (int)(i % CHID);
        int seq, n, g, kind; cmp_item(item, seq, n, g, kind);
        const float* pe = (kind ? p.pe_v : p.pe_k) + (size_t)l * 32 * 64;
        const float* w1 = (kind ? p.w1_v : p.w1_k) + (size_t)l * 32 * 64 * CHID;
        float acc = 0.f;
        for (int r = 0; r < 32; ++r) {
            const float* row = kvrow(p, l, seq, n * 16 + r, kind, g);
            for (int d = 0; d < 64; ++d) acc += (row[d] + pe[r * 64 + d]) * w1[((size_t)r * 64 + d) * CHID + e];
        }
        p.HID[i] = geluf_(acc);
    }
}
__device__ __forceinline__ void ph_cmp_out(const P& p, int l, long gtid, long gsz) {
    PLOOP(i, KC_ROWS * 4 * 64) {
        long item = i / 64; int f = (int)(i % 64);
        int seq, n, g, kind; cmp_item(item, seq, n, g, kind);
        const float* w2 = (kind ? p.w2_v : p.w2_k) + (size_t)l * CHID * 64;
        float acc = 0.f;
        for (int e = 0; e < CHID; ++e) acc += p.HID[item * CHID + e] * w2[e * 64 + f];
        (kind ? p.VC : p.KC)[((kc_base(seq) + n) * 2 + g) * 64 + f] = acc;
    }
}
__device__ __forceinline__ void ph_sc(const P& p, int l, long gtid, long gsz) {
    PLOOP_FROM(i, (size_t)NSA_TOK0 * NH * NCMAX, (size_t)NTOK * NH * NCMAX) {
        int n = (int)(i % NCMAX); int h = (int)((i / NCMAX) % NH); int tok = (int)(i / ((long)NCMAX * NH));
        Tok ti = tokinfo(tok);
        int nc = seq_nc(ti.seq);
        float s = NEG;
        if (n < nc && n * 16 + 31 <= ti.pos) {
            const float* q = p.Z + (size_t)tok * INW + ZQ + h * 64;
            const float* k = p.KC + ((kc_base(ti.seq) + n) * 2 + h / 4) * 64;
            float acc = 0.f;
            for (int d = 0; d < 64; ++d) acc += q[d] * k[d];
            s = acc * 0.125f;
        }
        p.PC[i] = s;
    }
}
__device__ __forceinline__ void softmax_row(float* s, int len) {
    float mx = NEG;
    for (int i = 0; i < len; ++i) mx = fmaxf(mx, s[i]);
    float sum = 0.f;
    for (int i = 0; i < len; ++i) { if (s[i] > 0.5f * NEG) sum += expf(s[i] - mx); }
    float inv = 1.f / fmaxf(sum, TINY);
    for (int i = 0; i < len; ++i) s[i] = (s[i] > 0.5f * NEG) ? expf(s[i] - mx) * inv : 0.f;
}
__device__ __forceinline__ void ph_sc_softmax(const P& p, int l, long gtid, long gsz) {
    PLOOP_FROM(i, (size_t)NSA_TOK0 * NH, (size_t)NTOK * NH) softmax_row(p.PC + (size_t)i * NCMAX, NCMAX);
}
__device__ __forceinline__ void ph_oc(const P& p, int l, long gtid, long gsz) {
    PLOOP_FROM(i, (size_t)NSA_TOK0 * 512, (size_t)NTOK * 512) {
        int tok = (int)(i / 512), h = (int)((i % 512) / 64), d = (int)(i % 64);
        Tok ti = tokinfo(tok); int nc = seq_nc(ti.seq);
        const float* pc = p.PC + ((size_t)tok * NH + h) * NCMAX;
        float acc = 0.f;
        for (int n = 0; n < nc; ++n) acc += pc[n] * p.VC[((kc_base(ti.seq) + n) * 2 + h / 4) * 64 + d];
        p.OC[i] = acc;
    }
}
__device__ __forceinline__ void ph_select(const P& p, int l, long gtid, long gsz) {
    PLOOP_FROM(i, (size_t)NSA_TOK0 * NKV, (size_t)NTOK * NKV) {
        int tok = (int)(i / NKV), g = (int)(i % NKV);
        Tok ti = tokinfo(tok);
        int nc = seq_nc(ti.seq), nblk = ti.sample ? NBS : NBP;
        int cur = ti.pos / SELB;
        float* sc = p.SCORE + (size_t)i * 64;
        for (int j = 0; j < nblk; ++j) {
            float imp = 0.f;
            for (int n = 4 * j - 1; n <= 4 * j + 3; ++n) {
                if (n < 0 || n >= nc) continue;
                int lo = n * 16 > j * 64 ? n * 16 : j * 64;
                int hi = n * 16 + 32 < j * 64 + 64 ? n * 16 + 32 : j * 64 + 64;
                int ov = hi - lo; if (ov <= 0) continue;
                float w = (float)ov / 32.f;
                float sum = 0.f;
                for (int r = 0; r < 4; ++r) sum += p.PC[((size_t)tok * NH + g * 4 + r) * NCMAX + n];
                imp += sum * w;
            }
            bool forced = (j == 0) || (j == cur) || (j == cur - 1);
            sc[j] = j <= cur ? (forced ? 1e9f : imp) : -1.f;
        }
        int nsel = nblk < SELTOP ? nblk : SELTOP;
        for (int k = 0; k < nsel; ++k) {
            int best = 0; float bv = -3e38f;
            for (int j = 0; j < nblk; ++j) if (sc[j] > bv) { bv = sc[j]; best = j; }
            p.SEL[(size_t)i * SELTOP + k] = best;
            sc[best] = -3.4e38f;
        }
    }
}
__device__ __forceinline__ void ph_ss(const P& p, int l, long gtid, long gsz) {
    PLOOP_FROM(i, (size_t)NSA_TOK0 * NH * 1024, (size_t)NTOK * NH * 1024) {
        int idx = (int)(i % 1024); int h = (int)((i / 1024) % NH); int tok = (int)(i / (1024 * NH));
        Tok ti = tokinfo(tok);
        int nblk = ti.sample ? NBS : NBP; int nsel = nblk < SELTOP ? nblk : SELTOP; int L = ti.sample ? PAST_LEN + DEC_SEQ : SEQ;
        int k = idx / 64, ii = idx % 64; int g = h / 4;
        float s = NEG;
        if (k < nsel) {
            int tk = p.SEL[((size_t)tok * NKV + g) * SELTOP + k] * 64 + ii;
            if (tk <= ti.pos) {
                int kp = tk < L - 1 ? tk : L - 1;
                const float* q = p.QR + (size_t)tok * 512 + h * 64;
                const float* kr = kvrow(p, l, ti.seq, kp, 2, g);
                float acc = 0.f;
                for (int d = 0; d < 64; ++d) acc += q[d] * kr[d];
                s = acc * 0.125f;
            }
        }
        p.PS[i] = s;
    }
}
__device__ __forceinline__ void ph_ss_softmax(const P& p, int l, long gtid, long gsz) {
    PLOOP_FROM(i, (size_t)NSA_TOK0 * NH, (size_t)NTOK * NH) softmax_row(p.PS + (size_t)i * 1024, 1024);
}
__device__ __forceinline__ void ph_os(const P& p, int l, long gtid, long gsz) {
    PLOOP_FROM(i, (size_t)NSA_TOK0 * 512, (size_t)NTOK * 512) {
        int tok = (int)(i / 512), h = (int)((i % 512) / 64), d = (int)(i % 64);
        Tok ti = tokinfo(tok); int g = h / 4;
        int nblk = ti.sample ? NBS : NBP; int nsel = nblk < SELTOP ? nblk : SELTOP; int L = ti.sample ? PAST_LEN + DEC_SEQ : SEQ;
        const float* ps = p.PS + ((size_t)tok * NH + h) * 1024;
        float acc = 0.f;
        for (int k = 0; k < nsel; ++k) {
            int blk = p.SEL[((size_t)tok * NKV + g) * SELTOP + k];
            for (int ii = 0; ii < 64; ++ii) {
                float w = ps[k * 64 + ii];
                if (w != 0.f) { int tk = blk * 64 + ii; int kp = tk < L - 1 ? tk : L - 1; acc += w * kvrow(p, l, ti.seq, kp, 3, g)[d]; }
            }
        }
        p.OS[i] = acc;
    }
}
__device__ __forceinline__ void ph_sw(const P& p, int l, long gtid, long gsz) {
    PLOOP_FROM(i, (size_t)NSA_TOK0 * NH * 512, (size_t)NTOK * NH * 512) {
        int w = (int)(i % 512); int h = (int)((i / 512) % NH); int tok = (int)(i / (512 * NH));
        Tok ti = tokinfo(tok);
        int kp = ti.pos - 511 + w;
        float s = NEG;
        if (kp >= 0) {
            const float* q = p.QR + (size_t)tok * 512 + h * 64;
            const float* kr = winrow(p, l, ti.seq, kp, 0, h / 4);
            float acc = 0.f;
            for (int d = 0; d < 64; ++d) acc += q[d] * kr[d];
            s = acc * 0.125f;
        }
        p.PW[i] = s;
    }
}
__device__ __forceinline__ void ph_sw_softmax(const P& p, int l, long gtid, long gsz) {
    PLOOP_FROM(i, (size_t)NSA_TOK0 * NH, (size_t)NTOK * NH) softmax_row(p.PW + (size_t)i * 512, 512);
}
__device__ __forceinline__ void ph_ow(const P& p, int l, long gtid, long gsz) {
    PLOOP_FROM(i, (size_t)NSA_TOK0 * 512, (size_t)NTOK * 512) {
        int tok = (int)(i / 512), h = (int)((i % 512) / 64), d = (int)(i % 64);
        Tok ti = tokinfo(tok);
        const float* pw = p.PW + ((size_t)tok * NH + h) * 512;
        float acc = 0.f;
        for (int w = 0; w < 512; ++w) {
            int kp = ti.pos - 511 + w;
            if (kp >= 0) acc += pw[w] * winrow(p, l, ti.seq, kp, 1, h / 4)[d];
        }
        p.OW[i] = acc;
    }
}
__device__ __forceinline__ void ph_hb(const P& p, int l, long gtid, long gsz) {
    PLOOP_FROM(i, (size_t)NSA_TOK0 * 512, (size_t)NTOK * 512) {
        int tok = (int)(i / 512), h = (int)((i % 512) / 64);
        const float* ng = p.Z + (size_t)tok * INW + ZNG + h * 3;
        p.HBB[i] = f2bf(sigmoidf_(ng[0]) * p.OC[i] + sigmoidf_(ng[1]) * p.OS[i] + sigmoidf_(ng[2]) * p.OW[i]);
    }
}

constexpr int KSTR = 72;
constexpr int NSA_K_OFF = 0, NSA_V_OFF = 64 * KSTR * 2, NSA_IMPA_OFF = 32768  , NSA_IMPB_OFF = NSA_IMPA_OFF + 64 * 65 * 4,
              NSA_MASK_OFF = NSA_IMPB_OFF + 64 * 65 * 4, NSA_QPARK_OFF = NSA_MASK_OFF + 64 * 8, NSA_LDS_END = NSA_QPARK_OFF + 4 * 8192;
typedef float f32x16 __attribute__((ext_vector_type(16)));
typedef short s16x4 __attribute__((ext_vector_type(4)));

#ifdef CPU_TEST
static inline s16x4 lds_tr16_b64(const unsigned char* p) {
    const unsigned char* a = p; auto s = emu_exchange(&a, sizeof(a));
    const int lane = threadIdx.x & 63, g0 = lane & ~15, i = lane & 15; s16x4 r;
    for (int q = 0; q < 4; ++q) { const unsigned char* sp; memcpy(&sp, s[g0 + 4 * q + (i >> 2)], sizeof(sp)); short v; memcpy(&v, sp + 2 * (i & 3), 2); r[q] = v; }
    return r;
}
static inline int readlane_i(int v, int i) { return emu_shfl(v, i); }
static inline float fast_exp2(float x) { return exp2f(x); }
#else
typedef short v4i16_t __attribute__((ext_vector_type(4)));
__device__ __forceinline__ s16x4 lds_tr16_b64(PG8_LAS const unsigned char* p) { return __builtin_bit_cast(s16x4, __builtin_amdgcn_ds_read_tr16_b64_v4i16((PG8_LAS v4i16_t*)p)); }
__device__ __forceinline__ int readlane_i(int v, int i) { return __builtin_amdgcn_readlane(v, i); }
__device__ __forceinline__ float fast_exp2(float x) { return __builtin_amdgcn_exp2f(x); }
#endif
#ifdef CPU_TEST
static inline f32x16 zero16() { f32x16 r; for (int i = 0; i < 16; ++i) r[i] = 0.f; return r; }
#else
__device__ __forceinline__ f32x16 zero16() { float z = 0.f; asm volatile("" : "+v"(z)); f32x16 r;
#pragma unroll
    for (int i = 0; i < 16; ++i) r[i] = z;
    return r; }
#endif
__device__ __forceinline__ unsigned pack_bf16(float lo, float hi) { return pg8::cvt_pk_bf16(lo, hi); }
__device__ __forceinline__ float bf_lo(unsigned u) { return __builtin_bit_cast(float, u << 16); }
__device__ __forceinline__ float bf_hi(unsigned u) { return __builtin_bit_cast(float, u & 0xffff0000u); }

__device__ __forceinline__ void nsa_load_tile_bf16(LDSP dst, const bf16_t* src, int src_ld, int nvalid, int tid) {
    const int key = tid >> 3, ch = tid & 7;
    pg8::u32x4 v = {0u, 0u, 0u, 0u};
    if (key < nvalid) v = *(const pg8::u32x4*)(src + (size_t)key * src_ld + ch * 8);
    *(PG8_LAS pg8::u32x4*)(dst + (key * KSTR + ch * 8) * 2) = v;
}
__device__ __forceinline__ void nsa_load_tile_f32(LDSP dst, const float* src, int src_ld, int nvalid, int tid) {
    const int key = tid >> 3, ch = tid & 7;
    pg8::u32x4 v = {0u, 0u, 0u, 0u};
    if (key < nvalid) { const f32x4 a = *(const f32x4*)(src + (size_t)key * src_ld + ch * 8), b = *(const f32x4*)(src + (size_t)key * src_ld + ch * 8 + 4);
        v[0] = pack_bf16(a[0], a[1]); v[1] = pack_bf16(a[2], a[3]); v[2] = pack_bf16(b[0], b[1]); v[3] = pack_bf16(b[2], b[3]); }
    *(PG8_LAS pg8::u32x4*)(dst + (key * KSTR + ch * 8) * 2) = v;
}
__device__ __forceinline__ void nsa_qk(f32x16& p0, f32x16& p1, LDSP Kt, const bf16x8 (&q)[4], int rw, int hh) {
    p0 = zero16(); p1 = zero16();
#pragma unroll
    for (int s = 0; s < 4; ++s) {
        const bf16x8 a0 = *(PG8_LAS const bf16x8*)(Kt + (rw * KSTR + 16 * s + 8 * hh) * 2);
        const bf16x8 a1 = *(PG8_LAS const bf16x8*)(Kt + ((rw + 32) * KSTR + 16 * s + 8 * hh) * 2);
        p0 = __builtin_amdgcn_mfma_f32_32x32x16_bf16(a0, q[s], p0, 0, 0, 0);
        p1 = __builtin_amdgcn_mfma_f32_32x32x16_bf16(a1, q[s], p1, 0, 0, 0);
    }
}
__device__ __forceinline__ void nsa_pv(f32x16 (&o)[2], LDSP Vt, const f32x16& p0, const f32x16& p1, int lane) {
    const int G = lane >> 4, ig = lane & 15;
    LDSP vb = Vt + ((4 * (G >> 1) + (ig >> 2)) * KSTR + 16 * (G & 1) + 4 * (ig & 3)) * 2;
#pragma unroll
    for (int kh = 0; kh < 2; ++kh)
#pragma unroll
        for (int ks = 0; ks < 2; ++ks) {
            const f32x16& pp = kh ? p1 : p0;
            pg8::u32x4 pb;
            pb[0] = pack_bf16(pp[8 * ks + 0], pp[8 * ks + 1]); pb[1] = pack_bf16(pp[8 * ks + 2], pp[8 * ks + 3]);
            pb[2] = pack_bf16(pp[8 * ks + 4], pp[8 * ks + 5]); pb[3] = pack_bf16(pp[8 * ks + 6], pp[8 * ks + 7]);
            const bf16x8 bfrag = __builtin_bit_cast(bf16x8, pb);
#pragma unroll
            for (int e = 0; e < 2; ++e) {
                const s16x4 lo = lds_tr16_b64(vb + ((32 * kh + 16 * ks) * KSTR + 32 * e) * 2);
                const s16x4 hi = lds_tr16_b64(vb + ((32 * kh + 16 * ks + 8) * KSTR + 32 * e) * 2);
                const bf16x8 afrag = {lo[0], lo[1], lo[2], lo[3], hi[0], hi[1], hi[2], hi[3]};
                o[e] = __builtin_amdgcn_mfma_f32_32x32x16_bf16(afrag, bfrag, o[e], 0, 0, 0);
            }
        }
}
__device__ __forceinline__ int nsa_kl(int kh, int i, int hh) { return 32 * kh + (i & 3) + 8 * (i >> 2) + 4 * hh; }
__device__ __forceinline__ void nsa_online(f32x16& p0, f32x16& p1, int lo, int hi, int hh, float& m, float& l, f32x16 (&o)[2]) {
    const bool rowall = (lo <= 0 && hi >= 63), rownone = hi < lo;
    if (!__all(rowall || rownone)) {
        const unsigned span = (unsigned)(hi - lo);
#pragma unroll
        for (int i = 0; i < 16; ++i) { const int k0 = nsa_kl(0, i, hh), k1 = nsa_kl(1, i, hh);
            p0[i] = ((unsigned)(k0 - lo) <= span && !rownone) ? p0[i] : -3e30f; p1[i] = ((unsigned)(k1 - lo) <= span && !rownone) ? p1[i] : -3e30f; }
    }
    float a = fmaxf(fmaxf(p0[0], p0[1]), p1[0]), b2 = fmaxf(fmaxf(p0[2], p0[3]), p1[1]);
    a = fmaxf(fmaxf(a, p1[2]), p1[3]);
#pragma unroll
    for (int r = 4; r < 16; r += 4) { a = fmaxf(fmaxf(a, p0[r]), p0[r + 1]); b2 = fmaxf(fmaxf(b2, p0[r + 2]), p0[r + 3]); a = fmaxf(fmaxf(a, p1[r]), p1[r + 1]); b2 = fmaxf(fmaxf(b2, p1[r + 2]), p1[r + 3]); }
    float mx = rownone ? -3e30f : fmaxf(a, b2);
    mx = fmaxf(mx, __shfl_xor(mx, 32));
    const float mn = fmaxf(m, mx);
    const float c = (rownone ? -3e30f : 0.f) - mn;
    float sum = 0.f;
#pragma unroll
    for (int i = 0; i < 16; ++i) { p0[i] = fast_exp2(p0[i] + c); p1[i] = fast_exp2(p1[i] + c); sum += p0[i] + p1[i]; }
    if (__any(mn != m)) {
        const float alpha = fast_exp2(m - mn);
        l *= alpha;
#pragma unroll
        for (int i = 0; i < 16; ++i) { o[0][i] *= alpha; o[1][i] *= alpha; }
    }
    m = mn;
    l += sum;
}
constexpr int NSA_DBUF = 16384;
__device__ __forceinline__ void nsa_dma_rows(LDSP dst, const bf16_t* src, int row_stride, int w, int lane) {
    const int r = 8 * w + (lane >> 3), c = (lane & 7) ^ (r & 7);
    __builtin_amdgcn_global_load_lds((const unsigned*)(src + (size_t)r * row_stride + c * 8), (PG8_LAS unsigned*)(dst + w * 1024), 16, 0, 0);
}
__device__ __forceinline__ void nsa_dma_tile(LDSP dstK, LDSP dstV, const bf16_t* srcK, const bf16_t* srcV, int w, int lane) {
    const int r = 8 * w + (lane >> 3), c = (lane & 7) ^ (r & 7);
    __builtin_amdgcn_global_load_lds((const unsigned*)(srcK + r * 64 + c * 8), (PG8_LAS unsigned*)(dstK + w * 1024), 16, 0, 0);
    __builtin_amdgcn_global_load_lds((const unsigned*)(srcV + r * 64 + c * 8), (PG8_LAS unsigned*)(dstV + w * 1024), 16, 0, 0);
}
__device__ __forceinline__ void nsa_qk_swz(f32x16& p0, f32x16& p1, LDSP Kt, LDSP qpark, int rw, int hh) {
    p0 = zero16(); p1 = zero16();
#pragma unroll
    for (int s = 0; s < 4; ++s) {
        const int off = rw * 128 + (((2 * s + hh) ^ (rw & 7)) * 16);
        const bf16x8 a0 = *(PG8_LAS const bf16x8*)(Kt + off);
        const bf16x8 a1 = *(PG8_LAS const bf16x8*)(Kt + off + 32 * 128);
        const bf16x8 qs = *(PG8_LAS const bf16x8*)(qpark + s * 8192);
        p0 = __builtin_amdgcn_mfma_f32_32x32x16_bf16(a0, qs, p0, 0, 0, 0);
        p1 = __builtin_amdgcn_mfma_f32_32x32x16_bf16(a1, qs, p1, 0, 0, 0);
    }
}
__device__ __forceinline__ void nsa_pv_swz(f32x16 (&o)[2], LDSP Vt, const f32x16& p0, const f32x16& p1, int lane) {
    const int G = lane >> 4, ig = lane & 15, rowb = 4 * (G >> 1) + (ig >> 2), x = rowb & 7, cb = 2 * (G & 1) + ((ig & 3) >> 1), half = ig & 1;
    LDSP vb0 = Vt + rowb * 128 + (((cb ^ (x & 3)) | (0 ^ (x & 4))) * 16) + half * 8;
    LDSP vb1 = Vt + rowb * 128 + (((cb ^ (x & 3)) | (4 ^ (x & 4))) * 16) + half * 8;
#pragma unroll
    for (int kh = 0; kh < 2; ++kh)
#pragma unroll
        for (int ks = 0; ks < 2; ++ks) {
            const f32x16& pp = kh ? p1 : p0;
            pg8::u32x4 pb;
            pb[0] = pack_bf16(pp[8 * ks + 0], pp[8 * ks + 1]); pb[1] = pack_bf16(pp[8 * ks + 2], pp[8 * ks + 3]);
            pb[2] = pack_bf16(pp[8 * ks + 4], pp[8 * ks + 5]); pb[3] = pack_bf16(pp[8 * ks + 6], pp[8 * ks + 7]);
            const bf16x8 bfrag = __builtin_bit_cast(bf16x8, pb);
#pragma unroll
            for (int e = 0; e < 2; ++e) {
                LDSP vb = e ? vb1 : vb0;
                const s16x4 lo = lds_tr16_b64(vb + (32 * kh + 16 * ks) * 128);
                const s16x4 hi = lds_tr16_b64(vb + (32 * kh + 16 * ks + 8) * 128);
                const bf16x8 afrag = {lo[0], lo[1], lo[2], lo[3], hi[0], hi[1], hi[2], hi[3]};
                o[e] = __builtin_amdgcn_mfma_f32_32x32x16_bf16(afrag, bfrag, o[e], 0, 0, 0);
            }
        }
}
#ifdef CPU_TEST
#define NSA_DMA_WAIT() ((void)0)
#else
#define NSA_DMA_WAIT() asm volatile("s_waitcnt vmcnt(0)" ::: "memory")
#endif
template <bool SAMPLE> __device__ __forceinline__ void nsa_load_sel(const P& p, int l, int b, int g, int j, LDSP Kt, LDSP Vt, int tid) {
    if (!SAMPLE) {
        nsa_load_tile_bf16(Kt, p.KSB + ((size_t)g * MPAD + (size_t)b * SEQ + 64 * j) * 64, 64, 64, tid);
        nsa_load_tile_bf16(Vt, p.VSB + ((size_t)g * MPAD + (size_t)b * SEQ + 64 * j) * 64, 64, 64, tid);
    } else {
        const int pos0 = 64 * j;
        if (pos0 < PAST_LEN) {
            const int pg = p.page_table[b * N_PAGES + pos0 / PAGE];
            const float* base = p.cache_kv + (((size_t)l * N_POOL + pg) * PAGE + pos0 % PAGE) * 512 + g * 64;
            nsa_load_tile_f32(Kt, base + 2 * 128, 512, 64, tid); nsa_load_tile_f32(Vt, base + 3 * 128, 512, 64, tid);
        } else {
            const float* base = p.out + O_SKV + (((size_t)l * DEC_BATCH + b) * DEC_SEQ) * 512 + g * 64;
            nsa_load_tile_f32(Kt, base + 2 * 128, 512, DEC_SEQ, tid); nsa_load_tile_f32(Vt, base + 3 * 128, 512, DEC_SEQ, tid);
        }
    }
}
template <bool SAMPLE> __device__ __forceinline__ void nsa_load_win(const P& p, int l, int b, int g, int j, LDSP Kt, LDSP Vt, int tid) {
    if (!SAMPLE) {
        nsa_load_tile_bf16(Kt, p.KWB + ((size_t)g * MPAD + (size_t)b * SEQ + 64 * j) * 64, 64, 64, tid);
        nsa_load_tile_bf16(Vt, p.VWB + ((size_t)g * MPAD + (size_t)b * SEQ + 64 * j) * 64, 64, 64, tid);
    } else {
        const int pos0 = 64 * j;
        if (pos0 < PAST_LEN) {
            const float* base = p.cache_win + (((size_t)l * DEC_BATCH + b) * WB + (pos0 - (PAST_LEN - WB))) * 256 + g * 64;
            nsa_load_tile_f32(Kt, base, 256, 64, tid); nsa_load_tile_f32(Vt, base + 128, 256, 64, tid);
        } else {
            const float* base = p.out + O_SWIN + (((size_t)l * DEC_BATCH + b) * WB + (WB - DEC_SEQ)) * 256 + g * 64;
            nsa_load_tile_f32(Kt, base, 256, DEC_SEQ, tid); nsa_load_tile_f32(Vt, base + 128, 256, DEC_SEQ, tid);
        }
    }
}
constexpr int NSA_NW = 6, NSA_WREG = 2 * 64 * KSTR * 2;
static_assert(3 * NSA_WREG <= NSA_MASK_OFF && NSA_MASK_OFF + 64 * 8 <= 67584 && 67584 + 3 * NSA_WREG <= 131072 && NSA_NW * 34 * 256 <= NSA_MASK_OFF, "worker buffers");
#ifdef CPU_TEST
#define NSA_WAVE_FENCE() emu_wave_sync(emu_wave())
#else
#define NSA_WAVE_FENCE() __builtin_amdgcn_wave_barrier()
#endif
__device__ __forceinline__ void nsa_load_wave_f32(LDSP Kt, const float* src, int ld, int nvalid, int lane) {
    const int key0 = lane >> 3, ch = lane & 7;
    const unsigned boff = ((unsigned)key0 * (unsigned)ld + (unsigned)ch * 8u) * 4u;
    const char* sb = (const char*)src;
    LDSP d = Kt + (key0 * KSTR + ch * 8) * 2;
#pragma unroll 2
    for (int c = 0; c < 8; ++c) {
        pg8::u32x4 k = {0u, 0u, 0u, 0u}, v = {0u, 0u, 0u, 0u};
        if (key0 + 8 * c < nvalid) { const char* q = sb + boff;
            const f32x4 k0 = *(const f32x4*)q, k1 = *(const f32x4*)(q + 16), v0 = *(const f32x4*)(q + 512), v1 = *(const f32x4*)(q + 528);
            k[0] = pack_bf16(k0[0], k0[1]); k[1] = pack_bf16(k0[2], k0[3]); k[2] = pack_bf16(k1[0], k1[1]); k[3] = pack_bf16(k1[2], k1[3]);
            v[0] = pack_bf16(v0[0], v0[1]); v[1] = pack_bf16(v0[2], v0[3]); v[2] = pack_bf16(v1[0], v1[1]); v[3] = pack_bf16(v1[2], v1[3]); }
        *(PG8_LAS pg8::u32x4*)(d + c * 8 * KSTR * 2) = k; *(PG8_LAS pg8::u32x4*)(d + 64 * KSTR * 2 + c * 8 * KSTR * 2) = v;
        sb += (size_t)8 * ld * 4;
    }
}
template <bool SEL> __device__ __forceinline__ void nsa_load_wave(const P& p, int l, int b, int g, int j, LDSP Kt, LDSP Vt, int lane) {
    NSA_WAVE_FENCE();
    const int pos0 = 64 * j; const bool past = pos0 < PAST_LEN;
    const float* src;
    if (SEL) { const int pg = p.page_table[b * N_PAGES + (past ? pos0 / PAGE : 0)];
        src = past ? p.cache_kv + (((size_t)l * N_POOL + pg) * PAGE + pos0 % PAGE) * 512 + g * 64 + 2 * 128 : p.out + O_SKV + (((size_t)l * DEC_BATCH + b) * DEC_SEQ) * 512 + g * 64 + 2 * 128; }
    else src = past ? p.cache_win + (((size_t)l * DEC_BATCH + b) * WB + (pos0 - (PAST_LEN - WB))) * 256 + g * 64 : p.out + O_SWIN + (((size_t)l * DEC_BATCH + b) * WB + (WB - DEC_SEQ)) * 256 + g * 64;
    nsa_load_wave_f32(Kt, src, SEL ? 512 : 256, past ? 64 : DEC_SEQ, lane);
    NSA_WAVE_FENCE();
}
__device__ __forceinline__ void nsa_combine(LDSP lds, int ws, int lane, float& m, float& l, f32x16 (&o)[2]) {
    PG8_LAS float* cb = (PG8_LAS float*)lds;
    __syncthreads();
    if (ws < NSA_NW) { PG8_LAS float* c = cb + ws * 34 * 64 + lane; c[0] = m; c[64] = l;
#pragma unroll
        for (int i = 0; i < 16; ++i) { c[(2 + i) * 64] = o[0][i]; c[(18 + i) * 64] = o[1][i]; } }
    __syncthreads();
    float M = -1e30f;
#pragma unroll
    for (int v = 0; v < NSA_NW; ++v) M = fmaxf(M, cb[v * 34 * 64 + lane]);
    float L = 0.f; o[0] = zero16(); o[1] = zero16();
#pragma unroll 1
    for (int v = 0; v < NSA_NW; ++v) { const PG8_LAS float* c = cb + v * 34 * 64 + lane; const float al = fast_exp2(c[0] - M); L += c[64] * al;
#pragma unroll
        for (int i = 0; i < 16; ++i) { o[0][i] += c[(2 + i) * 64] * al; o[1][i] += c[(18 + i) * 64] * al; } }
    m = M; l = L;
    __syncthreads();
}
template <bool SAMPLE> __device__ __forceinline__ void ph_nsa_t(const P& p, int l, LDSP lds) {
    constexpr int NQT = SEQ / 64, NITEM = SAMPLE ? DEC_BATCH * NKV : BATCH * NKV * NQT, NC = SAMPLE ? NCS : NCP, NTC = (NC + 63) / 64;
    static_assert(WB == WIN && PAST_LEN % 64 == 0 && PAST_LEN >= WIN, "sample window tiling");
    const int tid = opaque_tid(), w = tid >> 6, lane = tid & 63, rw = lane & 31, hh = lane >> 5;
    LDSP Kt = lds + NSA_K_OFF; LDSP Vt = lds + NSA_V_OFF;
    PG8_LAS float* impA = (PG8_LAS float*)(lds + NSA_IMPA_OFF); PG8_LAS float* impB = (PG8_LAS float*)(lds + NSA_IMPB_OFF);
    PG8_LAS unsigned long long* selmask = (PG8_LAS unsigned long long*)(lds + NSA_MASK_OFF);
    for (int it2 = blockIdx.x; it2 < NITEM; it2 += gridDim.x) {
        const int item = SAMPLE ? it2 : ((it2 & 1) ? NITEM - 1 - (it2 >> 1) : (it2 >> 1));
        int qt, b, g;
        if (SAMPLE) { b = item / NKV; g = item % NKV; qt = PAST_LEN / 64; }
        else { qt = NQT - 1 - item / (BATCH * NKV); const int bg = item % (BATCH * NKV); b = bg / NKV; g = bg % NKV; }
        const int q0 = SAMPLE ? PAST_LEN : 64 * qt;
        const int tl = SAMPLE ? (rw & 3) : 8 * w + (rw & 7), r = SAMPLE ? ((rw >> 2) & 3) : (rw >> 3);
        const int head = 4 * g + r, qpos = q0 + tl, tok = SAMPLE ? NPT + b * DEC_SEQ + tl : b * SEQ + qpos, seq = SAMPLE ? BATCH + b : b;
        const int cur = qpos >> 6;
        bf16x8 qc[4], qr[4];
#pragma unroll
        for (int s = 0; s < 4; ++s) { qc[s] = *(const bf16x8*)(p.QCB + (size_t)tok * 512 + head * 64 + 16 * s + 8 * hh); if (SAMPLE) qr[s] = *(const bf16x8*)(p.QRB + (size_t)tok * 512 + head * 64 + 16 * s + 8 * hh); }
        const float* ngp = p.Z + (size_t)tok * INW + ZNG + head * 3;
        const float g0 = sigmoidf_(ngp[0]);
        f32x16 o[2], p0, p1;
        unsigned outp[2][8];
        const int nmax = qpos >= 31 ? (qpos - 31) >> 4 : -1;
        const bf16_t* kcb = p.KCB + (kc_base(seq) * 2 + g) * 64; const bf16_t* vcb = p.VCB + (kc_base(seq) * 2 + g) * 64;
        LDSP qpark = lds + NSA_QPARK_OFF + tid * 16;
#pragma unroll
        for (int s = 0; s < 4; ++s) *(PG8_LAS bf16x8*)(qpark + s * 8192) = qc[s];
        float m = -1e30f, lsum = 0.f, inv_lc = 0.f;
        o[0] = zero16(); o[1] = zero16();
        nsa_dma_rows(lds, kcb, 128, w, lane);
        for (int st = 0, buf = 0; st < 2 * NTC; ++st, buf ^= 1) {
            LDSP Kc = lds + buf * NSA_DBUF; LDSP Vc = Kc + 8192;
            NSA_DMA_WAIT(); __syncthreads();
            if (st + 1 < 2 * NTC) { const int cn = (st + 1) % NTC; LDSP Kn = lds + (buf ^ 1) * NSA_DBUF;
                nsa_dma_rows(Kn, kcb + (size_t)cn * 64 * 128, 128, w, lane);
                if (st + 1 >= NTC) nsa_dma_rows(Kn + 8192, vcb + (size_t)cn * 64 * 128, 128, w, lane); }
            const int c = st % NTC;
            nsa_qk_swz(p0, p1, Kc, qpark, rw, hh);
            int hi = nmax - 64 * c; if (hi > NC - 1 - 64 * c) hi = NC - 1 - 64 * c;
            if (st < NTC) {
                nsa_online(p0, p1, 0, hi, hh, m, lsum, o);
                if (st == NTC - 1) { lsum += __shfl_xor(lsum, 32); inv_lc = 1.f / fmaxf(lsum, TINY); }
            } else {
#pragma unroll
                for (int i = 0; i < 16; ++i) { const int k0 = nsa_kl(0, i, hh), k1 = nsa_kl(1, i, hh);
                    p0[i] = k0 <= hi ? fast_exp2(p0[i] - m) : 0.f; p1[i] = k1 <= hi ? fast_exp2(p1[i] - m) : 0.f; }
#pragma unroll
                for (int kh = 0; kh < 2; ++kh)
#pragma unroll
                    for (int q4 = 0; q4 < 4; ++q4) {
                        const f32x16& pp = kh ? p1 : p0;
                        float a = (pp[4 * q4] + pp[4 * q4 + 1] + pp[4 * q4 + 2] + 0.5f * pp[4 * q4 + 3]) * inv_lc, bb = 0.5f * pp[4 * q4 + 3] * inv_lc;
                        if (SAMPLE) { a += __shfl_xor(a, 4); a += __shfl_xor(a, 8); bb += __shfl_xor(bb, 4); bb += __shfl_xor(bb, 8); }
                        else { a += __shfl_xor(a, 8); a += __shfl_xor(a, 16); bb += __shfl_xor(bb, 8); bb += __shfl_xor(bb, 16); }
                        const int jp = 16 * c + 8 * kh + 2 * q4 + hh;
                        if (rw < (SAMPLE ? 4 : 8) && (!SAMPLE || w == 0)) { impA[tl * 65 + jp] = a; impB[tl * 65 + jp + 1] = bb; }
                    }
                nsa_pv_swz(o, Vc, p0, p1, lane);
            }
        }
#pragma unroll
        for (int e = 0; e < 2; ++e)
#pragma unroll
            for (int i = 0; i < 8; ++i) outp[e][i] = pack_bf16(o[e][2 * i] * (g0 * inv_lc), o[e][2 * i + 1] * (g0 * inv_lc));
        __syncthreads();
        if (!SAMPLE || w == 0) {
            for (int t8 = 0; t8 < (SAMPLE ? DEC_SEQ : 8); ++t8) {
                const int tt = SAMPLE ? t8 : 8 * w + t8, j = lane;
                float sc;
                if (j > cur) sc = -1.f; else if (j == 0 || j == cur || j == cur - 1) sc = 1e9f; else sc = impA[tt * 65 + j] + impB[tt * 65 + j];
                int rank = 0; const int sci = __builtin_bit_cast(int, sc);
                for (int i = 0; i < 64; ++i) { const float si = __builtin_bit_cast(float, readlane_i(sci, i)); rank += (si > sc || (si == sc && i < j)) ? 1 : 0; }
                const unsigned long long msk = __ballot(rank < SELTOP);
                if (lane == 0) selmask[tt] = msk;
            }
        }
        __syncthreads();
        unsigned long long un = selmask[SAMPLE ? (lane & 3) : lane];
#pragma unroll
        for (int s = 32; s >= 1; s >>= 1) { unsigned lo32 = (unsigned)un, hi32 = (unsigned)(un >> 32); lo32 |= __shfl_xor(lo32, s); hi32 |= __shfl_xor(hi32, s); un = ((unsigned long long)hi32 << 32) | lo32; }
        if (SAMPLE) un = ((unsigned long long)(unsigned)__builtin_amdgcn_readfirstlane((int)(un >> 32)) << 32) | (unsigned)__builtin_amdgcn_readfirstlane((int)un);
        if (!SAMPLE) {
#pragma unroll
            for (int s = 0; s < 4; ++s) *(PG8_LAS bf16x8*)(qpark + s * 8192) = *(const bf16x8*)(p.QRB + (size_t)tok * 512 + head * 64 + 16 * s + 8 * hh);
        }
        m = -1e30f; lsum = 0.f;
        o[0] = zero16(); o[1] = zero16();
        if (SAMPLE) {
        const int ws = __builtin_amdgcn_readfirstlane(w);
        LDSP Kw = lds + (ws < 3 ? ws * NSA_WREG : 67584 + (ws - 3) * NSA_WREG); LDSP Vw = Kw + 64 * KSTR * 2;
        int kk = 0;
        for (int j = 0; j <= cur; ++j) {
            if (!((un >> j) & 1ull)) continue;
            const bool mine = (kk % NSA_NW) == ws; ++kk;
            if (!mine) continue;
            nsa_load_wave<true>(p, l, b, g, j, Kw, Vw, lane);
            nsa_qk(p0, p1, Kw, qr, rw, hh);
            int hi = qpos - 64 * j; if (hi > 63) hi = 63; if (!((selmask[tl] >> j) & 1ull)) hi = -1;
            nsa_online(p0, p1, 0, hi, hh, m, lsum, o);
            nsa_pv(o, Vw, p0, p1, lane);
        }
        nsa_combine(lds, ws, lane, m, lsum, o);
        } else {
            unsigned long long rem = un & ((cur >= 63) ? ~0ull : ((2ull << cur) - 1ull));
            int j = rem ? __builtin_ctzll(rem) : -1, buf = 0;
            const bf16_t* ks0 = p.KSB + ((size_t)g * MPAD + (size_t)b * SEQ) * 64; const bf16_t* vs0 = p.VSB + ((size_t)g * MPAD + (size_t)b * SEQ) * 64;
            __syncthreads();
            if (j >= 0) nsa_dma_tile(lds, lds + 8192, ks0 + (size_t)j * 4096, vs0 + (size_t)j * 4096, w, lane);
            while (j >= 0) {
                LDSP Kc = lds + buf * NSA_DBUF; LDSP Vc = Kc + 8192;
                NSA_DMA_WAIT(); __syncthreads();
                rem &= rem - 1ull; const int jn = rem ? __builtin_ctzll(rem) : -1;
                if (jn >= 0) nsa_dma_tile(lds + (buf ^ 1) * NSA_DBUF, lds + (buf ^ 1) * NSA_DBUF + 8192, ks0 + (size_t)jn * 4096, vs0 + (size_t)jn * 4096, w, lane);
                nsa_qk_swz(p0, p1, Kc, qpark, rw, hh);
                int hi = qpos - 64 * j; if (hi > 63) hi = 63; if (!((selmask[tl] >> j) & 1ull)) hi = -1;
                nsa_online(p0, p1, 0, hi, hh, m, lsum, o);
                nsa_pv_swz(o, Vc, p0, p1, lane);
                j = jn; buf ^= 1;
            }
        }
        lsum += __shfl_xor(lsum, 32);
        { const float sc = sigmoidf_(ngp[1]) / fmaxf(lsum, TINY);
#pragma unroll
          for (int e = 0; e < 2; ++e)
#pragma unroll
            for (int i = 0; i < 8; ++i) outp[e][i] = pack_bf16(bf_lo(outp[e][i]) + o[e][2 * i] * sc, bf_hi(outp[e][i]) + o[e][2 * i + 1] * sc); }
        m = -1e30f; lsum = 0.f;
        o[0] = zero16(); o[1] = zero16();
        if (SAMPLE) {
        const int ws = __builtin_amdgcn_readfirstlane(w);
        LDSP Kw = lds + (ws < 3 ? ws * NSA_WREG : 67584 + (ws - 3) * NSA_WREG); LDSP Vw = Kw + 64 * KSTR * 2;
        const int jw0 = (q0 >= WIN ? (q0 - (WIN - 1)) >> 6 : 0);
        for (int j = jw0; j <= cur; ++j) {
            if (((j - jw0) % NSA_NW) != ws) continue;
            nsa_load_wave<false>(p, l, b, g, j, Kw, Vw, lane);
            nsa_qk(p0, p1, Kw, qr, rw, hh);
            int hi = qpos - 64 * j; if (hi > 63) hi = 63;
            int lo = qpos - (WIN - 1) - 64 * j; if (lo < 0) lo = 0;
            nsa_online(p0, p1, lo, hi, hh, m, lsum, o);
            nsa_pv(o, Vw, p0, p1, lane);
        }
        nsa_combine(lds, ws, lane, m, lsum, o);
        } else {
            int j = (q0 >= WIN ? (q0 - (WIN - 1)) >> 6 : 0), buf = 0;
            const bf16_t* kw0 = p.KWB + ((size_t)g * MPAD + (size_t)b * SEQ) * 64; const bf16_t* vw0 = p.VWB + ((size_t)g * MPAD + (size_t)b * SEQ) * 64;
            __syncthreads();
            nsa_dma_tile(lds, lds + 8192, kw0 + (size_t)j * 4096, vw0 + (size_t)j * 4096, w, lane);
            for (; j <= cur; ++j) {
                LDSP Kc = lds + buf * NSA_DBUF; LDSP Vc = Kc + 8192;
                NSA_DMA_WAIT(); __syncthreads();
                if (j + 1 <= cur) nsa_dma_tile(lds + (buf ^ 1) * NSA_DBUF, lds + (buf ^ 1) * NSA_DBUF + 8192, kw0 + (size_t)(j + 1) * 4096, vw0 + (size_t)(j + 1) * 4096, w, lane);
                nsa_qk_swz(p0, p1, Kc, qpark, rw, hh);
                int hi = qpos - 64 * j; if (hi > 63) hi = 63;
                int lo = qpos - (WIN - 1) - 64 * j; if (lo < 0) lo = 0;
                nsa_online(p0, p1, lo, hi, hh, m, lsum, o);
                nsa_pv_swz(o, Vc, p0, p1, lane);
                buf ^= 1;
            }
        }
        lsum += __shfl_xor(lsum, 32);
        { const float sc = sigmoidf_(ngp[2]) / fmaxf(lsum, TINY);
#pragma unroll
          for (int e = 0; e < 2; ++e)
#pragma unroll
            for (int i = 0; i < 8; ++i) outp[e][i] = pack_bf16(bf_lo(outp[e][i]) + o[e][2 * i] * sc, bf_hi(outp[e][i]) + o[e][2 * i + 1] * sc); }
        if (!SAMPLE || (w == 0 && rw < 16)) {
            bf16_t* hb = p.HBB + (size_t)tok * 512 + head * 64;
#pragma unroll
            for (int e = 0; e < 2; ++e)
#pragma unroll
                for (int q4 = 0; q4 < 4; ++q4) {
                    uint2 v; v.x = outp[e][2 * q4]; v.y = outp[e][2 * q4 + 1];
                    *(uint2*)(hb + 32 * e + 8 * q4 + 4 * hh) = v;
                }
        }
        __syncthreads();
    }
}
__device__ __forceinline__ void ph_nsa_prompt(const P& p, int l, LDSP lds) { ph_nsa_t<false>(p, l, lds); }
__device__ __forceinline__ void ph_nsa_sample(const P& p, int l, LDSP lds) { ph_nsa_t<true>(p, l, lds); }


typedef unsigned u32x2 __attribute__((ext_vector_type(2)));
#ifdef CPU_TEST
#define MFMA_DRAIN() ((void)0)
#define VMEM_DRAIN() ((void)0)
#else
#define VMEM_DRAIN() asm volatile("s_waitcnt vmcnt(0)" ::: "memory")
#define MFMA_DRAIN() asm volatile("s_nop 15\n\ts_nop 15" ::: "memory")
#endif
constexpr int TS = 136;
constexpr int NCH = SEQ / 64, NMI = BATCH * MH * NCH;
constexpr int ML_C_OFF = 0, ML_K_OFF = 64 * TS * 2, ML_V_OFF = 2 * 64 * TS * 2, ML_Q_OFF = 3 * 64 * TS * 2, ML_CS_OFF = 4 * 64 * TS * 2,
              ML_VEC_OFF = ML_CS_OFF + 128 * TS * 2, ML_LDS_END = ML_VEC_OFF + 4096;
constexpr int M3_CS_OFF = 0, M3_V_OFF = 128 * TS * 2, M3_Q_OFF = M3_V_OFF + 64 * TS * 2, M3_K_OFF = M3_Q_OFF + 64 * TS * 2, M3_VEC_OFF = M3_K_OFF + 64 * TS * 2;
static_assert(M3_VEC_OFF + 4096 <= ML_LDS_END, "M3 LDS map");
__device__ __forceinline__ int tr_lane_off(int lane, bool natural, int stride) {
    const int G = lane >> 4, ig = lane & 15;
    return (((ig >> 2) + (natural ? 8 : 4) * (G >> 1)) * stride + 16 * (G & 1) + 4 * (ig & 3)) * 2;
}
__device__ __forceinline__ bf16x8 tr_frag(LDSP base_lane, int r0, int c0, bool natural, int stride) {
    const s16x4 lo = lds_tr16_b64(base_lane + (r0 * stride + c0) * 2);
    const s16x4 hi = lds_tr16_b64(base_lane + ((r0 + (natural ? 4 : 8)) * stride + c0) * 2);
    return (bf16x8){lo[0], lo[1], lo[2], lo[3], hi[0], hi[1], hi[2], hi[3]};
}
__device__ __forceinline__ float wave_incl_scan_add(float v, int lane) {
#pragma unroll
    for (int s = 1; s < 64; s <<= 1) { const float o = __shfl_up(v, s); if (lane >= s) v += o; }
    return v;
}
__device__ __forceinline__ float wave_incl_scan_max(float v, int lane) {
#pragma unroll
    for (int s = 1; s < 64; s <<= 1) { const float o = __shfl_up(v, s); if (lane >= s) v = fmaxf(v, o); }
    return v;
}
template <int DUP1> __device__ __forceinline__ void ph_ml1_t(const P& p, int l, LDSP lds, int first = -1, int step = 0) {
    if (first < 0) { first = blockIdx.x; step = gridDim.x; }
    const int tid = opaque_tid(), w = tid >> 6, lane = tid & 63, rw = lane & 31, hh = lane >> 5;
    LDSP Ct = lds + ML_C_OFF; LDSP Kt = lds + ML_K_OFF; LDSP Vt = lds + ML_V_OFF;
    PG8_LAS float* vec = (PG8_LAS float*)(lds + ML_VEC_OFF);
    for (int item = first; item < NMI; item += step) {
        const int c = item % NCH, h = (item / NCH) % MH, b = item / (NCH * MH);
        const int tok0 = b * SEQ + 64 * c;
        __syncthreads();
        {
            const int t = tid >> 3, c0 = (tid & 7) * 16;
#pragma unroll
            for (int cc = 0; cc < 16; cc += 4) {
                const int col = h * MHD + c0 + cc;
                f32x4 y = *(const f32x4*)(p.conv_b + l * MW + col);
#pragma unroll
                for (int j = 0; j < 4; ++j) {
                    const int tt = 64 * c + t + j - 3;
                    if (tt >= 0) { const f32x4 u = *(const f32x4*)(p.Z + (size_t)(b * SEQ + tt) * INW + ZU + col); const f32x4 wj = *(const f32x4*)(p.conv_w + ((size_t)l * 4 + j) * MW + col); y += u * wj; }
                }
                uint2 o; o.x = pack_bf16(siluf_(y[0]), siluf_(y[1])); o.y = pack_bf16(siluf_(y[2]), siluf_(y[3]));
                *(PG8_LAS u32x2*)(Ct + (t * TS + c0 + cc) * 2) = (u32x2){o.x, o.y};
                const f32x4 vv = *(const f32x4*)(p.Z + (size_t)(tok0 + t) * INW + ZV + col);
                uint2 ov; ov.x = pack_bf16(vv[0], vv[1]); ov.y = pack_bf16(vv[2], vv[3]);
                *(PG8_LAS u32x2*)(Vt + (t * TS + c0 + cc) * 2) = (u32x2){ov.x, ov.y};
            }
        }
        if (w == 0) {
            const float ig = p.IG[(size_t)(tok0 + lane) * 4 + h], lf = p.LF[(size_t)(tok0 + lane) * 4 + h];
            const float F = wave_incl_scan_add(lf, lane), a = ig - F;
            float A = a;
#pragma unroll
            for (int s = 32; s >= 1; s >>= 1) A = fmaxf(A, __shfl_xor(A, s));
            vec[lane] = F; vec[64 + lane] = a; vec[128 + lane] = expf(a - A);
            if (lane == 63) { vec[193] = F; vec[192] = A; }
        }
        __syncthreads();
        {
            const int eb = w & 3, tb = w >> 2;
            f32x16 aq, ak;
            aq = zero16(); ak = zero16();
            const bf16_t* wq = p.WMQ_T + (((size_t)l * MH + h) * MHD + 32 * eb + rw) * MHD;
            const bf16_t* wk = p.WMK_T + (((size_t)l * MH + h) * MHD + 32 * eb + rw) * MHD;
#pragma unroll
            for (int ds = 0; ds < 8; ++ds) {
                const bf16x8 bc = *(PG8_LAS const bf16x8*)(Ct + ((32 * tb + rw) * TS + 16 * ds + 8 * hh) * 2);
                const bf16x8 fq = *(const bf16x8*)(wq + 16 * ds + 8 * hh), fk = *(const bf16x8*)(wk + 16 * ds + 8 * hh);
                VMEM_DRAIN();
                aq = __builtin_amdgcn_mfma_f32_32x32x16_bf16(fq, bc, aq, 0, 0, 0);
                ak = __builtin_amdgcn_mfma_f32_32x32x16_bf16(fk, bc, ak, 0, 0, 0);
            }
            const int t = 32 * tb + rw; const float ws = vec[128 + t];
            bf16_t* qg = p.QMB + (size_t)DUP1 * MPAD * MW + (size_t)(tok0 + t) * MW + h * MHD + 32 * eb; bf16_t* kg = p.KMB + (size_t)DUP1 * MPAD * MW + (size_t)(tok0 + t) * MW + h * MHD + 32 * eb;
#pragma unroll
            for (int q4 = 0; q4 < 4; ++q4) {
                uint2 vq, vk, vkw; const float sc = 0.08838834764831845f;
                vq.x = pack_bf16(aq[4 * q4], aq[4 * q4 + 1]); vq.y = pack_bf16(aq[4 * q4 + 2], aq[4 * q4 + 3]);
                vk.x = pack_bf16(ak[4 * q4] * sc, ak[4 * q4 + 1] * sc); vk.y = pack_bf16(ak[4 * q4 + 2] * sc, ak[4 * q4 + 3] * sc);
                vkw.x = pack_bf16(ak[4 * q4] * sc * ws, ak[4 * q4 + 1] * sc * ws); vkw.y = pack_bf16(ak[4 * q4 + 2] * sc * ws, ak[4 * q4 + 3] * sc * ws);
                *(uint2*)(qg + 8 * q4 + 4 * hh) = vq; *(uint2*)(kg + 8 * q4 + 4 * hh) = vk;
                *(PG8_LAS u32x2*)(Kt + (t * TS + 32 * eb + 8 * q4 + 4 * hh) * 2) = (u32x2){vkw.x, vkw.y};
            }
        }
        __syncthreads();
        {
            LDSP kb = Kt + tr_lane_off(lane, true, TS); LDSP vb = Vt + tr_lane_off(lane, true, TS);
            float* dc = p.DC + (size_t)DUP1 * NMI * MHD * MHD + (size_t)item * MHD * MHD;
#pragma unroll
            for (int tt = 0; tt < 2; ++tt) {
                const int tile = 2 * w + tt, db = tile >> 2, eb = tile & 3;
                f32x16 acc;
                acc = zero16();
#pragma unroll
                for (int ss = 0; ss < 4; ++ss) {
                    const bf16x8 fa = tr_frag(kb, 16 * ss, 32 * db, true, TS), fb = tr_frag(vb, 16 * ss, 32 * eb, true, TS);
                    acc = __builtin_amdgcn_mfma_f32_32x32x16_bf16(fa, fb, acc, 0, 0, 0);
                }
#pragma unroll
                for (int i = 0; i < 16; ++i) dc[(size_t)(32 * db + (i & 3) + 8 * (i >> 2) + 4 * hh) * MHD + 32 * eb + rw] = acc[i];
            }
            if (tid < MHD) { float s = 0.f; for (int t = 0; t < 64; ++t) s += bf2f(*(PG8_LAS const bf16_t*)(Kt + (t * TS + tid) * 2)); p.DN[(size_t)DUP1 * NMI * MHD + (size_t)item * MHD + tid] = s; }
            if (tid == 0) { p.GSUM[(size_t)DUP1 * NMI * 2 + (size_t)item * 2] = vec[193]; p.GSUM[(size_t)DUP1 * NMI * 2 + (size_t)item * 2 + 1] = vec[193] + vec[192]; }
        }
    }
}
__device__ __forceinline__ void ph_ml2(const P& p, int l, LDSP lds_unused) {
    constexpr int PER = MHD * MHD / 4 + MHD / 4, NWT = BATCH * MH * PER / 64;
    static_assert((BATCH * MH * PER) % 64 == 0, "ml2 wave tasks");
    const int tid = opaque_tid(), lane = tid & 63, wv = tid >> 6;
    for (int wt = blockIdx.x + gridDim.x * wv; wt < NWT; wt += gridDim.x * 8) {
        const int it = wt * 64 + lane, bh = it / PER, e4 = it % PER;
        const bool isn = e4 >= MHD * MHD / 4;
        const int e = e4 % MHD, d4 = (e4 / MHD) * 4;
        const int noff = (e4 - MHD * MHD / 4) * 4;
        f32x4 C = {0.f, 0.f, 0.f, 0.f}; float m = 0.f;
        auto load_d = [&](int c) -> f32x4 {
            const size_t item = (size_t)bh * NCH + c; f32x4 d;
            if (isn) d = *(const f32x4*)(p.DN + item * MHD + noff);
            else { const float* dc = p.DC + item * MHD * MHD + (size_t)d4 * MHD + e; d[0] = dc[0]; d[1] = dc[MHD]; d[2] = dc[2 * MHD]; d[3] = dc[3 * MHD]; }
            return d; };
        f32x4 dn0 = load_d(0), dn1 = load_d(NCH > 1 ? 1 : 0);
        for (int c = 0; c < NCH; ++c) {
            const size_t item = (size_t)bh * NCH + c;
            const f32x4 d = dn0; dn0 = dn1; if (c + 2 < NCH) dn1 = load_d(c + 2);
            if (isn) *(f32x4*)(p.NS + item * MHD + noff) = C;
            else { uint2 o; o.x = pack_bf16(C[0], C[1]); o.y = pack_bf16(C[2], C[3]); *(uint2*)(p.CSB + item * MHD * MHD + (size_t)e * MHD + d4) = o; }
            if (e4 == 0) p.MS[item] = m;
            const float Fl = p.GSUM[item * 2], ml = p.GSUM[item * 2 + 1];
            const float mn = fmaxf(m + Fl, ml), dec = expf(m + Fl - mn), sc = expf(ml - mn);
            C = C * dec + d * sc; m = mn;
        }
        const int b = bh / MH, h = bh % MH;
        if (isn) *(f32x4*)(p.out + O_PN + (((size_t)l * BATCH + b) * MH + h) * MHD + noff) = C;
        else { float* oc = p.out + O_PC + (((size_t)l * BATCH + b) * MH + h) * MHD * MHD + (size_t)d4 * MHD + e; oc[0] = C[0]; oc[MHD] = C[1]; oc[2 * MHD] = C[2]; oc[3 * MHD] = C[3]; }
        if (e4 == 0) p.out[O_PM + ((size_t)l * BATCH + b) * MH + h] = m;
    }
}
template <int DUP> __device__ __forceinline__ void ph_ml3_t(const P& p, int l, LDSP lds) {
    const int tid = opaque_tid(), w = tid >> 6, lane = tid & 63, rw = lane & 31, hh = lane >> 5;
    LDSP Qt = lds + M3_Q_OFF; LDSP Kt = lds + M3_K_OFF; LDSP Vt = lds + M3_V_OFF; LDSP CSt = lds + M3_CS_OFF;
    PG8_LAS float* vec = (PG8_LAS float*)(lds + M3_VEC_OFF);
    for (int item = blockIdx.x; item < NMI; item += gridDim.x) {
        const int c = item % NCH, h = (item / NCH) % MH, b = item / (NCH * MH);
        const int tok0 = b * SEQ + 64 * c;
        __syncthreads();
        {
            const int t = tid >> 3, c0 = (tid & 7) * 16;
            const pg8::u32x4 q0 = *(const pg8::u32x4*)(p.QMB + (size_t)(tok0 + t) * MW + h * MHD + c0), q1 = *(const pg8::u32x4*)(p.QMB + (size_t)(tok0 + t) * MW + h * MHD + c0 + 8);
            const pg8::u32x4 k0 = *(const pg8::u32x4*)(p.KMB + (size_t)(tok0 + t) * MW + h * MHD + c0), k1 = *(const pg8::u32x4*)(p.KMB + (size_t)(tok0 + t) * MW + h * MHD + c0 + 8);
            *(PG8_LAS pg8::u32x4*)(Qt + (t * TS + c0) * 2) = q0; *(PG8_LAS pg8::u32x4*)(Qt + (t * TS + c0 + 8) * 2) = q1;
            *(PG8_LAS pg8::u32x4*)(Kt + (t * TS + c0) * 2) = k0; *(PG8_LAS pg8::u32x4*)(Kt + (t * TS + c0 + 8) * 2) = k1;
#pragma unroll
            for (int cc = 0; cc < 16; cc += 4) {
                const f32x4 vv = *(const f32x4*)(p.Z + (size_t)(tok0 + t) * INW + ZV + h * MHD + c0 + cc);
                uint2 ov; ov.x = pack_bf16(vv[0], vv[1]); ov.y = pack_bf16(vv[2], vv[3]);
                *(PG8_LAS u32x2*)(Vt + (t * TS + c0 + cc) * 2) = (u32x2){ov.x, ov.y};
            }
            const bf16_t* cs = p.CSB + (size_t)item * MHD * MHD;
#pragma unroll
            for (int r2 = 0; r2 < 2; ++r2) {
                const int d = (tid >> 3) + 64 * r2;
                *(PG8_LAS pg8::u32x4*)(CSt + (d * TS + c0) * 2) = *(const pg8::u32x4*)(cs + (size_t)d * MHD + c0);
                *(PG8_LAS pg8::u32x4*)(CSt + (d * TS + c0 + 8) * 2) = *(const pg8::u32x4*)(cs + (size_t)d * MHD + c0 + 8);
            }
            if (tid < MHD) vec[256 + tid] = p.NS[(size_t)item * MHD + tid];
        }
        if (w == 0) {
            const float ig = p.IG[(size_t)(tok0 + lane) * 4 + h], lf = p.LF[(size_t)(tok0 + lane) * 4 + h], ms = p.MS[item];
            const float F = wave_incl_scan_add(lf, lane), a = ig - F;
            const float mt = F + fmaxf(ms, wave_incl_scan_max(a, lane));
            vec[lane] = F - mt; vec[64 + lane] = a; vec[128 + lane] = expf(ms + F - mt); vec[192 + lane] = expf(-mt);
        }
        __syncthreads();
        if (tid < 64) { float s = 0.f; for (int d = 0; d < MHD; ++d) s += bf2f(*(PG8_LAS const bf16_t*)(Qt + (tid * TS + d) * 2)) * vec[256 + d]; vec[384 + tid] = s; }
        const int eb = w & 3, tb = w >> 2, t = 32 * tb + rw;
        f32x16 s0, s1, acc;
        s0 = zero16(); s1 = zero16(); acc = zero16();
#pragma unroll
        for (int ds = 0; ds < 8; ++ds) {
            const bf16x8 bq = *(PG8_LAS const bf16x8*)(Qt + (t * TS + 16 * ds + 8 * hh) * 2);
            const bf16x8 a0 = *(PG8_LAS const bf16x8*)(Kt + (rw * TS + 16 * ds + 8 * hh) * 2), a1 = *(PG8_LAS const bf16x8*)(Kt + ((rw + 32) * TS + 16 * ds + 8 * hh) * 2);
            s0 = __builtin_amdgcn_mfma_f32_32x32x16_bf16(a0, bq, s0, 0, 0, 0);
            s1 = __builtin_amdgcn_mfma_f32_32x32x16_bf16(a1, bq, s1, 0, 0, 0);
            const bf16x8 ac = *(PG8_LAS const bf16x8*)(CSt + ((32 * eb + rw) * TS + 16 * ds + 8 * hh) * 2);
            acc = __builtin_amdgcn_mfma_f32_32x32x16_bf16(ac, bq, acc, 0, 0, 0);
        }
        MFMA_DRAIN();
        const float lt = vec[t], inter = vec[128 + t];
        float rsum = 0.f;
#pragma unroll
        for (int i = 0; i < 16; ++i) {
            const int k0 = (i & 3) + 8 * (i >> 2) + 4 * hh, k1 = k0 + 32;
            const float e0 = fast_exp2((vec[64 + k0] + lt) * 1.4426950408889634f), e1 = fast_exp2((vec[64 + k1] + lt) * 1.4426950408889634f);
            s0[i] = k0 <= t ? s0[i] * e0 : 0.f; s1[i] = k1 <= t ? s1[i] * e1 : 0.f;
            rsum += s0[i] + s1[i];
            acc[i] *= inter;
        }
        rsum += __shfl_xor(rsum, 32);
        {
            LDSP vb = Vt + tr_lane_off(lane, false, TS);
#pragma unroll
            for (int kh = 0; kh < 2; ++kh)
#pragma unroll
                for (int ks = 0; ks < 2; ++ks) {
                    const f32x16& pp = kh ? s1 : s0;
                    pg8::u32x4 pb; pb[0] = pack_bf16(pp[8 * ks + 0], pp[8 * ks + 1]); pb[1] = pack_bf16(pp[8 * ks + 2], pp[8 * ks + 3]); pb[2] = pack_bf16(pp[8 * ks + 4], pp[8 * ks + 5]); pb[3] = pack_bf16(pp[8 * ks + 6], pp[8 * ks + 7]);
                    const bf16x8 av = tr_frag(vb, 32 * kh + 16 * ks, 32 * eb, false, TS);
                    acc = __builtin_amdgcn_mfma_f32_32x32x16_bf16(av, __builtin_bit_cast(bf16x8, pb), acc, 0, 0, 0);
                }
        }
        MFMA_DRAIN();
        __syncthreads();
        const float den = rsum + inter * vec[384 + t];
        const float inv = 1.f / fmaxf(fabsf(den), vec[192 + t]);
        float ss = 0.f;
#pragma unroll
        for (int i = 0; i < 16; ++i) { acc[i] *= inv; ss += acc[i] * acc[i]; }
        ss += __shfl_xor(ss, 32);
        if (hh == 0) vec[448 + eb * 64 + t] = ss;
        __syncthreads();
        const float rn = 1.f / sqrtf((vec[448 + t] + vec[448 + 64 + t] + vec[448 + 128 + t] + vec[448 + 192 + t]) * (1.f / MHD) + EPS);
        const size_t tok = (size_t)tok0 + t;
#pragma unroll
        for (int q4 = 0; q4 < 4; ++q4) {
            const int e = h * MHD + 32 * eb + 8 * q4 + 4 * hh;
            const f32x4 og = *(const f32x4*)(p.Z + tok * INW + ZO + e), gg = *(const f32x4*)(p.mnorm_g + l * MW + e);
            uint2 v; v.x = pack_bf16(acc[4 * q4] * rn * gg[0] * sigmoidf_(og[0]), acc[4 * q4 + 1] * rn * gg[1] * sigmoidf_(og[1]));
            v.y = pack_bf16(acc[4 * q4 + 2] * rn * gg[2] * sigmoidf_(og[2]), acc[4 * q4 + 3] * rn * gg[3] * sigmoidf_(og[3]));
                        if (DUP) *(uint2*)(p.HBB + (size_t)DUP * MPAD * MW + tok * MW + e) = v;
            else *(uint2*)(p.HAB + tok * MW + e) = v;
        }
    }
}

__device__ __forceinline__ void ph_ml3(const P& p, int l, LDSP lds) { ph_ml3_t<0>(p, l, lds); }
#if 1
__device__ __forceinline__ void ph_ml3_dup(const P& p, int l, LDSP lds) { ph_ml3_t<1>(p, l, lds); }
__device__ __forceinline__ void ph_ml3_dup2(const P& p, int l, LDSP lds) { ph_ml3_t<2>(p, l, lds); }
__device__ __forceinline__ void ph_ml3_cmp2(const P& p, int l, long gtid, long gsz) {
    PLOOP(i, (size_t)NPT * MW) { if (p.HBB[(size_t)2 * MPAD * MW + i] != p.HBB[(size_t)MPAD * MW + i]) p.DIAGF[0] = 1; }
}
__device__ __forceinline__ void ph_ml3_cmp(const P& p, int l, long gtid, long gsz) {
    PLOOP(i, (size_t)NPT * MW) { if (p.HAB[i] != p.HBB[(size_t)MPAD * MW + i]) p.DIAGF[0] = 1; }
}
#endif

#ifdef DIAG_SUM
__device__ __forceinline__ void ph_diag_sum(const P& p, int l, long gtid, long gsz) {
    unsigned long long s = 0ull;
    if (DIAG_SUM & 1) { PLOOP(i, (size_t)NPT * MW / 2) s += ((const unsigned*)p.QMB)[i] * 2654435761ull + (unsigned long long)i * ((const unsigned*)p.QMB)[i]; }
    if (DIAG_SUM & 2) { PLOOP(i, (size_t)NPT * MW / 2) s += ((const unsigned*)p.KMB)[i] * 2246822519ull + (unsigned long long)i * ((const unsigned*)p.KMB)[i]; }
    if (DIAG_SUM & 4) { PLOOP(i, (size_t)NMI * MHD * MHD / 2) s += ((const unsigned*)p.CSB)[i] * 3266489917ull + (unsigned long long)i * ((const unsigned*)p.CSB)[i]; }
    if (DIAG_SUM & 8) { PLOOP(i, (size_t)NMI * MHD) s += ((const unsigned*)p.NS)[i] * 668265263ull + (unsigned long long)i * ((const unsigned*)p.NS)[i]; }
    if (DIAG_SUM & 16) { PLOOP(i, (size_t)NMI) s += ((const unsigned*)p.MS)[i] * 374761393ull + (unsigned long long)i * ((const unsigned*)p.MS)[i]; }
    if (DIAG_SUM & 32) { PLOOP(i, (size_t)NPT * MW / 2) s += ((const unsigned*)(p.HBB + (size_t)MPAD * MW))[i] * 2654435761ull + (unsigned long long)i * ((const unsigned*)(p.HBB + (size_t)MPAD * MW))[i]; }
    if (DIAG_SUM & 64) { PLOOP(i, (size_t)NTOK * 4) s += ((const unsigned*)p.IG)[i] * 2654435761ull + ((const unsigned*)p.LF)[i] * 40503ull + (unsigned long long)i * ((const unsigned*)p.IG)[i]; }
    if (m & 256) s += cks(p.HAB, (size_t)NPT * MW / 2, 2654435761ull, gtid, gsz);
    if (m & 512) s += cks(p.HAB + (size_t)NPT * MW, (size_t)NST * MW / 2, 2654435761ull, gtid, gsz);
    if (s) atomicAdd((unsigned long long*)(p.DIAGF + 2), s);
}
#endif

#ifdef DIAG2
__device__ __forceinline__ unsigned long long cks(const void* buf, size_t nwords, unsigned long long mul, long gtid, long gsz) {
    unsigned long long s = 0ull; const unsigned* u = (const unsigned*)buf;
    for (long i = gtid; i < (long)nwords; i += gsz) s += u[i] * mul + (unsigned long long)i * u[i];
    return s;
}
__device__ __forceinline__ void ph_diag2(const P& p, int l, long gtid, long gsz) {
    unsigned long long s = 0ull;
    const int m = l == 0 ? (DIAG2 & 0xFFFF) : (DIAG2 >> 16);
    if (m & 1) s += cks(p.HAB, (size_t)NTOK * MW / 2, 2654435761ull, gtid, gsz);
    if (m & 2) s += cks(p.MGB, (size_t)NTOK * D / 2, 2246822519ull, gtid, gsz);
    if (m & 4) s += cks(p.X, (size_t)NTOK * D, 3266489917ull, gtid, gsz);
    if (m & 8) s += cks(p.Z, (size_t)NTOK * INW, 668265263ull, gtid, gsz);
    if (m & 16) s += cks(p.HBB, (size_t)NTOK * MW / 2, 374761393ull, gtid, gsz);
    if (m & 32) s += cks(p.ACTB, (size_t)NTOK * DFF / 2, 40503ull, gtid, gsz);
    if (m & 64) s += cks(p.XB, (size_t)NTOK * D / 2, 99991ull, gtid, gsz);
    if (m & 128) s += cks(p.MGF, (size_t)NTOK * D, 1234577ull, gtid, gsz);
    if (s) atomicAdd((unsigned long long*)(p.DIAGF + 2), s);
}
#endif

#ifdef DIAG3
__device__ __forceinline__ void ph_diag3(const P& p, int l, long gtid, long gsz) {
    if (l != 0) return;
    unsigned long long s = 0ull;
    if (DIAG3 & 1) s += cks(p.HAB, (size_t)NPT * MW / 2, 2654435761ull, gtid, gsz);
    if (DIAG3 & 2) s += cks(p.QMB, (size_t)NPT * MW / 2, 2246822519ull, gtid, gsz);
    if (DIAG3 & 4) s += cks(p.KMB, (size_t)NPT * MW / 2, 3266489917ull, gtid, gsz);
    if (DIAG3 & 8) s += cks(p.CSB, (size_t)NMI * MHD * MHD / 2, 668265263ull, gtid, gsz);
    if (DIAG3 & 16) s += cks(p.NS, (size_t)NMI * MHD, 374761393ull, gtid, gsz);
    if (DIAG3 & 32) s += cks(p.MS, (size_t)NMI, 40503ull, gtid, gsz);
    if (DIAG3 & 64) s += cks(p.IG, (size_t)NTOK * 4, 99991ull, gtid, gsz) + cks(p.LF, (size_t)NTOK * 4, 7919ull, gtid, gsz);
    if (DIAG3 & 128) s += cks(p.DC, (size_t)NMI * MHD * MHD, 1234577ull, gtid, gsz);
    if (DIAG3 & 256) s += cks(p.GSUM, (size_t)NMI * 2, 104729ull, gtid, gsz) + cks(p.DN, (size_t)NMI * MHD, 15485863ull, gtid, gsz);
    if (DIAG3 & 512) s += cks(p.Z, (size_t)NPT * INW, 32452843ull, gtid, gsz);
    if (DIAG3 & 1024) s += cks(p.WMQ_T, (size_t)DEPTH * MH * MHD * MHD / 2, 49979687ull, gtid, gsz) + cks(p.WMK_T, (size_t)DEPTH * MH * MHD * MHD / 2, 67867967ull, gtid, gsz);
    if (s) atomicAdd((unsigned long long*)(p.DIAGF + 2), s);
}
#endif

#ifdef ML3_VIA_COPY
__device__ __forceinline__ void ph_ml3_copy(const P& p, int l, long gtid, long gsz) {
    PLOOP(i, (size_t)NPT * MW / 8) ((pg8::u32x4*)p.HAB)[i] = ((const pg8::u32x4*)(p.HBB + (size_t)MPAD * MW))[i];
}
#endif

__device__ __forceinline__ void ph_ml1(const P& p, int l, LDSP lds, int first = -1, int step = 0) { ph_ml1_t<0>(p, l, lds, first, step); }
#ifdef DIAG_ML1DUP
__device__ __forceinline__ void ph_ml1_dup(const P& p, int l, LDSP lds) { ph_ml1_t<1>(p, l, lds); }
__device__ __forceinline__ void ph_ml1_cmp(const P& p, int l, long gtid, long gsz) {
    PLOOP(i, (size_t)NPT * MW / 2) { if (((const unsigned*)p.QMB)[i] != ((const unsigned*)(p.QMB + (size_t)MPAD * MW))[i] || ((const unsigned*)p.KMB)[i] != ((const unsigned*)(p.KMB + (size_t)MPAD * MW))[i]) p.DIAGF[0] = 1; }
    PLOOP(i, (size_t)NMI * MHD * MHD) { if (__builtin_bit_cast(unsigned, p.DC[i]) != __builtin_bit_cast(unsigned, p.DC[(size_t)NMI * MHD * MHD + i])) p.DIAGF[0] = 1; }
    PLOOP(i, (size_t)NMI * MHD) { if (__builtin_bit_cast(unsigned, p.DN[i]) != __builtin_bit_cast(unsigned, p.DN[(size_t)NMI * MHD + i])) p.DIAGF[0] = 1; }
    PLOOP(i, (size_t)NMI * 2) { if (__builtin_bit_cast(unsigned, p.GSUM[i]) != __builtin_bit_cast(unsigned, p.GSUM[(size_t)NMI * 2 + i])) p.DIAGF[0] = 1; }
}
#endif

#ifdef CPU_TEST
__device__ __forceinline__ float fast_gelu(float x) { return geluf_(x); }
#else
__device__ __forceinline__ float fast_gelu(float x) { const float u = 1.5957691216057308f * (x + 0.044715f * x * x * x); return x * __builtin_amdgcn_rcpf(1.f + __builtin_amdgcn_exp2f(-1.4426950408889634f * u)); }
#endif
constexpr int CMP_SL = 72;
constexpr int CMP_SLICE_BYTES = 128 * CMP_SL * 2, CMP_HID_OFF = 2 * CMP_SLICE_BYTES, CMP_HS = 136, CMP_LDS_END = CMP_HID_OFF + 8 * 16 * CMP_HS * 2;
constexpr int CMP_MB_P = (NCP + 127) / 128, CMP_MB_S = (NCS + 127) / 128;
constexpr int CMP_ITEMS = BATCH * NKV * 2 * CMP_MB_P + DEC_BATCH * NKV * 2 * CMP_MB_S;
__device__ __forceinline__ void ph_compress(const P& p, int l, LDSP lds) {
    const int tid = opaque_tid(), w = tid >> 6, lane = tid & 63, lr = lane & 15, kq = lane >> 4;
    LDSP hidw = lds + CMP_HID_OFF + w * 16 * CMP_HS * 2;
    for (int item = blockIdx.x; item < CMP_ITEMS; item += gridDim.x) {
        int seq, g, kind, mb;
        if (item < DEC_BATCH * NKV * 2 * CMP_MB_S) { int r = item; mb = r % CMP_MB_S; r /= CMP_MB_S; kind = r & 1; g = (r >> 1) & 1; seq = BATCH + (r >> 2); }
        else { int r = item - DEC_BATCH * NKV * 2 * CMP_MB_S; mb = r % CMP_MB_P; r /= CMP_MB_P; kind = r & 1; g = (r >> 1) & 1; seq = r >> 2; }
        const int nc = seq_nc(seq), n = mb * 128 + 16 * w + lr;
        const int nl = n < nc ? n : nc - 1;
        const bf16_t* w1t = p.W1T + ((size_t)l * 2 + kind) * 128 * 2048;
        f32x4 acc[8];
#pragma unroll
        for (int i = 0; i < 8; ++i) acc[i] = (f32x4){0.f, 0.f, 0.f, 0.f};
        __syncthreads();
        {
            const int e = tid >> 2, c16 = (tid & 3) * 16;
            const pg8::u32x4 s0 = *(const pg8::u32x4*)(w1t + (size_t)e * 2048 + c16), s1 = *(const pg8::u32x4*)(w1t + (size_t)e * 2048 + c16 + 8);
            *(PG8_LAS pg8::u32x4*)(lds + (e * CMP_SL + c16) * 2) = s0; *(PG8_LAS pg8::u32x4*)(lds + (e * CMP_SL + c16 + 8) * 2) = s1;
        }
        __syncthreads();
        const float* rb0; const float* rb1; int rsplit; size_t rstride;
        if (seq < BATCH) { rb0 = rb1 = p.out + O_PKV + ((((size_t)l * BATCH + seq) * SEQ + 16 * nl) * 4 + kind) * 128 + g * 64; rsplit = 32; rstride = 512; }
        else { const int bsm = seq - BATCH, pos0 = 16 * nl, pg0 = p.page_table[bsm * N_PAGES + pos0 / PAGE], pg1 = p.page_table[bsm * N_PAGES + (pos0 + 31) / PAGE];
            rb0 = p.cache_kv + ((((size_t)l * N_POOL + pg0) * PAGE + pos0 % PAGE) * 4 + kind) * 128 + g * 64;
            rsplit = PAGE - pos0 % PAGE;
            rb1 = p.cache_kv + ((((size_t)l * N_POOL + pg1) * PAGE) * 4 + kind) * 128 + g * 64 - (size_t)rsplit * 512; rstride = 512; }
        auto load_a = [&](int r, f32x4 (&a)[4]) { const float* row = (r < rsplit ? rb0 : rb1) + (size_t)r * rstride;
            a[0] = *(const f32x4*)(row + 8 * kq); a[1] = *(const f32x4*)(row + 8 * kq + 4); a[2] = *(const f32x4*)(row + 32 + 8 * kq); a[3] = *(const f32x4*)(row + 32 + 8 * kq + 4); };
        f32x4 an[4]; load_a(0, an);
        for (int r = 0; r < 32; ++r) {
            LDSP cur = lds + (r & 1) * CMP_SLICE_BYTES; LDSP nxt = lds + ((r + 1) & 1) * CMP_SLICE_BYTES;
            const int e = tid >> 2, c16 = (tid & 3) * 16;
            pg8::u32x4 s0 = {0u, 0u, 0u, 0u}, s1 = {0u, 0u, 0u, 0u};
            f32x4 ac[4] = {an[0], an[1], an[2], an[3]};
            if (r + 1 < 32) { s0 = *(const pg8::u32x4*)(w1t + (size_t)e * 2048 + (r + 1) * 64 + c16); s1 = *(const pg8::u32x4*)(w1t + (size_t)e * 2048 + (r + 1) * 64 + c16 + 8); load_a(r + 1, an); }
#pragma unroll
            for (int half = 0; half < 2; ++half) {
                const f32x4 a0 = ac[2 * half], a1 = ac[2 * half + 1];
                pg8::u32x4 ap; ap[0] = pack_bf16(a0[0], a0[1]); ap[1] = pack_bf16(a0[2], a0[3]); ap[2] = pack_bf16(a1[0], a1[1]); ap[3] = pack_bf16(a1[2], a1[3]);
                const bf16x8 af = __builtin_bit_cast(bf16x8, ap);
#pragma unroll
                for (int nt = 0; nt < 8; ++nt) {
                    const bf16x8 bfr = *(PG8_LAS const bf16x8*)(cur + ((16 * nt + lr) * CMP_SL + 32 * half + 8 * kq) * 2);
                    acc[nt] = __builtin_amdgcn_mfma_f32_16x16x32_bf16(af, bfr, acc[nt], 0, 0, 0);
                }
            }
            if (r + 1 < 32) { *(PG8_LAS pg8::u32x4*)(nxt + (e * CMP_SL + c16) * 2) = s0; *(PG8_LAS pg8::u32x4*)(nxt + (e * CMP_SL + c16 + 8) * 2) = s1; }
            __syncthreads();
        }
        const float* bias = p.CBIAS + ((size_t)l * 2 + kind) * 128;
#pragma unroll
        for (int nt = 0; nt < 8; ++nt) {
            const float bb = bias[16 * nt + lr];
#pragma unroll
            for (int i = 0; i < 4; ++i) *(PG8_LAS bf16_t*)(hidw + ((4 * kq + i) * CMP_HS + 16 * nt + lr) * 2) = f2bf(fast_gelu(acc[nt][i] + bb));
        }
        __syncthreads();
        const bf16_t* w2t = p.W2T + ((size_t)l * 2 + kind) * 64 * 128;
        f32x4 o[4];
#pragma unroll
        for (int i = 0; i < 4; ++i) o[i] = (f32x4){0.f, 0.f, 0.f, 0.f};
#pragma unroll
        for (int s = 0; s < 4; ++s) {
            const bf16x8 af = *(PG8_LAS const bf16x8*)(hidw + (lr * CMP_HS + 32 * s + 8 * kq) * 2);
#pragma unroll
            for (int ft = 0; ft < 4; ++ft) {
                const bf16x8 bfr = *(const bf16x8*)(w2t + (size_t)(16 * ft + lr) * 128 + 32 * s + 8 * kq);
                o[ft] = __builtin_amdgcn_mfma_f32_16x16x32_bf16(af, bfr, o[ft], 0, 0, 0);
            }
        }
        float* dst = kind ? p.VC : p.KC;
#pragma unroll
        for (int ft = 0; ft < 4; ++ft)
#pragma unroll
            for (int i = 0; i < 4; ++i) { const int nn = mb * 128 + 16 * w + 4 * kq + i; if (nn < nc) dst[((kc_base(seq) + nn) * 2 + g) * 64 + 16 * ft + lr] = o[ft][i]; }
    }
}
constexpr int CMP2_HID_OFF = 2 * CMP_SLICE_BYTES, CMP2_LDS_END = CMP2_HID_OFF + 8 * 32 * CMP_HS * 2;
constexpr int CMP2_ITEMS = DEC_BATCH * 2 * CMP_MB_S + BATCH * 2 * CMP_MB_P;
__device__ __forceinline__ void ph_compress2(const P& p, int l, LDSP lds) {
    const int tid = opaque_tid(), w = tid >> 6, lane = tid & 63, lr = lane & 31, hh = lane >> 5, g = w >> 2, wr = w & 3;
    LDSP hidw = lds + CMP2_HID_OFF + w * 32 * CMP_HS * 2;
    for (int item = blockIdx.x; item < CMP2_ITEMS; item += gridDim.x) {
        int seq, kind, mb;
        if (item < DEC_BATCH * 2 * CMP_MB_S) { int r = item; mb = r % CMP_MB_S; r /= CMP_MB_S; kind = r & 1; seq = BATCH + (r >> 1); }
        else { int r = item - DEC_BATCH * 2 * CMP_MB_S; mb = r % CMP_MB_P; r /= CMP_MB_P; kind = r & 1; seq = r >> 1; }
        const int nc = seq_nc(seq), n = mb * 128 + 32 * wr + lr;
        const int nl = n < nc ? n : nc - 1;
        const bf16_t* w1t = p.W1T + ((size_t)l * 2 + kind) * 128 * 2048;
        f32x16 acc[4];
#pragma unroll
        for (int i = 0; i < 4; ++i) acc[i] = zero16();
        const float* rb0; const float* rb1; int rsplit;
        if (seq < BATCH) { rb0 = rb1 = p.out + O_PKV + ((((size_t)l * BATCH + seq) * SEQ + 16 * nl) * 4 + kind) * 128 + g * 64; rsplit = 32; }
        else { const int bsm = seq - BATCH, pos0 = 16 * nl, pg0 = p.page_table[bsm * N_PAGES + pos0 / PAGE], pg1 = p.page_table[bsm * N_PAGES + (pos0 + 31) / PAGE];
            rb0 = p.cache_kv + ((((size_t)l * N_POOL + pg0) * PAGE + pos0 % PAGE) * 4 + kind) * 128 + g * 64;
            rsplit = PAGE - pos0 % PAGE;
            rb1 = p.cache_kv + ((((size_t)l * N_POOL + pg1) * PAGE) * 4 + kind) * 128 + g * 64 - (size_t)rsplit * 512; }
        auto load_a = [&](int r, f32x4 (&a)[8]) { const float* row = (r < rsplit ? rb0 : rb1) + (size_t)r * 512 + 8 * hh;
#pragma unroll
            for (int ks = 0; ks < 4; ++ks) { a[2 * ks] = *(const f32x4*)(row + 16 * ks); a[2 * ks + 1] = *(const f32x4*)(row + 16 * ks + 4); } };
        __syncthreads();
        {
            const int e = tid >> 2, c16 = (tid & 3) * 16;
            const pg8::u32x4 s0 = *(const pg8::u32x4*)(w1t + (size_t)e * 2048 + c16), s1 = *(const pg8::u32x4*)(w1t + (size_t)e * 2048 + c16 + 8);
            *(PG8_LAS pg8::u32x4*)(lds + (e * CMP_SL + c16) * 2) = s0; *(PG8_LAS pg8::u32x4*)(lds + (e * CMP_SL + c16 + 8) * 2) = s1;
        }
        f32x4 an[8]; load_a(0, an);
        __syncthreads();
        for (int r = 0; r < 32; ++r) {
            LDSP cur = lds + (r & 1) * CMP_SLICE_BYTES; LDSP nxt = lds + ((r + 1) & 1) * CMP_SLICE_BYTES;
            const int e = tid >> 2, c16 = (tid & 3) * 16;
            pg8::u32x4 s0 = {0u, 0u, 0u, 0u}, s1 = {0u, 0u, 0u, 0u};
            f32x4 ac[8];
#pragma unroll
            for (int i = 0; i < 8; ++i) ac[i] = an[i];
            if (r + 1 < 32) { s0 = *(const pg8::u32x4*)(w1t + (size_t)e * 2048 + (r + 1) * 64 + c16); s1 = *(const pg8::u32x4*)(w1t + (size_t)e * 2048 + (r + 1) * 64 + c16 + 8); load_a(r + 1, an); }
#pragma unroll
            for (int ks = 0; ks < 4; ++ks) {
                pg8::u32x4 ap; ap[0] = pack_bf16(ac[2 * ks][0], ac[2 * ks][1]); ap[1] = pack_bf16(ac[2 * ks][2], ac[2 * ks][3]); ap[2] = pack_bf16(ac[2 * ks + 1][0], ac[2 * ks + 1][1]); ap[3] = pack_bf16(ac[2 * ks + 1][2], ac[2 * ks + 1][3]);
                const bf16x8 af = __builtin_bit_cast(bf16x8, ap);
#pragma unroll
                for (int nt = 0; nt < 4; ++nt) {
                    const bf16x8 bfr = *(PG8_LAS const bf16x8*)(cur + ((32 * nt + lr) * CMP_SL + 16 * ks + 8 * hh) * 2);
                    acc[nt] = __builtin_amdgcn_mfma_f32_32x32x16_bf16(af, bfr, acc[nt], 0, 0, 0);
                }
            }
            if (r + 1 < 32) { *(PG8_LAS pg8::u32x4*)(nxt + (e * CMP_SL + c16) * 2) = s0; *(PG8_LAS pg8::u32x4*)(nxt + (e * CMP_SL + c16 + 8) * 2) = s1; }
            __syncthreads();
        }
        const float* bias = p.CBIAS + ((size_t)l * 2 + kind) * 128;
#pragma unroll
        for (int nt = 0; nt < 4; ++nt) {
            const float bb = bias[32 * nt + lr];
#pragma unroll
            for (int i = 0; i < 16; ++i) *(PG8_LAS bf16_t*)(hidw + (((i & 3) + 8 * (i >> 2) + 4 * hh) * CMP_HS + 32 * nt + lr) * 2) = f2bf(fast_gelu(acc[nt][i] + bb));
        }
        __syncthreads();
        const bf16_t* w2t = p.W2T + ((size_t)l * 2 + kind) * 64 * 128;
        f32x16 o[2]; o[0] = zero16(); o[1] = zero16();
#pragma unroll
        for (int ks = 0; ks < 8; ++ks) {
            const bf16x8 af = *(PG8_LAS const bf16x8*)(hidw + (lr * CMP_HS + 16 * ks + 8 * hh) * 2);
#pragma unroll
            for (int ft = 0; ft < 2; ++ft) {
                const bf16x8 bfr = *(const bf16x8*)(w2t + (size_t)(32 * ft + lr) * 128 + 16 * ks + 8 * hh);
                o[ft] = __builtin_amdgcn_mfma_f32_32x32x16_bf16(af, bfr, o[ft], 0, 0, 0);
            }
        }
        float* dst = kind ? p.VC : p.KC;
#pragma unroll
        for (int ft = 0; ft < 2; ++ft)
#pragma unroll
            for (int i = 0; i < 16; ++i) { const int nn = mb * 128 + 32 * wr + (i & 3) + 8 * (i >> 2) + 4 * hh; if (nn < nc) dst[((kc_base(seq) + nn) * 2 + g) * 64 + 32 * ft + lr] = o[ft][i]; }
    }
}
constexpr int CMP3_SL = 136, CMP3_SLICE_BYTES = 128 * CMP3_SL * 2, CMP3_LDS_END = 2 * CMP3_SLICE_BYTES;
static_assert(8 * 2 * 16 * CMP_HS * 2 <= CMP3_LDS_END, "compress3 LDS");
__device__ __forceinline__ void ph_compress3(const P& p, int l, LDSP lds, int first = -1, int step = 0) {
    if (first < 0) { first = blockIdx.x; step = gridDim.x; }
    const int tid = opaque_tid(), w = tid >> 6, lane = tid & 63, lr = lane & 15, kq = lane >> 4;
    for (int item = first; item < CMP2_ITEMS; item += step) {
        int seq, kind, mb;
        if (item < DEC_BATCH * 2 * CMP_MB_S) { int r = item; mb = r % CMP_MB_S; r /= CMP_MB_S; kind = r & 1; seq = BATCH + (r >> 1); }
        else { int r = item - DEC_BATCH * 2 * CMP_MB_S; mb = r % CMP_MB_P; r /= CMP_MB_P; kind = r & 1; seq = r >> 1; }
        const int nc = seq_nc(seq), n = mb * 128 + 16 * w + lr;
        const int nl = n < nc ? n : nc - 1;
        const bf16_t* w1t = p.W1T + ((size_t)l * 2 + kind) * 128 * 2048;
        f32x4 acc[2][8];
#pragma unroll
        for (int gg = 0; gg < 2; ++gg)
#pragma unroll
            for (int i = 0; i < 8; ++i) acc[gg][i] = (f32x4){0.f, 0.f, 0.f, 0.f};
        const float* rb0; const float* rb1; int rsplit;
        if (seq < BATCH) { rb0 = rb1 = p.out + O_PKV + ((((size_t)l * BATCH + seq) * SEQ + 16 * nl) * 4 + kind) * 128; rsplit = 32; }
        else { const int bsm = seq - BATCH, pos0 = 16 * nl, pg0 = p.page_table[bsm * N_PAGES + pos0 / PAGE], pg1 = p.page_table[bsm * N_PAGES + (pos0 + 31) / PAGE];
            rb0 = p.cache_kv + ((((size_t)l * N_POOL + pg0) * PAGE + pos0 % PAGE) * 4 + kind) * 128;
            rsplit = PAGE - pos0 % PAGE;
            rb1 = p.cache_kv + ((((size_t)l * N_POOL + pg1) * PAGE) * 4 + kind) * 128 - (size_t)rsplit * 512; }
        auto load_a = [&](int r, f32x4 (&a)[8]) { const float* row = (r < rsplit ? rb0 : rb1) + (size_t)r * 512 + 8 * kq;
#pragma unroll
            for (int gg = 0; gg < 2; ++gg) { a[4 * gg] = *(const f32x4*)(row + 64 * gg); a[4 * gg + 1] = *(const f32x4*)(row + 64 * gg + 4); a[4 * gg + 2] = *(const f32x4*)(row + 64 * gg + 32); a[4 * gg + 3] = *(const f32x4*)(row + 64 * gg + 36); } };
        auto load_b = [&](int st, pg8::u32x4 (&s)[4]) { const bf16_t* src = w1t + (size_t)(tid >> 2) * 2048 + st * 128 + (tid & 3) * 32;
#pragma unroll
            for (int i = 0; i < 4; ++i) s[i] = *(const pg8::u32x4*)(src + 8 * i); };
        auto put_b = [&](LDSP dst, const pg8::u32x4 (&s)[4]) {
#pragma unroll
            for (int i = 0; i < 4; ++i) *(PG8_LAS pg8::u32x4*)(dst + ((tid >> 2) * CMP3_SL + (tid & 3) * 32 + 8 * i) * 2) = s[i]; };
        __syncthreads();
        { pg8::u32x4 s[4]; load_b(0, s); put_b(lds, s); }
        f32x4 an[8]; load_a(0, an);
        __syncthreads();
        for (int st = 0; st < 16; ++st) {
            LDSP cur = lds + (st & 1) * CMP3_SLICE_BYTES; LDSP nxt = lds + ((st + 1) & 1) * CMP3_SLICE_BYTES;
            pg8::u32x4 sn[4];
            if (st + 1 < 16) load_b(st + 1, sn);
#pragma unroll
            for (int rr = 0; rr < 2; ++rr) {
                const int r = 2 * st + rr;
                f32x4 ac[8];
#pragma unroll
                for (int i = 0; i < 8; ++i) ac[i] = an[i];
                if (r + 1 < 32) load_a(r + 1, an);
#pragma unroll
                for (int half = 0; half < 2; ++half) {
                    bf16x8 af[2];
#pragma unroll
                    for (int gg = 0; gg < 2; ++gg) { const f32x4 a0 = ac[4 * gg + 2 * half], a1 = ac[4 * gg + 2 * half + 1];
                        pg8::u32x4 ap; ap[0] = pack_bf16(a0[0], a0[1]); ap[1] = pack_bf16(a0[2], a0[3]); ap[2] = pack_bf16(a1[0], a1[1]); ap[3] = pack_bf16(a1[2], a1[3]);
                        af[gg] = __builtin_bit_cast(bf16x8, ap); }
#pragma unroll
                    for (int nt = 0; nt < 8; ++nt) {
                        const bf16x8 bfr = *(PG8_LAS const bf16x8*)(cur + ((16 * nt + lr) * CMP3_SL + 64 * rr + 32 * half + 8 * kq) * 2);
                        acc[0][nt] = __builtin_amdgcn_mfma_f32_16x16x32_bf16(af[0], bfr, acc[0][nt], 0, 0, 0);
                        acc[1][nt] = __builtin_amdgcn_mfma_f32_16x16x32_bf16(af[1], bfr, acc[1][nt], 0, 0, 0);
                    }
                }
            }
            if (st + 1 < 16) put_b(nxt, sn);
            __syncthreads();
        }
        const float* bias = p.CBIAS + ((size_t)l * 2 + kind) * 128;
        LDSP hidw = lds + w * 2 * 16 * CMP_HS * 2;
#pragma unroll
        for (int gg = 0; gg < 2; ++gg)
#pragma unroll
            for (int nt = 0; nt < 8; ++nt) {
                const float bb = bias[16 * nt + lr];
#pragma unroll
                for (int i = 0; i < 4; ++i) *(PG8_LAS bf16_t*)(hidw + ((gg * 16 + 4 * kq + i) * CMP_HS + 16 * nt + lr) * 2) = f2bf(fast_gelu(acc[gg][nt][i] + bb));
            }
        __syncthreads();
        const bf16_t* w2t = p.W2T + ((size_t)l * 2 + kind) * 64 * 128;
        f32x4 o[2][4];
#pragma unroll
        for (int gg = 0; gg < 2; ++gg)
#pragma unroll
            for (int i = 0; i < 4; ++i) o[gg][i] = (f32x4){0.f, 0.f, 0.f, 0.f};
#pragma unroll
        for (int s = 0; s < 4; ++s) {
            const bf16x8 a0 = *(PG8_LAS const bf16x8*)(hidw + (lr * CMP_HS + 32 * s + 8 * kq) * 2), a1 = *(PG8_LAS const bf16x8*)(hidw + ((16 + lr) * CMP_HS + 32 * s + 8 * kq) * 2);
#pragma unroll
            for (int ft = 0; ft < 4; ++ft) {
                const bf16x8 bfr = *(const bf16x8*)(w2t + (size_t)(16 * ft + lr) * 128 + 32 * s + 8 * kq);
                o[0][ft] = __builtin_amdgcn_mfma_f32_16x16x32_bf16(a0, bfr, o[0][ft], 0, 0, 0);
                o[1][ft] = __builtin_amdgcn_mfma_f32_16x16x32_bf16(a1, bfr, o[1][ft], 0, 0, 0);
            }
        }
        float* dst = kind ? p.VC : p.KC; bf16_t* dstb = kind ? p.VCB : p.KCB;
#pragma unroll
        for (int gg = 0; gg < 2; ++gg)
#pragma unroll
            for (int ft = 0; ft < 4; ++ft)
#pragma unroll
                for (int i = 0; i < 4; ++i) { const int nn = mb * 128 + 16 * w + 4 * kq + i; if (nn < nc) { dst[((kc_base(seq) + nn) * 2 + gg) * 64 + 16 * ft + lr] = o[gg][ft][i]; dstb[((kc_base(seq) + nn) * 2 + gg) * 64 + 16 * ft + lr] = f2bf(o[gg][ft][i]); } }
    }
}

constexpr int SM_ITEMS = DEC_BATCH * MH;
constexpr int SM_C = 0, SM_Q = 2048, SM_K = 4096, SM_V = 6144, SM_SC = 8192, SM_RED = 8704, SM_END = SM_RED + 16 * 4 * 128 * 4;
__device__ __forceinline__ void ph_smlstm(const P& p, int l, LDSP lds, int first = -1, int step = 0) {
    if (first < 0) { first = blockIdx.x; step = gridDim.x; }
    const int tid = opaque_tid(), lane = tid & 63, w = tid >> 6;
    PG8_LAS float* cS = (PG8_LAS float*)(lds + SM_C); PG8_LAS float* qS = (PG8_LAS float*)(lds + SM_Q); PG8_LAS float* kS = (PG8_LAS float*)(lds + SM_K);
    PG8_LAS float* vS = (PG8_LAS float*)(lds + SM_V); PG8_LAS float* sc = (PG8_LAS float*)(lds + SM_SC); PG8_LAS float* red = (PG8_LAS float*)(lds + SM_RED);
    for (int item = first; item < SM_ITEMS; item += step) {
        const int b = item / MH, h = item % MH, tok0 = NPT + b * DEC_SEQ;
        const int t = tid >> 7, e = tid & 127;
        __syncthreads();
        {
            const int col = h * MHD + e;
            float y = p.conv_b[l * MW + col];
#pragma unroll
            for (int j = 0; j < 4; ++j) { const int tt = t + j - 3;
                const float u = tt >= 0 ? p.Z[(size_t)(tok0 + tt) * INW + ZU + col] : p.st_conv[(((size_t)l * DEC_BATCH + b) * 3 + (3 + tt)) * MW + col];
                y += u * p.conv_w[((size_t)l * 4 + j) * MW + col]; }
            cS[t * 128 + e] = siluf_(y);
            vS[t * 128 + e] = p.Z[(size_t)(tok0 + t) * INW + ZV + col];
        }
        __syncthreads();
        {
            const float* wq = p.w_mq + ((size_t)l * MH + h) * MHD * MHD + e; const float* wk = p.w_mk + ((size_t)l * MH + h) * MHD * MHD + e;
            float aq = 0.f, ak = 0.f;
            for (int d = 0; d < MHD; ++d) { const float c = cS[t * 128 + d]; aq += c * wq[(size_t)d * MHD]; ak += c * wk[(size_t)d * MHD]; }
            qS[t * 128 + e] = aq; kS[t * 128 + e] = ak * 0.08838834764831845f;
        }
        float dec[4], wg[4], mt[4];
        {
            float m = p.st_m[((size_t)l * DEC_BATCH + b) * MH + h];
#pragma unroll
            for (int s = 0; s < 4; ++s) { const float ig = p.IG[(size_t)(tok0 + s) * 4 + h], lf = p.LF[(size_t)(tok0 + s) * 4 + h];
                const float mn = fmaxf(lf + m, ig); dec[s] = expf(lf + m - mn); wg[s] = expf(ig - mn); m = mn; mt[s] = mn; }
        }
        __syncthreads();
        const int e4 = tid & 31, d0 = tid >> 5;
        const size_t cbase = (((size_t)l * DEC_BATCH + b) * MH + h) * MHD * MHD;
        f32x4 C[8]; f32x4 np[4];
#pragma unroll
        for (int i = 0; i < 8; ++i) C[i] = *(const f32x4*)(p.st_C + cbase + (size_t)(d0 + 16 * i) * MHD + 4 * e4);
#pragma unroll
        for (int s = 0; s < 4; ++s) {
            const f32x4 vv = *(PG8_LAS const f32x4*)(vS + s * 128 + 4 * e4);
            f32x4 acc = {0.f, 0.f, 0.f, 0.f};
#pragma unroll
            for (int i = 0; i < 8; ++i) { const float kd = kS[s * 128 + d0 + 16 * i] * wg[s], qd = qS[s * 128 + d0 + 16 * i];
                C[i] = C[i] * dec[s] + vv * kd; acc += C[i] * qd; }
            np[s] = acc;
        }
#pragma unroll
        for (int s = 0; s < 4; ++s) *(PG8_LAS f32x4*)(red + (d0 * 4 + s) * 128 + 4 * e4) = np[s];
        float* oc = p.out + O_SC + cbase;
#pragma unroll
        for (int i = 0; i < 8; ++i) *(f32x4*)(oc + (size_t)(d0 + 16 * i) * MHD + 4 * e4) = C[i];
        float dpart[4] = {0.f, 0.f, 0.f, 0.f};
        if (tid < MHD) {
            float nn = p.st_n[(((size_t)l * DEC_BATCH + b) * MH + h) * MHD + tid];
#pragma unroll
            for (int s = 0; s < 4; ++s) { nn = nn * dec[s] + wg[s] * kS[s * 128 + tid]; dpart[s] = qS[s * 128 + tid] * nn; }
            p.out[O_SN + (((size_t)l * DEC_BATCH + b) * MH + h) * MHD + tid] = nn;
            if (tid == 0) p.out[O_SM + ((size_t)l * DEC_BATCH + b) * MH + h] = mt[3];
        }
        if (w < 2) {
#pragma unroll
            for (int s = 0; s < 4; ++s) { float v = dpart[s];
#pragma unroll
                for (int x = 32; x >= 1; x >>= 1) v += __shfl_xor(v, x);
                if (lane == 0) sc[w * 4 + s] = v; }
        }
        __syncthreads();
        float num = 0.f;
#pragma unroll
        for (int d = 0; d < 16; ++d) num += red[(d * 4 + t) * 128 + e];
        const float den = sc[t] + sc[4 + t];
        float hv = num / fmaxf(fabsf(den), expf(-mt[t]));
        float ss = hv * hv;
#pragma unroll
        for (int x = 32; x >= 1; x >>= 1) ss += __shfl_xor(ss, x);
        if (lane == 0) sc[16 + w] = ss;
        __syncthreads();
        const float rn = 1.f / sqrtf((sc[16 + 2 * t] + sc[16 + 2 * t + 1]) * (1.f / MHD) + EPS);
        const float og = p.Z[(size_t)(tok0 + t) * INW + ZO + h * MHD + e];
        p.HAB[(size_t)(tok0 + t) * MW + h * MHD + e] = f2bf(hv * rn * p.mnorm_g[l * MW + h * MHD + e] * sigmoidf_(og));
    }
}
__device__ __forceinline__ void ph_small_mfma(const P& p, int l, LDSP lds) {
    const int tid = opaque_tid(), lane = tid & 63, lr = lane & 15, kq = lane >> 4;
    const bf16_t* wsm = p.WSM_T + (size_t)l * 32 * D;
    for (int task = (tid >> 6) * (int)gridDim.x + (int)blockIdx.x; task < MPAD / 16; task += gridDim.x * 8) {
        f32x4 a0 = {0.f, 0.f, 0.f, 0.f}, a1 = {0.f, 0.f, 0.f, 0.f};
        const bf16_t* xa = p.XB + (size_t)(task * 16 + lr) * D + 8 * kq;
        const bf16_t* w0 = wsm + (size_t)lr * D + 8 * kq; const bf16_t* w1 = wsm + (size_t)(16 + lr) * D + 8 * kq;
#pragma unroll 8
        for (int s = 0; s < D / 32; ++s) {
            const bf16x8 af = *(const bf16x8*)(xa + 32 * s), b0 = *(const bf16x8*)(w0 + 32 * s), b1 = *(const bf16x8*)(w1 + 32 * s);
            a0 = __builtin_amdgcn_mfma_f32_16x16x32_bf16(af, b0, a0, 0, 0, 0);
            a1 = __builtin_amdgcn_mfma_f32_16x16x32_bf16(af, b1, a1, 0, 0, 0);
        }
#pragma unroll
        for (int i = 0; i < 4; ++i) {
            const int tok = task * 16 + 4 * kq + i;
            if (tok >= NTOK) continue;
            const float rs = rstd_of(p.RSS[(size_t)(2 * l) * MPAD + tok]);
            const float z0 = a0[i] * rs, z1 = a1[i] * rs;
            float* zr = p.Z + (size_t)tok * INW;
            if (lr < 4) { zr[ZIG + lr] = z0; p.IG[(size_t)tok * 4 + lr] = z0 + p.b_gates[l * 8 + lr]; }
            else if (lr < 8) { zr[ZFG + lr - 4] = z0; p.LF[(size_t)tok * 4 + lr - 4] = log_sigmoidf_(z0 + p.b_gates[l * 8 + lr]); }
            else zr[ZNG + lr - 8] = z0;
            zr[ZNG + 8 + lr] = z1;
        }
    }
}
__device__ __forceinline__ void ph_conv_tails(const P& p, int l, long gtid, long gsz) {
    PLOOP(i, (size_t)NSEQ * 3 * 512) {
        int seq = (int)(i / 1536), r = (int)((i % 1536) / 512), c = (int)(i % 512);
        int T = seq_len(seq), row0 = seq_row0(seq);
        Tok ti = tokinfo(row0 + T - 1);
        float v = conv_u(p, l, ti, row0 + T - 1, r - 2, c);
        if (seq < BATCH) p.out[O_PCONV + (((size_t)l * BATCH + seq) * 3 + r) * MW + c] = v;
        else p.out[O_SCONV + (((size_t)l * DEC_BATCH + (seq - BATCH)) * 3 + r) * MW + c] = v;
    }
}
__device__ __forceinline__ void ph_swin_shift(const P& p, int l, long gtid, long gsz) {
    PLOOP(i, (size_t)DEC_BATCH * (WB - DEC_SEQ) * 64) {
        const int b = (int)(i / ((WB - DEC_SEQ) * 64)); const int r = (int)(i % ((WB - DEC_SEQ) * 64));
        ((float4*)(p.out + O_SWIN + ((size_t)l * DEC_BATCH + b) * WB * 256))[r] = ((const float4*)(p.cache_win + ((size_t)l * DEC_BATCH + b) * WB * 256 + DEC_SEQ * 256))[r];
    }
}
__device__ __forceinline__ void ph_misc(const P& p, int l, long gtid, long gsz) {
    PLOOP(i, (size_t)NSEQ * 3 * 512) {
        int seq = (int)(i / 1536), r = (int)((i % 1536) / 512), c = (int)(i % 512);
        int T = seq_len(seq), row0 = seq_row0(seq);
        Tok ti = tokinfo(row0 + T - 1);
        float v = conv_u(p, l, ti, row0 + T - 1, r - 2, c);
        if (seq < BATCH) p.out[O_PCONV + (((size_t)l * BATCH + seq) * 3 + r) * MW + c] = v;
        else p.out[O_SCONV + (((size_t)l * DEC_BATCH + (seq - BATCH)) * 3 + r) * MW + c] = v;
    }
    PLOOP(i, (size_t)DEC_BATCH * (WB - DEC_SEQ) * 64) {
        const int b = (int)(i / ((WB - DEC_SEQ) * 64)); const int r = (int)(i % ((WB - DEC_SEQ) * 64));
        ((float4*)(p.out + O_SWIN + ((size_t)l * DEC_BATCH + b) * WB * 256))[r] = ((const float4*)(p.cache_win + ((size_t)l * DEC_BATCH + b) * WB * 256 + DEC_SEQ * 256))[r];
    }
}


}

#ifdef DIAG_ML1DUP
#define ML1DUP_PHASES(F, B) B(ph_ml1_dup) F(ph_ml1_cmp)
#else
#define ML1DUP_PHASES(F, B)
#endif
#ifdef DIAG3
#define DIAG3_PHASES(F) F(ph_diag3)
#else
#define DIAG3_PHASES(F)
#endif
#ifdef DIAG2
#define DIAG2_PHASES(F) F(ph_diag2)
#else
#define DIAG2_PHASES(F)
#endif
#ifdef ML3_VIA_COPY
#define ML3_PHASE(B) B(ph_ml3_dup) ML3_COPY_F
#elif defined(BISECT_A)
#define ML3_PHASE(B) B(ph_ml3_dup)
#else
#define ML3_PHASE(B) B(ph_ml3)
#endif
#ifdef DIAG_SUM
#define DIAG_PHASES(F, B) F(ph_diag_sum)
#elif defined(DIAG_DUP2)
#define DIAG_PHASES(F, B) B(ph_ml3_dup2) F(ph_ml3_cmp2)
#elif defined(DIAG_DUP)
#define DIAG_PHASES(F, B) B(ph_ml3_dup) F(ph_ml3_cmp)
#else
#define DIAG_PHASES(F, B)
#endif
#define ML3_COPY_F RUN_F(ph_ml3_copy)
__device__ __forceinline__ void ph_mixB(const P& p, int l, LDSP lds) {
    ph_small_mfma(p, l, lds);
    const long gtid = (long)blockIdx.x * NT + opaque_tid(), gsz = (long)gridDim.x * NT;
    ph_misc(p, l, gtid, gsz);
}
__device__ __forceinline__ void ph_gemm_in_plus(const P& p, int l, LDSP lds) {
    ph_gemm_in(p, l, lds); __syncthreads(); ph_small_mfma(p, l, lds);
}
constexpr int MIXC_QSLOT_OFF = 120 * 1024, MIXC_ITEMS = CMP2_ITEMS + SM_ITEMS + NMI;
__device__ __forceinline__ void ph_mixC(const P& p, int l, LDSP lds) {
    const int tid = opaque_tid();
    { const long gtid = (long)blockIdx.x * NT + tid, gsz = (long)gridDim.x * NT; ph_conv_tails(p, l, gtid, gsz); }
    PG8_LAS int* qslot = (PG8_LAS int*)(lds + MIXC_QSLOT_OFF);
    for (;;) {
        __syncthreads();
        if (tid == 0) *qslot = atomicAdd(p.QCTR + l, 1);
        __syncthreads();
        const int it = *qslot;
        if (it >= MIXC_ITEMS) break;
        if (it < CMP2_ITEMS) ph_compress3(p, l, lds, it, 1 << 30);
        else if (it < CMP2_ITEMS + SM_ITEMS) ph_smlstm(p, l, lds, it - CMP2_ITEMS, 1 << 30);
        else ph_ml1(p, l, lds, it - CMP2_ITEMS - SM_ITEMS, 1 << 30);
    }
}
__device__ __forceinline__ void ph_mixD(const P& p, int l, LDSP lds) { ph_ml2(p, l, lds); __syncthreads(); ph_nsa_prompt(p, l, lds); __syncthreads(); ph_nsa_sample(p, l, lds); }
#if defined(TIME_DUP) && TIME_DUP == 1
#define DUP_FRONT(F) F(ph_small) F(ph_swin_copy) F(ph_conv) F(ph_mqk) F(ph_mlstm) F(ph_ha)
#else
#define DUP_FRONT(F)
#endif
#if defined(TIME_DUP) && TIME_DUP == 2
#define DUP_NSAS(F) F(ph_sc) F(ph_sc_softmax) F(ph_oc) F(ph_select) F(ph_ss) F(ph_ss_softmax) F(ph_os) F(ph_sw) F(ph_sw_softmax) F(ph_ow) F(ph_hb)
#else
#define DUP_NSAS(F)
#endif
#if defined(TIME_DUP) && TIME_DUP == 3
#define DUP_NSAP(B) B(ph_nsa_prompt)
#else
#define DUP_NSAP(B)
#endif
#if defined(TIME_DUP) && TIME_DUP == 4
#define DUP_ML(F, B) B(ph_ml1) F(ph_ml2) B(ph_ml3) B(ph_compress)
#else
#define DUP_ML(F, B)
#endif
#if defined(TIME_DUP) && TIME_DUP == 31
#define TDUP1(B) B(ph_smlstm)
#elif defined(TIME_DUP) && TIME_DUP == 32
#define TDUP1(B) B(ph_ml1)
#elif defined(TIME_DUP) && TIME_DUP == 33
#define TDUP1(B) B(ph_compress)
#elif defined(TIME_DUP) && TIME_DUP == 11
#define TDUP1(B) B(ph_mixC)
#else
#define TDUP1(B)
#endif
#if defined(TIME_DUP) && TIME_DUP == 21
#define TDUP2(B) B(ph_nsa_sample)
#elif defined(TIME_DUP) && TIME_DUP == 22
#define TDUP2(B) B(ph_nsa_prompt)
#elif defined(TIME_DUP) && TIME_DUP == 23
#define TDUP2(B) B(ph_ml2)
#elif defined(TIME_DUP) && TIME_DUP == 12
#define TDUP2(B) B(ph_mixD)
#else
#define TDUP2(B)
#endif
#if defined(TIME_DUP) && TIME_DUP == 13
#define TDUP3(B) B(ph_gemm_in)
#else
#define TDUP3(B)
#endif
#if defined(TIME_DUP) && TIME_DUP == 16
#define TDUP6(B) B(ph_ml3)
#else
#define TDUP6(B)
#endif
#define LAYER_PHASES(F, B) \
    B(ph_gemm_in_plus) TDUP3(B) B(ph_mixC) TDUP1(B) B(ph_mixD) TDUP2(B) ML3_PHASE(B) TDUP6(B) B(ph_gemm_branch) B(ph_gemm_out) B(ph_gemm_up) B(ph_gemm_down) DIAG2_PHASES(F)

constexpr int LDS_BYTES = pg8::STAGE_BYTES + 16 + 256;
static_assert(NSA_LDS_END <= pg8::STAGE_BYTES && ML_LDS_END <= pg8::STAGE_BYTES && CMP_LDS_END <= pg8::STAGE_BYTES && CMP2_LDS_END <= pg8::STAGE_BYTES && CMP3_LDS_END <= MIXC_QSLOT_OFF && ML_LDS_END <= MIXC_QSLOT_OFF && SM_END <= MIXC_QSLOT_OFF && CMP3_LDS_END <= pg8::STAGE_BYTES && SM_END <= pg8::STAGE_BYTES, "LDS maps");

#ifndef CPU_TEST
#define XB_TMO      128
#define XB_XCNT(j)  (256  + 64 * (j))
#define XB_XSUB(j)  (1280 + 64 * (j))
#define XB_XGEN(j)  (2304 + 64 * (j))
#define XB_TOP      3328
#define XB_TOPGEN   3392
#define XCD_BAR_WORDS 3456
#define XB_SPIN_CAP (1u << 18)
#define LAS __attribute__((address_space(3)))

__device__ __forceinline__ unsigned xb_ld(unsigned* p)              { return __hip_atomic_load(p, __ATOMIC_RELAXED, __HIP_MEMORY_SCOPE_AGENT); }
__device__ __forceinline__ unsigned xb_add(unsigned* p, unsigned v) { return __hip_atomic_fetch_add(p, v, __ATOMIC_RELAXED, __HIP_MEMORY_SCOPE_AGENT); }
__device__ __forceinline__ unsigned xb_xcc_id() { return (unsigned)__builtin_amdgcn_s_getreg((3 << 11) | 20) & 0xFu; }
#define XB_SPIN(cond, bar) do { unsigned _sp = 0; while (cond) { __builtin_amdgcn_s_sleep(1); \
    if ((++_sp & 255u) == 0u) { if (xb_ld(&(bar)[XB_TMO])) break; if (_sp > XB_SPIN_CAP) { atomicAdd(&(bar)[XB_TMO], 1u); break; } } } } while (0)

struct XcdBarrier {
    unsigned* bar; unsigned x;
    volatile LAS unsigned* st;
};

__device__ __forceinline__ XcdBarrier xcd_barrier_post(unsigned* bar, volatile LAS unsigned* st) {
    XcdBarrier b; b.bar = bar; b.x = xb_xcc_id(); b.st = st;
    if (threadIdx.x == 0) (void)xb_add(&bar[XB_XCNT(b.x)], 1u);
    return b;
}
__device__ __forceinline__ void xcd_barrier_complete(unsigned* bar, unsigned x, unsigned& nloc, unsigned& nx) {
    const unsigned G = gridDim.x * gridDim.y * gridDim.z;
    unsigned sum, cnt, mine, sp = 0u;
    for (;;) {
        sum = 0u; cnt = 0u; mine = 0u;
#pragma unroll
        for (unsigned j = 0; j < 16; ++j) { const unsigned c = xb_ld(&bar[XB_XCNT(j)]); sum += c; cnt += (c > 0u) ? 1u : 0u; mine = (j == x) ? c : mine; }
        if (sum == G) break;
        __builtin_amdgcn_s_sleep(1);
        if ((++sp & 255u) == 0u) { if (xb_ld(&bar[XB_TMO])) break; if (sp > XB_SPIN_CAP) { atomicAdd(&bar[XB_TMO], 1u); break; } }
    }
    nloc = mine > 0u ? mine : 1u; nx = cnt > 0u ? cnt : 1u;
}

__device__ __forceinline__ void xcd_barrier(const XcdBarrier& b) {
    asm volatile("s_waitcnt vmcnt(0)" ::: "memory");
    __syncthreads();
    if (opaque_tid() == 0) {
        unsigned* bar = b.bar;
        __builtin_amdgcn_s_waitcnt(0);
        unsigned nloc = b.st[0], nx = b.st[1];
        if (nloc == 0u) { xcd_barrier_complete(bar, b.x, nloc, nx); b.st[0] = nloc; b.st[1] = nx; }
        const unsigned old = xb_add(&bar[XB_XSUB(b.x)], 1u);
        const unsigned gen = old / nloc;
        if (old + 1u == (gen + 1u) * nloc) {
            __builtin_amdgcn_fence(__ATOMIC_RELEASE, "agent");
            asm volatile("s_waitcnt vmcnt(0)" ::: "memory");
            const unsigned og = xb_add(&bar[XB_TOP], 1u);
            const unsigned tg = og / nx;
            if (og + 1u == (tg + 1u) * nx) xb_add(&bar[XB_TOPGEN], 1u);
            else XB_SPIN(xb_ld(&bar[XB_TOPGEN]) == tg, bar);
            __builtin_amdgcn_fence(__ATOMIC_ACQUIRE, "agent");
            xb_add(&bar[XB_XGEN(b.x)], 1u);
            asm volatile("s_waitcnt vmcnt(0)" ::: "memory");
        } else {
            XB_SPIN(xb_ld(&bar[XB_XGEN(b.x)]) == gen, bar);
            __builtin_amdgcn_fence(__ATOMIC_ACQUIRE, "agent");
            asm volatile("s_waitcnt vmcnt(0)" ::: "memory");
        }
    }
    __syncthreads();
}


#define GRID_SYNC() do { XcdBarrier b_; b_.bar = p.bar; b_.x = xb_xcc_id(); b_.st = (volatile LAS unsigned*)(lds + pg8::STAGE_BYTES); xcd_barrier(b_); } while (0)
#define RUN_F(name) { const long gtid = (long)blockIdx.x * NT + opaque_tid(), gsz = (long)gridDim.x * NT; name(p, l, gtid, gsz); } GRID_SYNC();
#define RUN_B(name) name(p, l, lds); GRID_SYNC();
__global__ void __launch_bounds__(NT, 2) mega_kernel(P p) {
    extern __shared__ __attribute__((aligned(16))) unsigned char smem[];
    LDSP lds = (LDSP)smem;
    for (int i = threadIdx.x; i < LDS_BYTES / 4; i += NT) ((PG8_LAS unsigned*)lds)[i] = 0u;
    __syncthreads();
    if ((threadIdx.x & 63) == 0) *(PG8_LAS int*)(lds + WTAB_LDS_OFF + 4 * hw_wave_key()) = (int)(threadIdx.x >> 6);
    __syncthreads();
    (void)xcd_barrier_post(p.bar, (volatile LAS unsigned*)(lds + pg8::STAGE_BYTES));
    { const int l = 0; RUN_B(ph_prologue) }
#if defined(TIME_DUP) && TIME_DUP == 20
    { const int l = 0; RUN_B(ph_prologue) }
#endif
    { const int l = 0; LAYER_PHASES(RUN_F, RUN_B) }
    { const int l = 1; LAYER_PHASES(RUN_F, RUN_B) }
    static_assert(DEPTH == 2, "layer program is written out twice");
    { const int l = 0; const long gtid = (long)blockIdx.x * NT + opaque_tid(), gsz = (long)gridDim.x * NT; ph_final(p, l, gtid, gsz); }
}
#ifdef PHASE_PROBE
#define PK_B(name) __global__ void __launch_bounds__(NT, 2) probe_##name(P p, int l) { extern __shared__ __attribute__((aligned(16))) unsigned char smem[]; name(p, l, (LDSP)smem); }
#define PK_F(name) __global__ void __launch_bounds__(NT, 2) probe_##name(P p, int l) { name(p, l, (long)blockIdx.x * NT + threadIdx.x, (long)gridDim.x * NT); }
LAYER_PHASES(PK_F, PK_B)
PK_B(ph_prologue)
PK_B(ph_nsa_prompt) PK_B(ph_nsa_sample) PK_B(ph_ml1) PK_B(ph_ml2) PK_B(ph_compress) PK_B(ph_smlstm) PK_B(ph_small_mfma)
#endif
#else
#ifndef EMU_GRID
#define EMU_GRID 16
#endif
#define RUN_F(name) emu_parallel_for(1 << 14, [&](long g_) { name(p, l, g_, 1 << 14); });
#define RUN_B(name) emu_launch(EMU_GRID, NT, [&]() { name(p, l, (LDSP)emu_lds()); });
#endif

extern "C" void kernel_launch(void* const* d_in, const int* in_sizes, int n_in, void* d_out, int out_size, void* d_ws, size_t ws_size,
                              hipStream_t stream) {
    P p{};
    const float* const* f = (const float* const*)d_in;
    p.x_prompt = f[0]; p.x_sample = f[1]; p.cache_kv = f[2]; p.page_table = (const int*)d_in[3]; p.cache_win = f[4];
    p.st_C = f[5]; p.st_n = f[6]; p.st_m = f[7]; p.st_conv = f[8]; p.norm1_g = f[9]; p.w_in = f[10]; p.b_gates = f[11];
    p.conv_w = f[12]; p.conv_b = f[13]; p.w_mq = f[14]; p.w_mk = f[15]; p.mnorm_g = f[16]; p.pe_k = f[17]; p.pe_v = f[18];
    p.w1_k = f[19]; p.w2_k = f[20]; p.w1_v = f[21]; p.w2_v = f[22]; p.w_a = f[23]; p.w_b = f[24]; p.w_out = f[25];
    p.norm2_g = f[26]; p.w_up = f[27]; p.w_down = f[28]; p.final_g = f[29];
    p.out = (float*)d_out;
    char* w = (char*)d_ws;
    auto takeb = [&](size_t bytes) { char* r = w; w += (bytes + 255) / 256 * 256; return r; };
    auto take = [&](size_t n) { return (float*)takeb(n * 4); };
    auto take16 = [&](size_t n) { return (bf16_t*)takeb(n * 2); };
    p.bar = (unsigned*)takeb(16384); p.DIAGF = (int*)(p.bar + 3600); p.QCTR = (int*)(p.bar + 3800);
    p.X = take((size_t)MPAD * D); p.Z = take((size_t)MPAD * INW); p.RSS = (unsigned long long*)takeb((size_t)5 * MPAD * 8);
    p.KW = take((size_t)NTOK * 256); p.QR = take((size_t)NTOK * 512); p.CC = take((size_t)NTOK * 512);
    p.IG = take((size_t)NTOK * 4); p.LF = take((size_t)NTOK * 4); p.QM = take((size_t)NTOK * 512); p.KM = take((size_t)NTOK * 512);
    p.NUMP = take((size_t)NTOK * MH * 4 * 129); p.MT = take((size_t)NTOK * 4);
    p.HID = take(KC_ROWS * 4 * CHID); p.KC = take(KC_ROWS * 128); p.VC = take(KC_ROWS * 128);
    p.PC = take((size_t)NTOK * NH * NCMAX); p.OC = take((size_t)NTOK * 512); p.OS = take((size_t)NTOK * 512); p.OW = take((size_t)NTOK * 512);
    p.SCORE = take((size_t)NTOK * NKV * 64); p.PS = take((size_t)NTOK * NH * 1024); p.PW = take((size_t)NTOK * NH * 512);
    p.MGF = take((size_t)MPAD * D);
    p.SEL = (int*)take((size_t)NTOK * NKV * SELTOP);
    p.XB = take16((size_t)MPAD * D); p.HAB = take16((size_t)MPAD * MW); p.HBB = take16((size_t)3 * MPAD * MW); p.MGB = take16((size_t)MPAD * D);
    p.ACTB = take16((size_t)MPAD * DFF);
    p.QMB = take16((size_t)2 * MPAD * MW); p.KMB = take16((size_t)2 * MPAD * MW); p.CSB = take16((size_t)NMI * MHD * MHD);
    p.WSM_T = take16((size_t)DEPTH * 32 * D); p.SGB = take16((size_t)MPAD * 2048); p.KCB = take16(KC_ROWS * 128 + 64 * 128); p.VCB = take16(KC_ROWS * 128 + 64 * 128); p.ROPE = take((size_t)ROPE_POS * 16); p.W1T = take16((size_t)DEPTH * 2 * 128 * 2048); p.W2T = take16((size_t)DEPTH * 2 * 64 * 128); p.CBIAS = take((size_t)DEPTH * 2 * 128);
    p.WMQ_T = take16((size_t)DEPTH * MH * MHD * MHD); p.WMK_T = take16((size_t)DEPTH * MH * MHD * MHD);
    p.DC = take((size_t)2 * NMI * MHD * MHD); p.DN = take((size_t)2 * NMI * MHD); p.GSUM = take((size_t)2 * NMI * 2); p.NS = take((size_t)NMI * MHD); p.MS = take(NMI);
    p.QCB = take16((size_t)MPAD * 512); p.QRB = take16((size_t)MPAD * 512);
    p.KSB = take16((size_t)NKV * MPAD * 64); p.VSB = take16((size_t)NKV * MPAD * 64); p.KWB = take16((size_t)NKV * MPAD * 64); p.VWB = take16((size_t)NKV * MPAD * 64);
    p.WIN_T = take16((size_t)DEPTH * INP * D); p.WA_T = take16((size_t)DEPTH * D * MW); p.WB_T = take16((size_t)DEPTH * D * MW);
    p.WOUT_T = take16((size_t)DEPTH * D * D); p.WUP_T = take16((size_t)DEPTH * 2 * DFF * D); p.WDOWN_T = take16((size_t)DEPTH * D * DFF);
#ifdef CPU_TEST
    memset(p.bar, 0, 16384);
    { const int l = 0; RUN_B(ph_prologue) }
    for (int l = 0; l < DEPTH; ++l) {
        LAYER_PHASES(RUN_F, RUN_B)
    }
    { const int l = 0; RUN_F(ph_final) }
#else
    static int grid = 0;
    if (grid == 0) {
        int dev = 0, cus = 0;
        if (hipGetDevice(&dev) != hipSuccess || hipDeviceGetAttribute(&cus, hipDeviceAttributeMultiprocessorCount, dev) != hipSuccess) { grid = -1; return; }
        if (hipFuncSetAttribute((const void*)mega_kernel, hipFuncAttributeMaxDynamicSharedMemorySize, LDS_BYTES) != hipSuccess) { fprintf(stderr, "hipFuncSetAttribute failed\n"); grid = -1; return; }
        (void)hipGetLastError();
        grid = cus;
    }
    if (grid < 0) return;
    (void)hipMemsetAsync(p.bar, 0, 16384, stream);
#ifdef DIAG_NANFILL
    (void)hipMemsetAsync((char*)d_ws + 16384, 0xFF, (size_t)(w - (char*)d_ws) - 16384, stream);
#endif
    hipLaunchKernelGGL(mega_kernel, dim3(grid), dim3(NT), LDS_BYTES, stream, p);
#endif
}
```
